# Optimizing an MI355X kernel written in HIP

```python
import math
import jax, jax.numpy as jnp
from jax import lax
import numpy as np

D_MODEL = 1024
BATCH = 16
SEQ = 2048
DEPTH = 1

MLA_HEADS = 8
QK_NOPE = 64
QK_ROPE = 32
V_DIM = 64
Q_LORA = 384
KV_LORA = 256
ROPE_BASE = 10000.0
Q_BLOCK = 128
MLA_OUT = MLA_HEADS * V_DIM
RWKV_HEADS = 8
RWKV_HEAD = 64
RWKV_DIM = RWKV_HEADS * RWKV_HEAD
DECAY_LORA = 64
AAA_LORA = 64
GATE_LORA = 128
LNX_EPS = 64e-5
N_DIR = 2
N_BRANCH = 2
MLA_IN = Q_LORA + KV_LORA + QK_ROPE
RWKV_IN = 3 * RWKV_DIM + N_DIR * DECAY_LORA + N_DIR * AAA_LORA + GATE_LORA
GATE_IN = N_BRANCH * D_MODEL
IN_DIM = MLA_IN + RWKV_IN + GATE_IN
N_GROUPS = 4
EXPERTS_PER_GROUP = 8
N_EXPERTS = N_GROUPS * EXPERTS_PER_GROUP
TOP_K = 2
D_EXPERT = 256
MOE_BLOCK = 128
NORM_EPS = 1e-6

kernel_name = 'hybrid_mla_birwkv7_hiermoe_encoder'


def rms_norm(x, g, eps=NORM_EPS):
    xf = x.astype(jnp.float32)
    y = xf * lax.rsqrt(jnp.mean(xf * xf, axis=-1, keepdims=True) + eps)
    return (y * g.astype(jnp.float32)).astype(x.dtype)


def apply_rope(x, cos, sin):
    half = x.shape[-1] // 2
    x1 = x[..., :half].astype(jnp.float32)
    x2 = x[..., half:].astype(jnp.float32)
    out = jnp.concatenate([x1 * cos - x2 * sin, x1 * sin + x2 * cos], axis=-1)
    return out.astype(x.dtype)


def mla_branch(z, q_norm_g, kv_norm_g, w_uq, w_ukv):
    B, S, _ = z.shape
    c_q = rms_norm(z[..., :Q_LORA], q_norm_g)
    c_kv = rms_norm(z[..., Q_LORA:Q_LORA + KV_LORA], kv_norm_g)
    k_rope = z[..., Q_LORA + KV_LORA:]
    q = (c_q @ w_uq).reshape(B, S, MLA_HEADS, QK_NOPE + QK_ROPE)
    kv = (c_kv @ w_ukv).reshape(B, S, MLA_HEADS, QK_NOPE + V_DIM)
    q_nope, q_rope = q[..., :QK_NOPE], q[..., QK_NOPE:]
    k_nope, v = kv[..., :QK_NOPE], kv[..., QK_NOPE:]
    pos = jnp.arange(S, dtype=jnp.float32)
    inv_freq = ROPE_BASE ** (-jnp.arange(0, QK_ROPE, 2, dtype=jnp.float32) / QK_ROPE)
    ang = pos[:, None] * inv_freq[None, :]
    cos, sin = jnp.cos(ang), jnp.sin(ang)
    q_rope = apply_rope(q_rope, cos[:, None, :], sin[:, None, :])
    k_rope = apply_rope(k_rope, cos, sin)
    scale = (QK_NOPE + QK_ROPE) ** -0.5
    nb = S // Q_BLOCK
    qn_b = q_nope.reshape(B, nb, Q_BLOCK, MLA_HEADS, QK_NOPE).transpose(1, 0, 2, 3, 4)
    qr_b = q_rope.reshape(B, nb, Q_BLOCK, MLA_HEADS, QK_ROPE).transpose(1, 0, 2, 3, 4)

    def attend(blk):
        qn, qr = blk
        s = (jnp.einsum('bqhd,bkhd->bhqk', qn, k_nope)
             + jnp.einsum('bqhd,bkd->bhqk', qr, k_rope))
        p = jax.nn.softmax(s.astype(jnp.float32) * scale, axis=-1).astype(v.dtype)
        return jnp.einsum('bhqk,bkhd->bqhd', p, v)

    o = lax.map(attend, (qn_b, qr_b))
    return o.transpose(1, 0, 2, 3, 4).reshape(B, S, MLA_OUT)


def token_shift_centred(z, mu_prev, mu_next):
    z_prev = jnp.pad(z[:, :-1], ((0, 0), (1, 0), (0, 0)))
    z_next = jnp.pad(z[:, 1:], ((0, 0), (0, 1), (0, 0)))
    return z + mu_prev * (z_prev - z) + mu_next * (z_next - z)


def wkv7_scan(r, w, k, v, a_vec, b_vec):
    B, S, H, N = r.shape

    def step(state, inp):
        r_t, w_t, k_t, v_t, a_t, b_t = inp
        sa = jnp.einsum('bhvk,bhk->bhv', state, a_t)
        state = (state * w_t[:, :, None, :] + sa[..., None] * b_t[:, :, None, :]
                 + v_t[..., None] * k_t[:, :, None, :])
        return state, jnp.einsum('bhvk,bhk->bhv', state, r_t)

    xs = tuple(jnp.moveaxis(t, 1, 0) for t in (r, w, k, v, a_vec, b_vec))
    s0 = jnp.zeros((B, H, N, N), jnp.float32)
    _, y = lax.scan(step, s0, xs)
    return jnp.moveaxis(y, 0, 1)


def rwkv_branch(z, mu_prev, mu_next, w0, w_up, a0, a_up, g_up, k_k, k_a, r_k, lnx_g, lnx_b):
    B, S, _ = z.shape
    C, H, N = RWKV_DIM, RWKV_HEADS, RWKV_HEAD
    f32 = jnp.float32
    zf = token_shift_centred(z.astype(f32), mu_prev.astype(f32), mu_next.astype(f32))
    r, k, v = zf[..., :C], zf[..., C:2 * C], zf[..., 2 * C:3 * C]
    o = 3 * C
    wd = zf[..., o:o + N_DIR * DECAY_LORA].reshape(B, S, N_DIR, DECAY_LORA)
    o += N_DIR * DECAY_LORA
    ad = zf[..., o:o + N_DIR * AAA_LORA].reshape(B, S, N_DIR, AAA_LORA)
    o += N_DIR * AAA_LORA
    gd = zf[..., o:]
    w_logit = w0.astype(f32) + jnp.einsum('bsdr,drc->bsdc', jnp.tanh(wd), w_up.astype(f32))
    decay = jnp.exp(-jnp.exp(-jax.nn.softplus(-w_logit) - 0.5))
    a = jax.nn.sigmoid(a0.astype(f32) + jnp.einsum('bsdr,drc->bsdc', ad, a_up.astype(f32)))
    g = jax.nn.sigmoid(gd) @ g_up.astype(f32)

    def heads(t):
        return t.reshape(t.shape[:-1] + (H, N))

    kk = heads(k * k_k.astype(f32))
    kk = kk / jnp.maximum(jnp.sqrt(jnp.sum(kk * kk, axis=-1, keepdims=True)), 1e-12)
    k_dir = heads(k[:, :, None, :] * (1.0 + (a - 1.0) * k_a.astype(f32)))
    a_h, decay_h = heads(a), heads(decay)
    r_h, v_h = heads(r), heads(v)
    y_f = wkv7_scan(r_h, decay_h[:, :, 0], k_dir[:, :, 0], v_h, -kk, kk * a_h[:, :, 0])
    fl = lambda t: jnp.flip(t, axis=1)
    y_b = fl(wkv7_scan(fl(r_h), fl(decay_h[:, :, 1]), fl(k_dir[:, :, 1]), fl(v_h),
                       fl(-kk), fl(kk * a_h[:, :, 1])))
    y = y_f + y_b
    mu = jnp.mean(y, axis=-1, keepdims=True)
    var = jnp.mean(jnp.square(y - mu), axis=-1, keepdims=True)
    y = ((y - mu) * lax.rsqrt(var + LNX_EPS)).reshape(B, S, C)
    y = y * lnx_g.astype(f32) + lnx_b.astype(f32)
    bonus = jnp.sum(r_h[:, :, None] * k_dir * heads(r_k.astype(f32)), axis=-1, keepdims=True) * v_h[:, :, None]
    y = y + jnp.sum(bonus, axis=2).reshape(B, S, C)
    return (y * g).astype(z.dtype)


def hier_moe(h, rg_w, rg_b, re_w, re_b, w1, w3, w2):
    B, S, D = h.shape
    T = B * S
    ht = h.reshape(T, D)
    group_p = jax.nn.softmax((ht @ rg_w + rg_b).astype(jnp.float32), axis=-1)
    gp, gi = lax.top_k(group_p, 1)
    gp, gi = gp[:, 0], gi[:, 0]
    e_logits = (ht @ re_w + re_b).astype(jnp.float32).reshape(T, N_GROUPS, EXPERTS_PER_GROUP)
    sel = jnp.take_along_axis(e_logits, gi[:, None, None], axis=1)[:, 0]
    ep = jax.nn.softmax(sel, axis=-1)
    tp, ti = lax.top_k(ep, TOP_K)
    tp = tp / jnp.sum(tp, axis=-1, keepdims=True)
    weight = gp[:, None] * tp
    expert = gi[:, None] * EXPERTS_PER_GROUP + ti
    A = T * TOP_K
    flat_e = expert.reshape(A)
    flat_w = weight.reshape(A)
    flat_tok = jnp.repeat(jnp.arange(T, dtype=jnp.int32), TOP_K)
    order = jnp.argsort(flat_e)
    se, stok, sw = flat_e[order], flat_tok[order], flat_w[order]
    counts = jnp.bincount(flat_e, length=N_EXPERTS)
    padded = ((counts + MOE_BLOCK - 1) // MOE_BLOCK) * MOE_BLOCK
    start = jnp.cumsum(counts) - counts
    pend = jnp.cumsum(padded)
    pstart = pend - padded
    dest = pstart[se] + (jnp.arange(A, dtype=jnp.int32) - start[se])
    n_blocks = -(-A // MOE_BLOCK) + N_EXPERTS
    cap = n_blocks * MOE_BLOCK
    slot_tok = jnp.full((cap,), T, jnp.int32).at[dest].set(stok)
    slot_w = jnp.zeros((cap,), h.dtype).at[dest].set(sw.astype(h.dtype))
    block_e = jnp.minimum(jnp.searchsorted(pend, jnp.arange(n_blocks) * MOE_BLOCK, side='right'),
                          N_EXPERTS - 1)
    h_pad = jnp.concatenate([ht, jnp.zeros((1, D), ht.dtype)], axis=0)
    xb = h_pad[slot_tok].reshape(n_blocks, MOE_BLOCK, D)

    def expert_block(args):
        xblk, e = args
        hid = jax.nn.silu(xblk @ w1[e]) * (xblk @ w3[e])
        return hid @ w2[e]

    yb = lax.map(expert_block, (xb, block_e)).reshape(cap, D)
    y = jax.ops.segment_sum(yb * slot_w[:, None], slot_tok, num_segments=T + 1)[:T]
    return y.reshape(B, S, D)


def setup_inputs(seed: int = 0) -> dict:
    key = jax.random.key(seed)
    ks = iter(jax.random.split(key, 48))
    L, D, C = DEPTH, D_MODEL, RWKV_DIM
    f32 = jnp.float32
    nrm = lambda shape, s: jax.random.normal(next(ks), shape, f32) * s
    uni = lambda shape, lo, hi: jax.random.uniform(next(ks), shape, f32, lo, hi)
    return {
        'x': nrm((BATCH, SEQ, D), 1.0),
        'norm_mix_g': 1.0 + nrm((L, D), 0.02),
        'w_in': nrm((L, D, IN_DIM), D ** -0.5),
        'q_norm_g': 1.0 + nrm((L, Q_LORA), 0.02),
        'kv_norm_g': 1.0 + nrm((L, KV_LORA), 0.02),
        'w_uq': nrm((L, Q_LORA, MLA_HEADS * (QK_NOPE + QK_ROPE)), Q_LORA ** -0.5),
        'w_ukv': nrm((L, KV_LORA, MLA_HEADS * (QK_NOPE + V_DIM)), KV_LORA ** -0.5),
        'w_br_mla': nrm((L, MLA_OUT, D), MLA_OUT ** -0.5),
        'mu_prev': uni((L, RWKV_IN), 0.0, 0.5),
        'mu_next': uni((L, RWKV_IN), 0.0, 0.5),
        'w0': uni((L, N_DIR, C), -3.0, 1.0),
        'w_up': nrm((L, N_DIR, DECAY_LORA, C), 0.5 * DECAY_LORA ** -0.5),
        'a0': nrm((L, N_DIR, C), 0.1),
        'a_up': nrm((L, N_DIR, AAA_LORA, C), 0.5 * AAA_LORA ** -0.5),
        'g_up': nrm((L, GATE_LORA, C), GATE_LORA ** -0.5),
        'k_k': 0.85 + nrm((L, C), 0.02),
        'k_a': 1.0 + nrm((L, C), 0.02),
        'r_k': nrm((L, C), 0.1),
        'lnx_g': 1.0 + nrm((L, C), 0.02),
        'lnx_b': nrm((L, C), 0.01),
        'w_br_rwkv': nrm((L, C, D), C ** -0.5),
        'gate_b': nrm((L, N_BRANCH, D), 0.01),
        'w_out': nrm((L, D, D), D ** -0.5),
        'norm_ffn_g': 1.0 + nrm((L, D), 0.02),
        'router_group_w': nrm((L, D, N_GROUPS), D ** -0.5),
        'router_group_b': nrm((L, N_GROUPS), 0.01),
        'router_expert_w': nrm((L, D, N_EXPERTS), D ** -0.5),
        'router_expert_b': nrm((L, N_EXPERTS), 0.01),
        'w1': nrm((L, N_EXPERTS, D, D_EXPERT), D ** -0.5),
        'w3': nrm((L, N_EXPERTS, D, D_EXPERT), D ** -0.5),
        'w2': nrm((L, N_EXPERTS, D_EXPERT, D), D_EXPERT ** -0.5),
        'norm_final_g': 1.0 + nrm((D,), 0.02),
    }


def reference(x, norm_mix_g, w_in, q_norm_g, kv_norm_g, w_uq, w_ukv, w_br_mla,
              mu_prev, mu_next, w0, w_up, a0, a_up, g_up, k_k, k_a, r_k, lnx_g, lnx_b,
              w_br_rwkv, gate_b, w_out, norm_ffn_g, router_group_w, router_group_b,
              router_expert_w, router_expert_b, w1, w3, w2, norm_final_g):
    B, S, D = x.shape
    for l in range(DEPTH):
        h = rms_norm(x, norm_mix_g[l])
        z = h @ w_in[l]
        z_mla = z[..., :MLA_IN]
        z_rwkv = z[..., MLA_IN:MLA_IN + RWKV_IN]
        z_gate = z[..., MLA_IN + RWKV_IN:].reshape(B, S, N_BRANCH, D)
        o_mla = mla_branch(z_mla, q_norm_g[l], kv_norm_g[l], w_uq[l], w_ukv[l])
        o_rwkv = rwkv_branch(z_rwkv, mu_prev[l], mu_next[l], w0[l], w_up[l], a0[l], a_up[l],
                             g_up[l], k_k[l], k_a[l], r_k[l], lnx_g[l], lnx_b[l])
        gates = jax.nn.sigmoid(z_gate + gate_b[l])
        mixed = gates[:, :, 0] * (o_mla @ w_br_mla[l]) + gates[:, :, 1] * (o_rwkv @ w_br_rwkv[l])
        x = x + mixed @ w_out[l]
        h2 = rms_norm(x, norm_ffn_g[l])
        x = x + hier_moe(h2, router_group_w[l], router_group_b[l], router_expert_w[l],
                         router_expert_b[l], w1[l], w3[l], w2[l])
    return rms_norm(x, norm_final_g)
```

```cpp
#include <hip/hip_runtime.h>
#include <cstdio>
#include <cstdint>

#define DEVI __device__ __forceinline__
#ifndef PROBE_MASK
#define PROBE_MASK 0
#endif
typedef unsigned short bf16_t;
typedef short bf16x8 __attribute__((ext_vector_type(8)));
typedef short s16x4 __attribute__((ext_vector_type(4)));
typedef float f32x4 __attribute__((ext_vector_type(4)));
typedef float f32x16 __attribute__((ext_vector_type(16)));
typedef unsigned u32x4 __attribute__((ext_vector_type(4)));
typedef unsigned u32x2 __attribute__((ext_vector_type(2)));

constexpr int BATCH = 16, SEQ = 2048, DM = 1024, T_ = BATCH * SEQ;
constexpr int NH = 8;
constexpr int LDZ = 2560;
constexpr int NZ = 2560;
constexpr int ZR = 640;
constexpr int NEXP = 32, DEXP = 256;
constexpr int CAP = T_ * 2 + NEXP * 256;
constexpr int NBLK = CAP / 256;
constexpr int NTHREADS = 512, NWAVES = 8;

constexpr size_t MiB = 1u << 20;
constexpr size_t OFF_CTL = 0;
constexpr size_t OFF_WIN = 1 * MiB;
constexpr size_t OFF_WG = 7 * MiB;
constexpr size_t OFF_WUQ = 11 * MiB;
constexpr size_t OFF_WUKV = 12 * MiB;
constexpr size_t OFF_WBM = 13 * MiB;
constexpr size_t OFF_WBR = 14 * MiB;
constexpr size_t OFF_WOUT = 15 * MiB;
constexpr size_t OFF_WUP = 17 * MiB;
constexpr size_t OFF_AUP = 17 * MiB + 131072;
constexpr size_t OFF_GUP = 17 * MiB + 262144;
constexpr size_t OFF_WKR = 17 * MiB + 524288;
constexpr size_t OFF_ROPE = 18 * MiB;
constexpr size_t OFF_TOKE = 18 * MiB + 262144;
constexpr size_t OFF_TOKW = 18 * MiB + 524288;
constexpr size_t OFF_TOKS = 18 * MiB + 786432;
constexpr size_t OFF_TOKR = 19 * MiB;
constexpr size_t OFF_WRT = 19 * MiB + 524288;
constexpr size_t OFF_CNTWG = 19 * MiB + 786432;
constexpr size_t OFF_KROPE = 20 * MiB;
constexpr size_t OFF_YB = 22 * MiB;
constexpr size_t OFF_W13 = 366 * MiB;
constexpr size_t OFF_W2 = 54 * MiB;
constexpr size_t OFF_TW = 70 * MiB;
constexpr size_t OFF_AD = 78 * MiB;
constexpr size_t OFF_SG = 54 * MiB;
constexpr size_t OFF_Z = 94 * MiB;
constexpr size_t OFF_H = 302 * MiB;
constexpr size_t OFF_WL = 270 * MiB;
constexpr size_t OFF_G = 398 * MiB;
constexpr size_t OFF_OMLA = 430 * MiB;
constexpr size_t OFF_YF = 462 * MiB;
constexpr size_t OFF_H2ND = 94 * MiB;
constexpr size_t OFF_GL = 158 * MiB;
constexpr size_t OFF_BM = 94 * MiB;
constexpr size_t OFF_X1 = 94 * MiB;
constexpr size_t DOFF_H2 = 0;
constexpr size_t OFF_YE = 158 * MiB;
constexpr size_t DOFF_HID = 65 * MiB;
constexpr size_t OFF_VS = 270 * MiB;
constexpr size_t OFF_SDIR = 70 * MiB;
constexpr size_t OFF_MIXED = 286 * MiB;
constexpr size_t OFF_SLOTTOK = 338 * MiB;
constexpr size_t WS_NEED = 494 * MiB;
constexpr size_t DOFF_QRAW = 0, DOFF_KVRAW = 48 * MiB;

constexpr int C_CNT = 0, C_CUR = 64, C_PST = 128, C_NBLK = 192, C_BLKE = 256;

DEVI int my_tid() { int t = threadIdx.x; asm volatile("" : "+v"(t)); return t; }
DEVI float bf2f(unsigned h) { return __uint_as_float(h << 16); }
DEVI unsigned f2bf(float f) { unsigned u = __float_as_uint(f); return (u + 0x7fffu + ((u >> 16) & 1u)) >> 16; }
typedef float f32x2p __attribute__((ext_vector_type(2))); typedef __bf16 bf16x2p __attribute__((ext_vector_type(2)));
DEVI unsigned pk2(float lo, float hi) { const f32x2p v = {lo, hi}; return __builtin_bit_cast(unsigned, __builtin_convertvector(v, bf16x2p)); }
DEVI float lo16(unsigned w) { return __uint_as_float(w << 16); }
DEVI float hi16(unsigned w) { return __uint_as_float(w & 0xffff0000u); }
DEVI float wave_sum(float v) {
    v += __int_as_float(__builtin_amdgcn_update_dpp(0, __float_as_int(v), 0xB1, 0xF, 0xF, false));
    v += __int_as_float(__builtin_amdgcn_update_dpp(0, __float_as_int(v), 0x4E, 0xF, 0xF, false));
    v += __int_as_float(__builtin_amdgcn_update_dpp(0, __float_as_int(v), 0x141, 0xF, 0xF, false));
    v += __int_as_float(__builtin_amdgcn_update_dpp(0, __float_as_int(v), 0x140, 0xF, 0xF, false));
    v += __shfl_xor(v, 16); v += __shfl_xor(v, 32);
    return v;
}
DEVI float sigmoidf_(float x) { return __builtin_amdgcn_rcpf(1.f + __expf(-x)); }

struct TJob { int in_idx, K, ldsrc, col0, ncols, row_mul, row_off, nbatch; long long sbs, dbs, dst_off; int item0, dst_ld; };
constexpr int MAXJOBS = 16;
struct Params {
    const float* in[32];
    float* out;
    unsigned char* ws;
    TJob jobs[MAXJOBS];
    int njobs_early, njobs_all, items_early, items_all;
    int njobs_mid, items_mid;
};

DEVI void transpose_item(const float* W, int K, int ld, bf16_t* WT, int dst_ld, int row_off, int row_mul, float* scr, int kb, int nb, int lane) {
    const int k0 = 64 * kb, n0 = 32 * nb;
    float tv[32];
#pragma unroll
    for (int i = 0; i < 32; ++i) tv[i] = W[(size_t)(k0 + 2 * i + (lane >> 5)) * ld + n0 + (lane & 31)];
#pragma unroll
    for (int i = 0; i < 32; ++i) scr[(2 * i + (lane >> 5)) * 33 + (lane & 31)] = tv[i];
    asm volatile("s_waitcnt lgkmcnt(0)" ::: "memory");
    const int c = lane & 7;
#pragma unroll
    for (int j = 0; j < 4; ++j) {
        const int n = (lane >> 3) + 8 * j; const float* s = scr + (8 * c) * 33 + n;
        u32x4 o; o.x = pk2(s[0], s[33]); o.y = pk2(s[66], s[99]); o.z = pk2(s[132], s[165]); o.w = pk2(s[198], s[231]);
        *(u32x4*)(WT + (size_t)(row_off + (n0 + n) * row_mul) * dst_ld + k0 + 8 * c) = o;
    }
    asm volatile("s_waitcnt lgkmcnt(0)" ::: "memory");
}
DEVI void stage_transposes(const Params& p, int j0, int j1, int item_base, int item_end, char* lds, int bid, int nb) {
    const int lane = my_tid() & 63, wave = my_tid() >> 6;
    float* scr = (float*)(lds + wave * 8704);
    const int gw = bid * NWAVES + wave, NGW = nb * NWAVES;
    for (int it = item_base + gw; it < item_end; it += NGW) {
        int j = j0;
        while (j + 1 < j1 && it >= p.jobs[j + 1].item0) ++j;
        const TJob& J = p.jobs[j];
        int r = it - J.item0;
        const int nblk = J.ncols / 32, per = (J.K / 64) * nblk;
        const int e = r / per; r -= e * per;
        const int kb = r / nblk, nbk = r % nblk;
        transpose_item(p.in[J.in_idx] + (size_t)e * J.sbs + J.col0, J.K, J.ldsrc, (bf16_t*)(p.ws + J.dst_off) + (size_t)e * J.dbs, J.dst_ld, J.row_off, J.row_mul, scr, kb, nbk, lane);
    }
}
DEVI void stage_rope_table(const Params& p, int bid, int nb) {
    float* ct = (float*)(p.ws + OFF_ROPE); float* st = ct + SEQ * 16;
    for (int i = bid * NTHREADS + my_tid(); i < SEQ * 16; i += nb * NTHREADS) {
        const int pos = i >> 4, f = i & 15;
        const double inv = pow(10000.0, -(double)(2 * f) / 32.0);
        const double ang = (double)pos * inv;
        ct[i] = (float)cos(ang); st[i] = (float)sin(ang);
    }
}

DEVI void stage_rms_rows(const float* x, const float* g, bf16_t* out, int bid, int nb) {
    const int lane = my_tid() & 63, wave = my_tid() >> 6;
    const int gw = bid * NWAVES + wave, NGW = nb * NWAVES;
    f32x4 gv[4];
#pragma unroll
    for (int j = 0; j < 4; ++j) gv[j] = *(const f32x4*)(g + 4 * lane + 256 * j);
    for (int mb = gw * 4; mb < T_; mb += NGW * 4) {
        f32x4 v[4][4];
#pragma unroll
        for (int q = 0; q < 4; ++q) { const f32x4* xr = (const f32x4*)(x + (size_t)(mb + q) * DM) + lane;
#pragma unroll
            for (int j = 0; j < 4; ++j) v[q][j] = xr[64 * j]; }
#pragma unroll
        for (int q = 0; q < 4; ++q) { float s = 0.f;
#pragma unroll
            for (int j = 0; j < 4; ++j) s += (v[q][j].x * v[q][j].x + v[q][j].y * v[q][j].y) + (v[q][j].z * v[q][j].z + v[q][j].w * v[q][j].w);
            const float rstd = rsqrtf(wave_sum(s) * (1.f / DM) + 1e-6f);
            u32x2* o8 = (u32x2*)(out + (size_t)(mb + q) * DM) + lane;
#pragma unroll
            for (int j = 0; j < 4; ++j) { u32x2 w; w.x = pk2(v[q][j].x * rstd * gv[j].x, v[q][j].y * rstd * gv[j].y); w.y = pk2(v[q][j].z * rstd * gv[j].z, v[q][j].w * rstd * gv[j].w); o8[64 * j] = w; } }
    }
}

typedef short v4i16_t_ __attribute__((ext_vector_type(4)));
DEVI s16x4 vtr_(const char* p) { return __builtin_bit_cast(s16x4, __builtin_amdgcn_ds_read_tr16_b64_v4i16((__attribute__((address_space(3))) v4i16_t_*)p)); }
struct EpiBf16 { bf16_t* out; int ld;
    DEVI void operator()(int row, int col, f32x4 v) const { u32x2 w; w.x = pk2(v.x, v.y); w.y = pk2(v.z, v.w); *(u32x2*)(out + (size_t)row * ld + col) = w; } };
struct EpiBiasAct { bf16_t* out; int ld; const float* bias; int act;
    DEVI void operator()(int row, int col, f32x4 v) const {
        const f32x4 b = *(const f32x4*)(bias + col); v = v + b;
        if (act) { v.x = sigmoidf_(v.x); v.y = sigmoidf_(v.y); v.z = sigmoidf_(v.z); v.w = sigmoidf_(v.w); }
        u32x2 w; w.x = pk2(v.x, v.y); w.y = pk2(v.z, v.w); *(u32x2*)(out + (size_t)row * ld + col) = w; } };
struct EpiMix { const bf16_t* gl; bf16_t* bm; const float* gb;
    DEVI void operator()(int row, int col, f32x4 v) const {
        const u32x2 g1 = *(const u32x2*)(gl + (size_t)row * 2048 + col), g2 = *(const u32x2*)(gl + (size_t)row * 2048 + 1024 + col);
        const u32x2 m = *(const u32x2*)(bm + (size_t)row * 1024 + col);
        const f32x4 b0 = *(const f32x4*)(gb + col), b1 = *(const f32x4*)(gb + 1024 + col);
        f32x4 r;
        r.x = sigmoidf_(lo16(g1.x) + b0.x) * lo16(m.x) + sigmoidf_(lo16(g2.x) + b1.x) * v.x;
        r.y = sigmoidf_(hi16(g1.x) + b0.y) * hi16(m.x) + sigmoidf_(hi16(g2.x) + b1.y) * v.y;
        r.z = sigmoidf_(lo16(g1.y) + b0.z) * lo16(m.y) + sigmoidf_(lo16(g2.y) + b1.z) * v.z;
        r.w = sigmoidf_(hi16(g1.y) + b0.w) * hi16(m.y) + sigmoidf_(hi16(g2.y) + b1.w) * v.w;
        u32x2 w; w.x = pk2(r.x, r.y); w.y = pk2(r.z, r.w); *(u32x2*)(bm + (size_t)row * 1024 + col) = w; } };
struct EpiResid { const float* x; float* out;
    DEVI void operator()(int row, int col, f32x4 v) const { const f32x4 b = *(const f32x4*)(x + (size_t)row * DM + col); *(f32x4*)(out + (size_t)row * DM + col) = b + v; } };
struct EpiSwiglu { bf16_t* hid;
    DEVI void operator()(int row, int col, f32x4 v) const {
        const float a = v.x * sigmoidf_(v.x) * v.y, b = v.z * sigmoidf_(v.z) * v.w;
        *(unsigned*)(hid + (size_t)row * DEXP + (col >> 1)) = pk2(a, b); } };

template <class Epi>
DEVI void gemm_stage(const bf16_t* A, int lda, const bf16_t* Bt, int ldb, int M, int N, int K, const Epi& epi, char* lds, int bid, int nb,
                     const int* rowidx, const int* blk_e, size_t estride) {
    const int tid = my_tid(), lane = tid & 63, wid = tid >> 6, wr = wid >> 1, wc = wid & 1;
    const int nM = M / 256, nN = (N + 127) / 128, nt = K / 64;
    for (int u = bid; u < nM * nN; u += nb) {
        const int pm = u / nN, pn = u % nN, m0 = pm * 256, n0 = pn * 128;
        const bf16_t* Bu = Bt;
        if (blk_e) { const int e = blk_e[pm]; if (e < 0) continue; Bu = Bt + (size_t)e * estride; }
        const bf16_t* ga[4]; const bf16_t* gb[2]; int offA[4], offB[2];
#pragma unroll
        for (int i = 0; i < 4; ++i) { const int pc = tid + 512 * i, row = pc >> 3, ch = pc & 7;
            int r = m0 + row; if (rowidx) r = rowidx[m0 + row];
            ga[i] = (r >= 0) ? A + (size_t)r * lda + ch * 8 : nullptr; offA[i] = row * 128 + ((ch ^ (row & 7)) << 4); }
#pragma unroll
        for (int i = 0; i < 2; ++i) { const int pc = tid + 512 * i, row = pc >> 3, ch = pc & 7; const int n = n0 + row;
            gb[i] = (n < N) ? Bu + (size_t)n * ldb + ch * 8 : nullptr; offB[i] = row * 128 + ((ch ^ (row & 7)) << 4); }
        u32x4 ra[4], rb[2];
        const u32x4 zero4 = {0u, 0u, 0u, 0u};
#define G_LOAD(kt) do { _Pragma("unroll") for (int i = 0; i < 4; ++i) ra[i] = ga[i] ? *(const u32x4*)(ga[i] + (kt) * 64) : zero4; \
                        _Pragma("unroll") for (int i = 0; i < 2; ++i) rb[i] = gb[i] ? *(const u32x4*)(gb[i] + (kt) * 64) : zero4; } while (0)
#define G_STORE(buf) do { _Pragma("unroll") for (int i = 0; i < 4; ++i) *(u32x4*)(lds + (buf) * 32768 + offA[i]) = ra[i]; \
                          _Pragma("unroll") for (int i = 0; i < 2; ++i) *(u32x4*)(lds + 65536 + (buf) * 16384 + offB[i]) = rb[i]; } while (0)
        f32x4 acc[4][4];
#pragma unroll
        for (int a = 0; a < 4; ++a)
#pragma unroll
            for (int b = 0; b < 4; ++b) acc[a][b] = (f32x4){0.f, 0.f, 0.f, 0.f};
        G_LOAD(0); G_STORE(0); __syncthreads();
        for (int kt = 0; kt < nt; ++kt) {
            const int buf = kt & 1;
            if (kt + 1 < nt) G_LOAD(kt + 1);
            const char* As = lds + buf * 32768; const char* Bs = lds + 65536 + buf * 16384;
#pragma unroll
            for (int kk = 0; kk < 2; ++kk) {
                bf16x8 af[4], bfr[4];
#pragma unroll
                for (int mi = 0; mi < 4; ++mi) { const int row = 64 * wr + 16 * mi + (lane & 15), ch = 4 * kk + (lane >> 4); af[mi] = *(const bf16x8*)(As + row * 128 + ((ch ^ (row & 7)) << 4)); }
#pragma unroll
                for (int ni = 0; ni < 4; ++ni) { const int row = 64 * wc + 16 * ni + (lane & 15), ch = 4 * kk + (lane >> 4); bfr[ni] = *(const bf16x8*)(Bs + row * 128 + ((ch ^ (row & 7)) << 4)); }
#pragma unroll
                for (int mi = 0; mi < 4; ++mi)
#pragma unroll
                    for (int ni = 0; ni < 4; ++ni) acc[mi][ni] = __builtin_amdgcn_mfma_f32_16x16x32_bf16(bfr[ni], af[mi], acc[mi][ni], 0, 0, 0);
            }
            if (kt + 1 < nt) G_STORE(buf ^ 1);
            __syncthreads();
        }
#undef G_LOAD
#undef G_STORE
#pragma unroll
        for (int mi = 0; mi < 4; ++mi)
#pragma unroll
            for (int ni = 0; ni < 4; ++ni) {
                const int row = m0 + 64 * wr + 16 * mi + (lane & 15), col = n0 + 64 * wc + 16 * ni + 4 * (lane >> 4);
                if (col < N) epi(row, col, acc[mi][ni]);
            }
    }
}


namespace pg8 {
#define PG8_LAS __attribute__((address_space(3)))
constexpr int BM = 256, BK = 64, HALF = 128, HTB = HALF * BK * 2, STAGE_BYTES = 8 * HTB, NXCD = 8, WGM = 8;
__host__ __device__ __forceinline__ int lds_byte(int r, int c) { const int st = (r >> 4) * 2 + (c >> 5), rr = r & 15, cc = c & 31, ob = rr * 64 + cc * 2; return st * 1024 + (ob ^ (((ob >> 9) & 1) << 5)); }
__host__ __device__ __forceinline__ void stage_rc(int b, int& R, int& C) { const int st = b / 1024, sb = b % 1024, swz = sb ^ (((sb >> 9) & 1) << 5); R = (st >> 1) * 16 + swz / 64; C = (st & 1) * 32 + (swz % 64) / 2; }
__host__ __device__ __forceinline__ int perm32(int rho) { const int n = rho >> 4, i = rho & 15; return 8 * (i >> 2) + 4 * n + (i & 3); }
struct Unit { int pm, pn, e; };
struct Gemm { const bf16_t* A; const bf16_t* Bt; int M, N, K, lda, ldb; size_t estride; const int* rowidx; };
struct StaticOrder {
    int nM, nN, nwg, G, c; const int* blk_e;
    __device__ void init(int M, int N, int G_, int c_, const int* be = nullptr) { nM = M / BM; nN = N / BM; nwg = nM * nN; G = G_; c = c_; blk_e = be; }
    __device__ bool next(int i, Unit& u) const {
        const long L = (long)i * G + c; if (L >= nwg) return false;
        int wgid = (int)L; { const int q = nwg / NXCD, r = nwg % NXCD, xcd = wgid % NXCD, off = wgid / NXCD; wgid = (xcd < r ? xcd * (q + 1) : r * (q + 1) + (xcd - r) * q) + off; }
        const int nig = WGM * nN, gid = wgid / nig, fm = gid * WGM, gsz = (nM - fm) < WGM ? (nM - fm) : WGM;
        u.pm = fm + ((wgid % nig) % gsz); u.pn = (wgid % nig) / gsz; u.e = blk_e ? blk_e[u.pm] : 0; return true;
    }
    __device__ __forceinline__ void a_ready(const Unit&) const {}
    __device__ __forceinline__ void done(const Unit&) const {}
};
template <class F> struct Epi8 {
    static constexpr bool PERM = true, AFTER_DRAIN = false; F f;
    __device__ __forceinline__ void operator()(const f32x4 (&acc)[2][2][4][2], const Unit& u, int wr, int wc, int fr, int fq) const {
#pragma unroll
        for (int ai = 0; ai < 2; ++ai)
#pragma unroll
            for (int m = 0; m < 4; ++m) { const int row = u.pm * BM + ai * HALF + wr * 64 + m * 16 + fr;
#pragma unroll
                for (int bj = 0; bj < 2; ++bj) f(row, u.pn * BM + bj * HALF + wc * 32 + 8 * fq, acc[ai][bj][m][0], acc[ai][bj][m][1]); }
    }
};
template <class Epi, class Sched, bool ALIGN_EPI = false, bool SP2 = false, bool GATHER = false>
__device__ __forceinline__ void gemm_phase(PG8_LAS unsigned char* lds, const Gemm g, const Sched& S, const Epi& E) {
    const int tid = my_tid(), wid = __builtin_amdgcn_readfirstlane(tid >> 6), lane = tid & 63, wr = wid >> 2, wc = wid & 3, fr = lane & 15, fq = lane >> 4;
    const int K = g.K, nt = K / BK;
    unsigned voffA[2], voffB[2]; int rA[2], cA2[2];
#pragma unroll
    for (int i = 0; i < 2; ++i) { int R, C; stage_rc(tid * 16 + i * 8192, R, C); const int Rb = Epi::PERM ? ((R & ~31) + perm32(R & 31)) : R; rA[i] = R; cA2[i] = C * 2;
        voffA[i] = (unsigned)(R * g.lda + C) * 2u; voffB[i] = (unsigned)(Rb * g.ldb + C) * 2u; }
    unsigned vAc[2][2], vAn[2][2];
#define PG8_VA(dst, pmv) do { _Pragma("unroll") for (int h_ = 0; h_ < 2; ++h_) _Pragma("unroll") for (int i_ = 0; i_ < 2; ++i_) { \
        if constexpr (GATHER) dst[h_][i_] = (unsigned)g.rowidx[(pmv) * BM + h_ * HALF + rA[i_]] * (unsigned)(g.lda * 2) + (unsigned)cA2[i_]; \
        else dst[h_][i_] = voffA[i_] + (unsigned)(h_ * HALF * g.lda * 2); } } while (0)
    const size_t kstep = (size_t)(BK * 2);
    const size_t hstepA = (size_t)HALF * g.lda * 2, hstepB = (size_t)HALF * g.ldb * 2;
    const size_t tstepA = 2 * hstepA, tstepB = 2 * hstepB, estep = g.estride * 2;
    const unsigned ldsw = (unsigned)wid * 1024u;
    const int aoff = lds_byte(wr * 64 + fr, fq * 8), boff = lds_byte(wc * 32 + fr, fq * 8);
#define PG8_SA(b, h) (((b) * 2 + (h)) * HTB)
#define PG8_SB(b, h) ((4 + (b) * 2 + (h)) * HTB)
#define PG8_STAGE(bufoff, gbase, voff) do { _Pragma("unroll") for (int _i = 0; _i < 2; ++_i) \
        __builtin_amdgcn_global_load_lds((const unsigned*)((const char*)(gbase) + (voff)[_i]), (PG8_LAS unsigned*)(lds + (bufoff) + ldsw + _i * 8192), 16, 0, 0); } while (0)
#define PG8_LDA(dst, b, h) do { _Pragma("unroll") for (int m = 0; m < 4; ++m) _Pragma("unroll") for (int k = 0; k < 2; ++k) dst[m][k] = *(const PG8_LAS bf16x8*)(lds + PG8_SA(b, h) + aoff + m * 2048 + k * 1024); } while (0)
#define PG8_LDB(dst, b, h) do { _Pragma("unroll") for (int n = 0; n < 2; ++n) _Pragma("unroll") for (int k = 0; k < 2; ++k) dst[n][k] = *(const PG8_LAS bf16x8*)(lds + PG8_SB(b, h) + boff + n * 2048 + k * 1024); } while (0)
#define PG8_MMA(ai, bj, At, Bt) do { __builtin_amdgcn_s_setprio(1); _Pragma("unroll") for (int m = 0; m < 4; ++m) _Pragma("unroll") for (int n = 0; n < 2; ++n) _Pragma("unroll") for (int k = 0; k < 2; ++k) \
        acc[ai][bj][m][n] = __builtin_amdgcn_mfma_f32_16x16x32_bf16(Bt[n][k], At[m][k], acc[ai][bj][m][n], 0, 0, 0); __builtin_amdgcn_s_setprio(0); } while (0)
#define PG8_WAIT_V(n) asm volatile("s_waitcnt vmcnt(" #n ")" ::: "memory")
#define PG8_WAIT_L(n) asm volatile("s_waitcnt lgkmcnt(" #n ")" ::: "memory")
#define PG8_BAR __builtin_amdgcn_s_barrier()
#define PG8_SCHED __builtin_amdgcn_sched_barrier(0)
    Unit cur, nxt; int ui = 0;
    if (!S.next(0, cur)) return;
    f32x4 acc[2][2][4][2];
#pragma unroll
    for (int a = 0; a < 2; ++a)
#pragma unroll
        for (int b = 0; b < 2; ++b)
#pragma unroll
            for (int m = 0; m < 4; ++m)
#pragma unroll
                for (int n = 0; n < 2; ++n) acc[a][b][m][n] = (f32x4){0.f, 0.f, 0.f, 0.f};
    bf16x8 At[4][2], B0[2][2], B1[2][2];
    const char* cA = (const char*)g.A + (GATHER ? (size_t)0 : (size_t)cur.pm * tstepA); const char* cB = (const char*)g.Bt + (size_t)cur.e * estep + (size_t)cur.pn * tstepB;
    PG8_VA(vAc, cur.pm);
    S.a_ready(cur);
    if constexpr (SP2) {
        PG8_STAGE(PG8_SB(0, 0), cB, voffB); PG8_STAGE(PG8_SB(0, 1), cB + hstepB, voffB); PG8_STAGE(PG8_SA(0, 0), cA, vAc[0]); PG8_STAGE(PG8_SA(0, 1), cA, vAc[1]);
        if (wr == 1) PG8_BAR;
        PG8_WAIT_V(2); PG8_BAR;
        PG8_STAGE(PG8_SB(1, 0), cB + kstep, voffB); PG8_STAGE(PG8_SA(1, 0), cA + kstep, vAc[0]); PG8_STAGE(PG8_SB(1, 1), cB + hstepB + kstep, voffB);
        PG8_WAIT_V(6); PG8_BAR;
    } else {
        PG8_STAGE(PG8_SB(0, 0), cB, voffB); PG8_STAGE(PG8_SA(0, 0), cA, voffA); PG8_STAGE(PG8_SB(0, 1), cB + hstepB, voffB); PG8_STAGE(PG8_SA(0, 1), cA + hstepA, voffA);
        if (wr == 1) PG8_BAR;
        PG8_WAIT_V(4); PG8_BAR;
        PG8_STAGE(PG8_SB(1, 0), cB + kstep, voffB); PG8_STAGE(PG8_SA(1, 0), cA + kstep, voffA); PG8_STAGE(PG8_SB(1, 1), cB + hstepB + kstep, voffB);
        PG8_WAIT_V(6); PG8_BAR;
    }
    for (;;) {
        const bool has_next = S.next(ui + 1, nxt);
        const char* nA = (has_next && !GATHER) ? (const char*)g.A + (size_t)nxt.pm * tstepA : cA; PG8_VA(vAn, (has_next ? nxt.pm : cur.pm)); const char* nB = has_next ? (const char*)g.Bt + (size_t)nxt.e * estep + (size_t)nxt.pn * tstepB : cB;
        for (int t = 0; t < nt; t += 2) {
            const bool last = (t == nt - 2);
            const char* a1 = cA + (size_t)(t + 1) * kstep;
            const char* a2 = last ? nA : cA + (size_t)(t + 2) * kstep; const char* b2 = last ? nB : cB + (size_t)(t + 2) * kstep;
            const char* a3 = a2 + kstep; const char* b3 = b2 + kstep;
            unsigned v2[2][2];
#pragma unroll
            for (int h_ = 0; h_ < 2; ++h_)
#pragma unroll
                for (int i_ = 0; i_ < 2; ++i_) v2[h_][i_] = last ? vAn[h_][i_] : vAc[h_][i_];
            if (last && has_next) S.a_ready(nxt);
            if constexpr (SP2) {
            PG8_LDB(B0, 0, 0); PG8_LDB(B1, 0, 1); PG8_SCHED; PG8_LDA(At, 0, 0); PG8_STAGE(PG8_SA(1, 1), a1, vAc[1]);
            PG8_WAIT_V(8); PG8_WAIT_L(0); PG8_BAR; PG8_MMA(0, 0, At, B0); PG8_MMA(0, 1, At, B1); PG8_BAR; PG8_SCHED;
            PG8_LDA(At, 0, 1); PG8_STAGE(PG8_SB(0, 0), b2, voffB); PG8_STAGE(PG8_SB(0, 1), b2 + hstepB, voffB); PG8_STAGE(PG8_SA(0, 0), a2, v2[0]);
            PG8_WAIT_V(8); PG8_WAIT_L(0); PG8_BAR; PG8_MMA(1, 0, At, B0); PG8_MMA(1, 1, At, B1); PG8_BAR; PG8_SCHED;
            PG8_LDB(B0, 1, 0); PG8_LDB(B1, 1, 1); PG8_SCHED; PG8_LDA(At, 1, 0); PG8_STAGE(PG8_SA(0, 1), a2, v2[1]);
            PG8_WAIT_V(8); PG8_WAIT_L(0); PG8_BAR; PG8_MMA(0, 0, At, B0); PG8_MMA(0, 1, At, B1); PG8_BAR; PG8_SCHED;
            PG8_LDA(At, 1, 1); PG8_STAGE(PG8_SB(1, 0), b3, voffB); PG8_STAGE(PG8_SB(1, 1), b3 + hstepB, voffB); PG8_STAGE(PG8_SA(1, 0), a3, v2[0]);
            PG8_WAIT_V(8); PG8_WAIT_L(0); PG8_BAR; PG8_MMA(1, 0, At, B0); PG8_MMA(1, 1, At, B1); PG8_BAR; PG8_SCHED;
            } else {
            PG8_LDB(B0, 0, 0); PG8_SCHED; PG8_LDA(At, 0, 0); PG8_STAGE(PG8_SA(1, 1), a1 + hstepA, voffA);
            PG8_WAIT_L(8); PG8_BAR; PG8_WAIT_L(0); PG8_MMA(0, 0, At, B0); PG8_BAR; PG8_SCHED;
            PG8_LDB(B1, 0, 1); PG8_STAGE(PG8_SB(0, 0), b2, voffB);
            PG8_BAR; PG8_WAIT_L(0); PG8_MMA(0, 1, At, B1); PG8_BAR;
            PG8_LDA(At, 0, 1); PG8_STAGE(PG8_SA(0, 0), a2, voffA);
            PG8_BAR; PG8_WAIT_L(0); PG8_MMA(1, 0, At, B0); PG8_BAR; PG8_SCHED;
            PG8_STAGE(PG8_SB(0, 1), b2 + hstepB, voffB);
            PG8_WAIT_V(6); PG8_BAR; PG8_MMA(1, 1, At, B1); PG8_BAR;
            PG8_LDB(B0, 1, 0); PG8_SCHED; PG8_LDA(At, 1, 0); PG8_STAGE(PG8_SA(0, 1), a2 + hstepA, voffA);
            PG8_WAIT_L(8); PG8_BAR; PG8_WAIT_L(0); PG8_MMA(0, 0, At, B0); PG8_BAR; PG8_SCHED;
            PG8_LDB(B1, 1, 1); PG8_STAGE(PG8_SB(1, 0), b3, voffB);
            PG8_BAR; PG8_WAIT_L(0); PG8_MMA(0, 1, At, B1); PG8_BAR;
            PG8_LDA(At, 1, 1); PG8_STAGE(PG8_SA(1, 0), a3, voffA);
            PG8_BAR; PG8_WAIT_L(0); PG8_MMA(1, 0, At, B0); PG8_BAR; PG8_SCHED;
            PG8_STAGE(PG8_SB(1, 1), b3 + hstepB, voffB);
            PG8_WAIT_V(6); PG8_BAR; PG8_MMA(1, 1, At, B1); PG8_BAR;
            }
        }
        if constexpr (ALIGN_EPI) { if (wr == 0) PG8_BAR; }
        if constexpr (!Epi::AFTER_DRAIN) { E(acc, cur, wr, wc, fr, fq); S.done(cur); }
        if (!has_next) break;
#pragma unroll
        for (int a = 0; a < 2; ++a)
#pragma unroll
            for (int b = 0; b < 2; ++b)
#pragma unroll
                for (int m = 0; m < 4; ++m)
#pragma unroll
                    for (int n = 0; n < 2; ++n) acc[a][b][m][n] = (f32x4){0.f, 0.f, 0.f, 0.f};
        cur = nxt; cA = nA; cB = nB; ++ui;
#pragma unroll
        for (int h_ = 0; h_ < 2; ++h_)
#pragma unroll
            for (int i_ = 0; i_ < 2; ++i_) vAc[h_][i_] = vAn[h_][i_];
        if constexpr (ALIGN_EPI) { if (wr == 1) PG8_BAR; }
    }
    PG8_WAIT_V(0);
    if constexpr (!ALIGN_EPI) { if (wr == 0) PG8_BAR; }
    PG8_BAR;
    if constexpr (Epi::AFTER_DRAIN) { E.fused(acc, cur, wr, wc, fr, fq, lds, wid, lane); S.done(cur); }
#undef PG8_VA
#undef PG8_SA
#undef PG8_SB
#undef PG8_STAGE
#undef PG8_LDA
#undef PG8_LDB
#undef PG8_MMA
#undef PG8_WAIT_V
#undef PG8_WAIT_L
#undef PG8_BAR
#undef PG8_SCHED
}
}

struct F8Bf16 { bf16_t* out; int ld;
    DEVI void operator()(int row, int col, f32x4 a, f32x4 b) const { u32x4 w; w.x = pk2(a.x, a.y); w.y = pk2(a.z, a.w); w.z = pk2(b.x, b.y); w.w = pk2(b.z, b.w); *(u32x4*)(out + (size_t)row * ld + col) = w; } };
struct F8Resid { const float* x; bf16_t* out;
    DEVI void operator()(int row, int col, f32x4 a, f32x4 b) const { const float* xp = x + (size_t)row * DM + col;
        a = a + *(const f32x4*)xp; b = b + *(const f32x4*)(xp + 4);
        u32x4 w; w.x = pk2(a.x, a.y); w.y = pk2(a.z, a.w); w.z = pk2(b.x, b.y); w.w = pk2(b.z, b.w); *(u32x4*)(out + (size_t)row * DM + col) = w; } };
struct F8Swiglu { bf16_t* hid;
    DEVI void operator()(int row, int col, f32x4 a, f32x4 b) const {
        u32x2 w; w.x = pk2(a.x * sigmoidf_(a.x) * a.y, a.z * sigmoidf_(a.z) * a.w); w.y = pk2(b.x * sigmoidf_(b.x) * b.y, b.z * sigmoidf_(b.z) * b.w);
        *(u32x2*)(hid + (size_t)row * DEXP + (col >> 1)) = w; } };
struct F8Mix { const bf16_t* gl; const bf16_t* bm; bf16_t* mixed; const float* gb;
    DEVI void operator()(int row, int col, f32x4 a, f32x4 b) const {
        const u32x4 g1 = *(const u32x4*)(gl + (size_t)row * 2048 + col), g2 = *(const u32x4*)(gl + (size_t)row * 2048 + 1024 + col);
        const u32x4 m = *(const u32x4*)(bm + (size_t)row * 1024 + col);
        const f32x4 b0a = *(const f32x4*)(gb + col), b0b = *(const f32x4*)(gb + col + 4), b1a = *(const f32x4*)(gb + 1024 + col), b1b = *(const f32x4*)(gb + 1024 + col + 4);
        float r[8];
        r[0] = sigmoidf_(lo16(g1.x) + b0a.x) * lo16(m.x) + sigmoidf_(lo16(g2.x) + b1a.x) * a.x;
        r[1] = sigmoidf_(hi16(g1.x) + b0a.y) * hi16(m.x) + sigmoidf_(hi16(g2.x) + b1a.y) * a.y;
        r[2] = sigmoidf_(lo16(g1.y) + b0a.z) * lo16(m.y) + sigmoidf_(lo16(g2.y) + b1a.z) * a.z;
        r[3] = sigmoidf_(hi16(g1.y) + b0a.w) * hi16(m.y) + sigmoidf_(hi16(g2.y) + b1a.w) * a.w;
        r[4] = sigmoidf_(lo16(g1.z) + b0b.x) * lo16(m.z) + sigmoidf_(lo16(g2.z) + b1b.x) * b.x;
        r[5] = sigmoidf_(hi16(g1.z) + b0b.y) * hi16(m.z) + sigmoidf_(hi16(g2.z) + b1b.y) * b.y;
        r[6] = sigmoidf_(lo16(g1.w) + b0b.z) * lo16(m.w) + sigmoidf_(lo16(g2.w) + b1b.z) * b.z;
        r[7] = sigmoidf_(hi16(g1.w) + b0b.w) * hi16(m.w) + sigmoidf_(hi16(g2.w) + b1b.w) * b.w;
        u32x4 w; w.x = pk2(r[0], r[1]); w.y = pk2(r[2], r[3]); w.z = pk2(r[4], r[5]); w.w = pk2(r[6], r[7]);
        *(u32x4*)(mixed + (size_t)row * 1024 + col) = w; } };
template <class F, bool GATHER = false, bool SP2 = true>
DEVI void big_gemm_(char* lds, const bf16_t* A, int lda, const bf16_t* Bt, int ldb, int M, int N, int K, const F& f, int bid, int nb, const int* blk_e, size_t estride, const int* rowidx) {
    int Kr = K; asm volatile("" : "+s"(Kr));
    pg8::Gemm g{A, Bt, M, N, Kr, lda, ldb, estride, rowidx}; pg8::StaticOrder S; S.init(M, N, nb, bid, blk_e);
    pg8::Epi8<F> E{f};
    pg8::gemm_phase<pg8::Epi8<F>, pg8::StaticOrder, true, SP2, GATHER>((PG8_LAS unsigned char*)lds, g, S, E);
}
template <class F>
DEVI void big_gemm(char* lds, const bf16_t* A, int lda, const bf16_t* Bt, int ldb, int M, int N, int K, const F& f, int bid, int nb, const int* blk_e = nullptr, size_t estride = 0) {
    big_gemm_<F, false>(lds, A, lda, Bt, ldb, M, N, K, f, bid, nb, blk_e, estride, nullptr);
}

DEVI void stage_mla_prep(const Params& p, int bid, int nb, bool dry = false) {
    const int lane = my_tid() & 63, wave = my_tid() >> 6;
    const int gw = bid * NWAVES + wave, NGW = nb * NWAVES;
    bf16_t* z = (bf16_t*)(p.ws + OFF_Z); bf16_t* krope = (bf16_t*)(p.ws + OFF_KROPE);
    const float* ct = (const float*)(p.ws + OFF_ROPE); const float* st = ct + SEQ * 16;
    const float* gq = p.in[3]; const float* gkv = p.in[4];
    for (int t = gw; t < T_; t += NGW) {
        bf16_t* zr = z + (size_t)t * LDZ;
        const u32x4 A = *(const u32x4*)(zr + 8 * lane);
        u32x4 B = {0u, 0u, 0u, 0u}; if (lane < 16) B = *(const u32x4*)(zr + 512 + 8 * lane);
        float a[8], b[8];
        a[0] = lo16(A.x); a[1] = hi16(A.x); a[2] = lo16(A.y); a[3] = hi16(A.y); a[4] = lo16(A.z); a[5] = hi16(A.z); a[6] = lo16(A.w); a[7] = hi16(A.w);
        b[0] = lo16(B.x); b[1] = hi16(B.x); b[2] = lo16(B.y); b[3] = hi16(B.y); b[4] = lo16(B.z); b[5] = hi16(B.z); b[6] = lo16(B.w); b[7] = hi16(B.w);
        float sa = 0.f, sb = 0.f;
#pragma unroll
        for (int j = 0; j < 8; ++j) { sa += a[j] * a[j]; sb += b[j] * b[j]; }
        const bool isq = lane < 48;
        const float ssq = wave_sum(isq ? sa : 0.f), sskv = wave_sum((isq ? 0.f : sa) + sb);
        const float rq = rsqrtf(ssq * (1.f / 384.f) + 1e-6f), rkv = rsqrtf(sskv * (1.f / 256.f) + 1e-6f);
        {
            const float r = isq ? rq : rkv; const float* g = isq ? gq + 8 * lane : gkv + 8 * (lane - 48);
            u32x4 o; o.x = pk2(a[0] * r * g[0], a[1] * r * g[1]); o.y = pk2(a[2] * r * g[2], a[3] * r * g[3]); o.z = pk2(a[4] * r * g[4], a[5] * r * g[5]); o.w = pk2(a[6] * r * g[6], a[7] * r * g[7]);
            if (!dry) *(u32x4*)(zr + 8 * lane) = o; else asm volatile("" :: "v"(o));
        }
        if (lane < 16) {
            const float* g = gkv + 8 * (lane + 16);
            u32x4 o; o.x = pk2(b[0] * rkv * g[0], b[1] * rkv * g[1]); o.y = pk2(b[2] * rkv * g[2], b[3] * rkv * g[3]); o.z = pk2(b[4] * rkv * g[4], b[5] * rkv * g[5]); o.w = pk2(b[6] * rkv * g[6], b[7] * rkv * g[7]);
            if (!dry) *(u32x4*)(zr + 512 + 8 * lane) = o; else asm volatile("" :: "v"(o));
        }
    }
    const bf16_t* hb = (const bf16_t*)(p.ws + OFF_H); const bf16_t* wkr = (const bf16_t*)(p.ws + OFF_WKR);
    for (int tb = gw * 16; tb < T_; tb += NGW * 16) {
        const int li = lane & 15, kq = lane >> 4;
        const bf16_t* ap = hb + (size_t)(tb + li) * DM + 8 * kq; const bf16_t* b0p = wkr + (size_t)li * DM + 8 * kq; const bf16_t* b1p = b0p + 16 * DM;
        f32x4 a0 = {0.f, 0.f, 0.f, 0.f}, a1 = a0;
#pragma unroll 8
        for (int ks = 0; ks < 32; ++ks) {
            const bf16x8 av = *(const bf16x8*)(ap + 32 * ks);
            a0 = __builtin_amdgcn_mfma_f32_16x16x32_bf16(av, *(const bf16x8*)(b0p + 32 * ks), a0, 0, 0, 0);
            a1 = __builtin_amdgcn_mfma_f32_16x16x32_bf16(av, *(const bf16x8*)(b1p + 32 * ks), a1, 0, 0, 0);
        }
#pragma unroll
        for (int r = 0; r < 4; ++r) { const int t = tb + 4 * kq + r, pos = t & (SEQ - 1);
            const float c = ct[pos * 16 + li], s = st[pos * 16 + li];
            if (!dry) { krope[(size_t)t * 32 + li] = (bf16_t)f2bf(a0[r] * c - a1[r] * s); krope[(size_t)t * 32 + 16 + li] = (bf16_t)f2bf(a0[r] * s + a1[r] * c); } }
    }
}

DEVI void stage_sg_prep(const Params& p, int bid, int nb) {
    const bf16_t* z = (const bf16_t*)(p.ws + OFF_Z); bf16_t* sg = (bf16_t*)(p.ws + OFF_SG);
    const float* mup = p.in[8] + 1792; const float* mun = p.in[9] + 1792;
    for (int i = bid * NTHREADS + my_tid(); i < T_ * 32; i += nb * NTHREADS) {
        const int t = i >> 5, c = (i & 31) * 8, s = t & (SEQ - 1);
        u32x4 o = {0u, 0u, 0u, 0u};
        if (c < 128) {
            const bf16_t* zp = z + (size_t)t * LDZ + ZR + 1792 + c;
            const u32x4 z4 = {0u, 0u, 0u, 0u};
            const u32x4 w0 = *(const u32x4*)zp, wm = (s > 0) ? *(const u32x4*)(zp - LDZ) : z4, wn = (s < SEQ - 1) ? *(const u32x4*)(zp + LDZ) : z4;
            const float z0[8] = {lo16(w0.x), hi16(w0.x), lo16(w0.y), hi16(w0.y), lo16(w0.z), hi16(w0.z), lo16(w0.w), hi16(w0.w)};
            const float zm[8] = {lo16(wm.x), hi16(wm.x), lo16(wm.y), hi16(wm.y), lo16(wm.z), hi16(wm.z), lo16(wm.w), hi16(wm.w)};
            const float zn[8] = {lo16(wn.x), hi16(wn.x), lo16(wn.y), hi16(wn.y), lo16(wn.z), hi16(wn.z), lo16(wn.w), hi16(wn.w)};
            float r[8];
#pragma unroll
            for (int j = 0; j < 8; ++j) r[j] = sigmoidf_(z0[j] + mup[c + j] * (zm[j] - z0[j]) + mun[c + j] * (zn[j] - z0[j]));
            o.x = pk2(r[0], r[1]); o.y = pk2(r[2], r[3]); o.z = pk2(r[4], r[5]); o.w = pk2(r[6], r[7]);
        }
        *(u32x4*)(sg + (size_t)t * 256 + c) = o;
    }
}

DEVI float max3f_(float a, float b, float c) { return __builtin_fmaxf(__builtin_fmaxf(a, b), c); }
constexpr int KROW = 208, VROW = 192;
constexpr int ATT_KB = 64 * KROW, ATT_VB = 64 * VROW;
DEVI void attn_unit(const Params& p, int u, char* lds) {
    const int tid = my_tid(), lane = tid & 63, wid = tid >> 6, r32 = lane & 31, hi = lane >> 5;
    const int bh = u >> 3, qb = u & 7, b = bh >> 3, h = bh & 7;
    const bf16_t* qraw = (const bf16_t*)((const char*)p.out + DOFF_QRAW);
    const bf16_t* kvraw = (const bf16_t*)((const char*)p.out + DOFF_KVRAW);
    const bf16_t* krope = (const bf16_t*)(p.ws + OFF_KROPE);
    const float* ct = (const float*)(p.ws + OFF_ROPE); const float* st = ct + SEQ * 16;
    bf16_t* omla = (bf16_t*)(p.ws + OFF_OMLA);
    const size_t rowb = (size_t)b * SEQ;
    const int sq = qb * 256 + wid * 32 + r32;
    const float QS = 0.10206207261596577f * 1.4426950408889634f;
    bf16x8 qf[6];
    {
        const bf16_t* qp = qraw + (rowb + sq) * 768 + h * 96;
        u32x4 w[6];
#pragma unroll
        for (int ks = 0; ks < 6; ++ks) w[ks] = *(const u32x4*)(qp + 16 * ks + 8 * hi);
#pragma unroll
        for (int ks = 0; ks < 4; ++ks) {
            u32x4 o; o.x = pk2(lo16(w[ks].x) * QS, hi16(w[ks].x) * QS); o.y = pk2(lo16(w[ks].y) * QS, hi16(w[ks].y) * QS);
            o.z = pk2(lo16(w[ks].z) * QS, hi16(w[ks].z) * QS); o.w = pk2(lo16(w[ks].w) * QS, hi16(w[ks].w) * QS);
            qf[ks] = __builtin_bit_cast(bf16x8, o);
        }
        float x1[8], x2[8], y1[8], y2[8];
        x1[0] = lo16(w[4].x); x1[1] = hi16(w[4].x); x1[2] = lo16(w[4].y); x1[3] = hi16(w[4].y); x1[4] = lo16(w[4].z); x1[5] = hi16(w[4].z); x1[6] = lo16(w[4].w); x1[7] = hi16(w[4].w);
        x2[0] = lo16(w[5].x); x2[1] = hi16(w[5].x); x2[2] = lo16(w[5].y); x2[3] = hi16(w[5].y); x2[4] = lo16(w[5].z); x2[5] = hi16(w[5].z); x2[6] = lo16(w[5].w); x2[7] = hi16(w[5].w);
#pragma unroll
        for (int j = 0; j < 8; ++j) { const float c = ct[sq * 16 + 8 * hi + j], s = st[sq * 16 + 8 * hi + j]; y1[j] = (x1[j] * c - x2[j] * s) * QS; y2[j] = (x1[j] * s + x2[j] * c) * QS; }
        u32x4 o4, o5;
        o4.x = pk2(y1[0], y1[1]); o4.y = pk2(y1[2], y1[3]); o4.z = pk2(y1[4], y1[5]); o4.w = pk2(y1[6], y1[7]);
        o5.x = pk2(y2[0], y2[1]); o5.y = pk2(y2[2], y2[3]); o5.z = pk2(y2[4], y2[5]); o5.w = pk2(y2[6], y2[7]);
        qf[4] = __builtin_bit_cast(bf16x8, o4); qf[5] = __builtin_bit_cast(bf16x8, o5);
    }
    const int kp0r = tid / 12, kp0c = tid % 12;
    const int kp1 = 512 + tid, kp1r = kp1 / 12, kp1c = kp1 % 12;
    const int vr = tid >> 3, vc = tid & 7;
    u32x4 rk0, rk1, rv;
#define A_LOAD(t) do { const size_t base = rowb + (size_t)(t) * 64; \
        rk0 = (kp0c < 8) ? *(const u32x4*)(kvraw + (base + kp0r) * 1024 + h * 128 + 8 * kp0c) : *(const u32x4*)(krope + (base + kp0r) * 32 + 8 * (kp0c - 8)); \
        if (tid < 256) rk1 = (kp1c < 8) ? *(const u32x4*)(kvraw + (base + kp1r) * 1024 + h * 128 + 8 * kp1c) : *(const u32x4*)(krope + (base + kp1r) * 32 + 8 * (kp1c - 8)); \
        rv = *(const u32x4*)(kvraw + (base + vr) * 1024 + h * 128 + 64 + 8 * vc); } while (0)
#define A_STORE(buf) do { char* Kb_ = lds + (buf) * ATT_KB; char* Vb_ = lds + 2 * ATT_KB + (buf) * ATT_VB; \
        *(u32x4*)(Kb_ + kp0r * KROW + kp0c * 16) = rk0; if (tid < 256) *(u32x4*)(Kb_ + kp1r * KROW + kp1c * 16) = rk1; \
        *(u32x4*)(Vb_ + vr * VROW + vc * 16) = rv; } while (0)
    float mhat = 0.f, l = 0.f;
    f32x16 o0, o1, negm;
#pragma unroll
    for (int r = 0; r < 16; ++r) { o0[r] = 0.f; o1[r] = 0.f; negm[r] = 0.f; }
    A_LOAD(0); A_STORE(0); __syncthreads();
    constexpr int NT = SEQ / 64;
    for (int t = 0; t < NT; ++t) {
        const int buf = t & 1;
        if (t + 1 < NT) A_LOAD(t + 1);
        const char* Kb = lds + buf * ATT_KB; const char* Vb = lds + 2 * ATT_KB + buf * ATT_VB;
        f32x16 p0 = negm, p1 = negm;
#pragma unroll
        for (int ks = 0; ks < 6; ++ks) {
            const bf16x8 k0 = *(const bf16x8*)(Kb + r32 * KROW + 32 * ks + 16 * hi);
            const bf16x8 k1 = *(const bf16x8*)(Kb + (32 + r32) * KROW + 32 * ks + 16 * hi);
            p0 = __builtin_amdgcn_mfma_f32_32x32x16_bf16(k0, qf[ks], p0, 0, 0, 0);
            p1 = __builtin_amdgcn_mfma_f32_32x32x16_bf16(k1, qf[ks], p1, 0, 0, 0);
        }
        float mxa = max3f_(p0[0], p0[1], p1[0]), mxb = max3f_(p0[2], p0[3], p1[1]); mxa = max3f_(mxa, p1[2], p1[3]);
#pragma unroll
        for (int r = 4; r < 16; r += 4) { mxa = max3f_(mxa, p0[r], p0[r + 1]); mxb = max3f_(mxb, p0[r + 2], p0[r + 3]); mxa = max3f_(mxa, p1[r], p1[r + 1]); mxb = max3f_(mxb, p1[r + 2], p1[r + 3]); }
        float rm = max3f_(mxa, mxb, mxb); rm = max3f_(rm, __shfl_xor(rm, 32), rm);
        if (t == 0 || __any(rm > 8.f)) {
            const float dl = (t == 0) ? rm : fmaxf(rm, 0.f); mhat += dl;
            const float f = __builtin_amdgcn_exp2f(-dl); l *= f;
#pragma unroll
            for (int r = 0; r < 16; ++r) { p0[r] -= dl; p1[r] -= dl; o0[r] *= f; o1[r] *= f; negm[r] = -mhat; }
        }
        float sum = 0.f;
#pragma unroll
        for (int r = 0; r < 16; ++r) { p0[r] = __builtin_amdgcn_exp2f(p0[r]); p1[r] = __builtin_amdgcn_exp2f(p1[r]); sum += p0[r] + p1[r]; }
        l += sum;
        bf16x8 pb[4];
        {
            u32x4 w;
            w.x = pk2(p0[0], p0[1]); w.y = pk2(p0[2], p0[3]); w.z = pk2(p0[4], p0[5]); w.w = pk2(p0[6], p0[7]); pb[0] = __builtin_bit_cast(bf16x8, w);
            w.x = pk2(p0[8], p0[9]); w.y = pk2(p0[10], p0[11]); w.z = pk2(p0[12], p0[13]); w.w = pk2(p0[14], p0[15]); pb[1] = __builtin_bit_cast(bf16x8, w);
            w.x = pk2(p1[0], p1[1]); w.y = pk2(p1[2], p1[3]); w.z = pk2(p1[4], p1[5]); w.w = pk2(p1[6], p1[7]); pb[2] = __builtin_bit_cast(bf16x8, w);
            w.x = pk2(p1[8], p1[9]); w.y = pk2(p1[10], p1[11]); w.z = pk2(p1[12], p1[13]); w.w = pk2(p1[14], p1[15]); pb[3] = __builtin_bit_cast(bf16x8, w);
        }
#pragma unroll
        for (int s = 0; s < 4; ++s) {
            const char* vtp = Vb + (16 * s + 4 * hi + ((lane & 15) >> 2)) * VROW + (16 * ((lane >> 4) & 1) + 4 * (lane & 3)) * 2;
            const s16x4 a0 = vtr_(vtp), a1 = vtr_(vtp + 8 * VROW);
            const s16x4 c0 = vtr_(vtp + 64), c1 = vtr_(vtp + 8 * VROW + 64);
            const bf16x8 va0 = {a0[0], a0[1], a0[2], a0[3], a1[0], a1[1], a1[2], a1[3]};
            const bf16x8 va1 = {c0[0], c0[1], c0[2], c0[3], c1[0], c1[1], c1[2], c1[3]};
            o0 = __builtin_amdgcn_mfma_f32_32x32x16_bf16(va0, pb[s], o0, 0, 0, 0);
            o1 = __builtin_amdgcn_mfma_f32_32x32x16_bf16(va1, pb[s], o1, 0, 0, 0);
        }
        if (t + 1 < NT) A_STORE(buf ^ 1);
        __syncthreads();
    }
#undef A_LOAD
#undef A_STORE
    l += __shfl_xor(l, 32);
    const float inv = 1.f / l;
    bf16_t* op = omla + (rowb + sq) * 512 + h * 64;
#pragma unroll
    for (int g = 0; g < 4; ++g) {
        const int d0 = 8 * g + 4 * hi;
        u32x2 w; w.x = pk2(o0[4 * g] * inv, o0[4 * g + 1] * inv); w.y = pk2(o0[4 * g + 2] * inv, o0[4 * g + 3] * inv);
        *(u32x2*)(op + d0) = w;
        w.x = pk2(o1[4 * g] * inv, o1[4 * g + 1] * inv); w.y = pk2(o1[4 * g + 2] * inv, o1[4 * g + 3] * inv);
        *(u32x2*)(op + 32 + d0) = w;
    }
}

typedef _Float16 f16x4 __attribute__((ext_vector_type(4)));
typedef _Float16 f16x8 __attribute__((ext_vector_type(8)));
DEVI float dppx1(float x) { return __int_as_float(__builtin_amdgcn_update_dpp(0, __float_as_int(x), 0xB1, 0xF, 0xF, false)); }
DEVI float dppx2(float x) { return __int_as_float(__builtin_amdgcn_update_dpp(0, __float_as_int(x), 0x4E, 0xF, 0xF, false)); }
DEVI float dpphm(float x) { return __int_as_float(__builtin_amdgcn_update_dpp(0, __float_as_int(x), 0x141, 0xF, 0xF, false)); }
DEVI float red8(float x) { x += dppx1(x); x += dppx2(x); x += dpphm(x); return x; }
DEVI float fmix_lo(float a, unsigned h, float c) { float d; asm("v_fma_mix_f32 %0, %1, %2, %3 op_sel_hi:[0,1,0]" : "=v"(d) : "v"(a), "v"(h), "v"(c)); return d; }
DEVI float fmix_hi(float a, unsigned h, float c) { float d; asm("v_fma_mix_f32 %0, %1, %2, %3 op_sel:[0,1,0] op_sel_hi:[0,1,0]" : "=v"(d) : "v"(a), "v"(h), "v"(c)); return d; }
DEVI float mmix_lo(float a, unsigned h) { float d; asm("v_fma_mix_f32 %0, %1, %2, 0 op_sel_hi:[0,1,0]" : "=v"(d) : "v"(a), "v"(h)); return d; }
DEVI float mmix_hi(float a, unsigned h) { float d; asm("v_fma_mix_f32 %0, %1, %2, 0 op_sel:[0,1,0] op_sel_hi:[0,1,0]" : "=v"(d) : "v"(a), "v"(h)); return d; }
DEVI float fmix2_lo(unsigned v, unsigned h, float c) { float d; asm("v_fma_mix_f32 %0, %1, %2, %3 op_sel_hi:[1,1,0]" : "=v"(d) : "v"(v), "v"(h), "v"(c)); return d; }
DEVI float fmix2_hi(unsigned v, unsigned h, float c) { float d; asm("v_fma_mix_f32 %0, %1, %2, %3 op_sel:[0,1,0] op_sel_hi:[1,1,0]" : "=v"(d) : "v"(v), "v"(h), "v"(c)); return d; }
DEVI float fmix_h0(unsigned hv, float b, float c) { float d; asm("v_fma_mix_f32 %0, %1, %2, %3 op_sel_hi:[1,0,0]" : "=v"(d) : "v"(hv), "v"(b), "v"(c)); return d; }
DEVI void unpack8(const u32x4 w, float (&f)[8]) { f[0] = lo16(w.x); f[1] = hi16(w.x); f[2] = lo16(w.y); f[3] = hi16(w.y); f[4] = lo16(w.z); f[5] = hi16(w.z); f[6] = lo16(w.w); f[7] = hi16(w.w); }
DEVI u32x4 pack8(const float (&f)[8]) { u32x4 w; w.x = pk2(f[0], f[1]); w.y = pk2(f[2], f[3]); w.z = pk2(f[4], f[5]); w.w = pk2(f[6], f[7]); return w; }
DEVI u32x4 pack8h(const float (&f)[8]) { f16x8 h;
#pragma unroll
    for (int j = 0; j < 8; ++j) h[j] = (_Float16)f[j];
    return __builtin_bit_cast(u32x4, h); }
constexpr int SLOT = 9216;
constexpr int SL_AT = 0, SL_BT = 1, SL_KT = 2, SL_RT = 3, SL_VT = 4, SL_BH = 5, SL_KH = 6, SL_S0 = 7, SL_MOFF = 8, SL_MOFFT = 9, SL_MAK = 10, SL_LRB = 11, SL_LRK = 12;
constexpr int SL_DD = 1, SL_DDT = 2, SL_N = 10, SL_NT = 12, SL_N2 = 6, SL_W1T = 8, SL_W1 = 9, SL_T = 4, SL_RHST = 1, SL_UT = 2;
constexpr int L_G = 8 * SLOT;
constexpr int L_TW = 10 * SLOT, L_AD = 11 * SLOT;
constexpr int L_ATMP = 12 * SLOT;
constexpr int L_FD = 13 * SLOT;
constexpr int L_C = L_FD + 8 * 272 * 4;
constexpr int L_SEG = L_C + (896 + 320) * 4;
constexpr int L_CHAIN_END = L_SEG + 8 * 64 * 4;
static_assert(L_CHAIN_END <= 147200, "chain LDS");
DEVI f32x16 mm_tile(f32x16 acc, const char* Yt, const char* Xt, int jt, int it, int r32, int hi) {
    const char* yp = Yt + (32 * jt + r32) * 144 + 16 * hi; const char* xp = Xt + (32 * it + r32) * 144 + 16 * hi;
#pragma unroll
    for (int ks = 0; ks < 4; ++ks) acc = __builtin_amdgcn_mfma_f32_32x32x16_bf16(*(const bf16x8*)(xp + 32 * ks), *(const bf16x8*)(yp + 32 * ks), acc, 0, 0, 0);
    return acc;
}
DEVI bf16x8 frag_tr(const char* T, int col0, int ks, int lane, int hi) {
    const char* p = T + (16 * ks + 8 * hi + ((lane & 15) >> 2)) * 144 + (col0 + 16 * ((lane >> 4) & 1) + 4 * (lane & 3)) * 2;
    const s16x4 a = vtr_(p), b = vtr_(p + 4 * 144);
    return (bf16x8){a[0], a[1], a[2], a[3], b[0], b[1], b[2], b[3]};
}
template <bool YT, bool XT>
DEVI f32x16 mm_tile2(f32x16 acc, const char* Yt, const char* Xt, int jt, int it, int lane, int r32, int hi) {
#pragma unroll
    for (int ks = 0; ks < 4; ++ks) {
        const bf16x8 yf = YT ? frag_tr(Yt, 32 * jt, ks, lane, hi) : *(const bf16x8*)(Yt + (32 * jt + r32) * 144 + 16 * hi + 32 * ks);
        const bf16x8 xf = XT ? frag_tr(Xt, 32 * it, ks, lane, hi) : *(const bf16x8*)(Xt + (32 * it + r32) * 144 + 16 * hi + 32 * ks);
        acc = __builtin_amdgcn_mfma_f32_32x32x16_bf16(xf, yf, acc, 0, 0, 0);
    }
    return acc;
}
template <class M> DEVI void st_tile(char* Ot, int jt, int it, int r32, int hi, const f32x16& acc, M mask) {
    const int row = 32 * jt + r32;
#pragma unroll
    for (int g = 0; g < 4; ++g) { const int c0 = 32 * it + 8 * g + 4 * hi;
        u32x2 w; w.x = pk2(mask(row, c0) ? acc[4 * g] : 0.f, mask(row, c0 + 1) ? acc[4 * g + 1] : 0.f); w.y = pk2(mask(row, c0 + 2) ? acc[4 * g + 2] : 0.f, mask(row, c0 + 3) ? acc[4 * g + 3] : 0.f);
        *(u32x2*)(Ot + row * 144 + c0 * 2) = w; }
}
DEVI f32x16 zero16() { f32x16 z;
#pragma unroll
    for (int r = 0; r < 16; ++r) z[r] = 0.f;
    return z; }
DEVI void chain_unit(const Params& p, int unit, char* lds) {
    const int tid0 = my_tid(); const int tid = tid0;
    const int dir = unit & 1, bh = unit >> 1, b = bh >> 3, h = bh & 7;
    const bool fwd = (dir == 0);
    const bf16_t* z = (const bf16_t*)(p.ws + OFF_Z);
    bf16_t* yout = (bf16_t*)(p.ws + (dir ? OFF_YB : OFF_YF));
    bf16_t* vout = (bf16_t*)(p.ws + OFF_VS);
    float* sout = (float*)(p.ws + OFF_SDIR) + (size_t)dir * T_ * 8;
    const size_t rowb = (size_t)b * SEQ;
    float* Cc = (float*)(lds + L_C);
    for (int i = tid; i < 448; i += NTHREADS) {
        int gi;
        if (i < 192) gi = (i >> 6) * 512 + h * 64 + (i & 63); else if (i < 256) gi = 1536 + dir * 64 + (i - 192); else if (i < 320) gi = 1664 + dir * 64 + (i - 256); else gi = 1792 + (i - 320);
        Cc[i] = p.in[8][gi]; Cc[448 + i] = p.in[9][gi];
    }
    if (tid < 64) { const int c = h * 64 + tid; Cc[896 + tid] = p.in[15][c]; Cc[960 + tid] = p.in[16][c]; Cc[1024 + tid] = p.in[17][c]; Cc[1088 + tid] = p.in[10][dir * 512 + c]; Cc[1152 + tid] = p.in[12][dir * 512 + c]; }
    for (int i = tid; i < SLOT / 16; i += NTHREADS) ((u32x4*)(lds + SL_S0 * SLOT))[i] = (u32x4){0u, 0u, 0u, 0u};
    bf16x8 wf[4];
    {
        const int lane = tid & 63, wid = __builtin_amdgcn_readfirstlane(tid >> 6), r32 = lane & 31, hi = lane >> 5, nt = (wid >> 1) & 1;
        const bf16_t* wsrc = (const bf16_t*)(p.ws + (wid < 4 ? OFF_WUP : OFF_AUP)) + ((size_t)dir * 512 + h * 64 + 32 * nt + r32) * 64 + 8 * hi;
#pragma unroll
        for (int ks = 0; ks < 4; ++ks) wf[ks] = *(const bf16x8*)(wsrc + 16 * ks);
    }
    u32x4 zl[5][3];
#define C_LOAD(c) do { const int t0_ = dir ? (SEQ - 64 * ((c) + 1)) : 64 * (c); const int ts_ = t0_ + tt; const bf16_t* zp_ = z + (rowb + ts_) * LDZ + ZR; \
        const bool hp_ = ts_ > 0, hn_ = ts_ < SEQ - 1; const u32x4 z4_ = {0u, 0u, 0u, 0u}; \
        _Pragma("unroll") for (int sg = 0; sg < 5; ++sg) { const int co_ = (sg < 3) ? (sg * 512 + h * 64 + 8 * c8) : (sg == 3 ? 1536 + dir * 64 + 8 * c8 : 1664 + dir * 64 + 8 * c8); \
            zl[sg][1] = *(const u32x4*)(zp_ + co_); zl[sg][0] = hp_ ? *(const u32x4*)(zp_ + co_ - LDZ) : z4_; zl[sg][2] = hn_ ? *(const u32x4*)(zp_ + co_ + LDZ) : z4_; } \
        } while (0)
#define SHIFT8(dst, regs, mi) do { float z0_[8], zm_[8], zn_[8]; unpack8(regs[1], z0_); unpack8(regs[0], zm_); unpack8(regs[2], zn_); \
        const f32x4 mpa_ = *(const f32x4*)(Cc + (mi)), mpb_ = *(const f32x4*)(Cc + (mi) + 4), mna_ = *(const f32x4*)(Cc + 448 + (mi)), mnb_ = *(const f32x4*)(Cc + 448 + (mi) + 4); \
        const float mp_[8] = {mpa_.x, mpa_.y, mpa_.z, mpa_.w, mpb_.x, mpb_.y, mpb_.z, mpb_.w}, mn_[8] = {mna_.x, mna_.y, mna_.z, mna_.w, mnb_.x, mnb_.y, mnb_.z, mnb_.w}; \
        _Pragma("unroll") for (int j = 0; j < 8; ++j) dst[j] = z0_[j] + mp_[j] * (zm_[j] - z0_[j]) + mn_[j] * (zn_[j] - z0_[j]); } while (0)
    f32x16 state = zero16();
    __syncthreads();
    { const int tt = tid >> 3, c8 = tid & 7; C_LOAD(0); }
    for (int c = 0; c < SEQ / 64; ++c) {
        int tid = tid0; asm volatile("" : "+v"(tid));
        const int lane = tid & 63, wid = __builtin_amdgcn_readfirstlane(tid >> 6), r32 = lane & 31, hi = lane >> 5;
        const int nt = (wid >> 1) & 1, tt2 = wid & 1, pj = nt, pi = tt2;
        const int tt = tid >> 3, c8 = tid & 7;
        const int sp = dir ? 63 - tt : tt;
        const int t0 = dir ? (SEQ - 64 * (c + 1)) : 64 * c;
        float r8[8], k8[8], v8[8], kk8[8];
        {
            float wd8[8], ad8[8];
            SHIFT8(r8, zl[0], 8 * c8); SHIFT8(k8, zl[1], 64 + 8 * c8); SHIFT8(v8, zl[2], 128 + 8 * c8); SHIFT8(wd8, zl[3], 192 + 8 * c8); SHIFT8(ad8, zl[4], 256 + 8 * c8);
#pragma unroll
            for (int j = 0; j < 8; ++j) wd8[j] = 1.f - 2.f * __builtin_amdgcn_rcpf(1.f + __expf(2.f * wd8[j]));
            *(u32x4*)(lds + L_TW + tt * 144 + c8 * 16) = pack8(wd8);
            *(u32x4*)(lds + L_AD + tt * 144 + c8 * 16) = pack8(ad8);
            float ss = 0.f;
#pragma unroll
            for (int j = 0; j < 8; ++j) { kk8[j] = k8[j] * Cc[896 + 8 * c8 + j]; ss += kk8[j] * kk8[j]; }
            ss = red8(ss);
            const float inv = 1.f / fmaxf(sqrtf(ss), 1e-12f);
#pragma unroll
            for (int j = 0; j < 8; ++j) kk8[j] *= inv;
        }
        __syncthreads();
        {
            f32x16 acc = zero16();
            const char* xt = lds + (wid < 4 ? L_TW : L_AD) + (32 * tt2 + r32) * 144 + 16 * hi;
#pragma unroll
            for (int ks = 0; ks < 4; ++ks) acc = __builtin_amdgcn_mfma_f32_32x32x16_bf16(wf[ks], *(const bf16x8*)(xt + 32 * ks), acc, 0, 0, 0);
            const int tl = 32 * tt2 + r32;
            if (wid < 4) {
                const int sl = dir ? 63 - tl : tl;
#pragma unroll
                for (int g = 0; g < 4; ++g) { const int n0 = 32 * nt + 8 * g + 4 * hi; f32x4 o;
#pragma unroll
                    for (int q = 0; q < 4; ++q) o[q] = -0.6065306597126334f * sigmoidf_(acc[4 * g + q] + Cc[1088 + n0 + q]);
                    *(f32x4*)(lds + L_G + sl * 256 + n0 * 4) = o; }
            } else {
#pragma unroll
                for (int g = 0; g < 4; ++g) { const int n0 = 32 * nt + 8 * g + 4 * hi; f16x4 o;
#pragma unroll
                    for (int q = 0; q < 4; ++q) o[q] = (_Float16)sigmoidf_(acc[4 * g + q] + Cc[1152 + n0 + q]);
                    *(f16x4*)(lds + L_ATMP + tl * 128 + n0 * 2) = o; }
            }
        }
        __syncthreads();
        float kd8[8], b8[8];
        {
            const f16x8 ah = *(const f16x8*)(lds + L_ATMP + tt * 128 + c8 * 16);
            float sp_ = 0.f;
#pragma unroll
            for (int j = 0; j < 8; ++j) { const float a = (float)ah[j];
                kd8[j] = k8[j] * (1.f + (a - 1.f) * Cc[960 + 8 * c8 + j]); b8[j] = kk8[j] * a; sp_ += r8[j] * kd8[j] * Cc[1024 + 8 * c8 + j]; }
            sp_ = red8(sp_);
            if (c8 == 0) sout[(rowb + t0 + tt) * 8 + h] = sp_;
            if (fwd) *(u32x4*)(vout + (rowb + t0 + tt) * 512 + h * 64 + 8 * c8) = pack8(v8);
            const int n = tid & 63, seg = tid >> 6; float* gp = (float*)(lds + L_G) + (8 * seg) * 64 + n; float run = 0.f;
#pragma unroll
            for (int q = 0; q < 8; ++q) { run += gp[q * 64]; gp[q * 64] = run; }
            ((float*)(lds + L_SEG))[seg * 64 + n] = run;
        }
        __syncthreads();
        {
            const int n = tid & 63, seg = tid >> 6; float off = 0.f;
            for (int q = 0; q < seg; ++q) off += ((const float*)(lds + L_SEG))[q * 64 + n];
            float* gp = (float*)(lds + L_G) + (8 * seg) * 64 + n;
#pragma unroll
            for (int q = 0; q < 8; ++q) gp[q * 64] += off;
        }
        __syncthreads();
        {
            const float* G = (const float*)(lds + L_G);
            const f32x4 ga = *(const f32x4*)(G + sp * 64 + 8 * c8), gb = *(const f32x4*)(G + sp * 64 + 8 * c8 + 4);
            const f32x4 ha = *(const f32x4*)(G + 63 * 64 + 8 * c8), hb = *(const f32x4*)(G + 63 * 64 + 8 * c8 + 4);
            f32x4 pa = {0.f, 0.f, 0.f, 0.f}, pb = pa;
            if (sp > 0) { pa = *(const f32x4*)(G + (sp - 1) * 64 + 8 * c8); pb = *(const f32x4*)(G + (sp - 1) * 64 + 8 * c8 + 4); }
            const float gs[8] = {ga.x, ga.y, ga.z, ga.w, gb.x, gb.y, gb.z, gb.w}, gm[8] = {pa.x, pa.y, pa.z, pa.w, pb.x, pb.y, pb.z, pb.w}, gl[8] = {ha.x, ha.y, ha.z, ha.w, hb.x, hb.y, hb.z, hb.w};
            {
                float at_[8], rt_[8];
#pragma unroll
                for (int j = 0; j < 8; ++j) { at_[j] = -kk8[j] * __expf(gm[j]); rt_[j] = r8[j] * __expf(gs[j]); }
                *(u32x4*)(lds + SL_AT * SLOT + sp * 144 + c8 * 16) = pack8(at_); *(u32x4*)(lds + SL_RT * SLOT + sp * 144 + c8 * 16) = pack8(rt_);
            }
            {
                float bt_[8], kt_[8];
#pragma unroll
                for (int j = 0; j < 8; ++j) { const float en = __expf(-gs[j]); bt_[j] = b8[j] * en; kt_[j] = kd8[j] * en; }
                *(u32x4*)(lds + SL_BT * SLOT + sp * 144 + c8 * 16) = pack8(bt_); *(u32x4*)(lds + SL_KT * SLOT + sp * 144 + c8 * 16) = pack8(kt_);
            }
            {
                float bh_[8], kh_[8];
#pragma unroll
                for (int j = 0; j < 8; ++j) { const float eh = __expf(gl[j] - gs[j]); bh_[j] = b8[j] * eh; kh_[j] = kd8[j] * eh; }
                *(u32x4*)(lds + SL_VT * SLOT + sp * 144 + c8 * 16) = pack8(v8);
                *(u32x4*)(lds + SL_BH * SLOT + sp * 144 + c8 * 16) = pack8(bh_); *(u32x4*)(lds + SL_KH * SLOT + sp * 144 + c8 * 16) = pack8(kh_);
            }
            if (tid < 64) ((float*)(lds + L_SEG))[tid] = __expf(G[63 * 64 + tid]);
        }
        __syncthreads();
        {
            const char* ATt = lds + SL_AT * SLOT; const char* RTt = lds + SL_RT * SLOT;
            f32x16 acc = mm_tile(zero16(), ATt, lds + (wid < 4 ? SL_BT : SL_KT) * SLOT, pj, pi, r32, hi);
            f32x16 acc2 = mm_tile(zero16(), RTt, lds + (wid < 4 ? SL_BT : SL_KT) * SLOT, pj, pi, r32, hi);
            const int row = 32 * pj + r32;
            if (wid < 4) {
                st_tile(lds + SL_MOFF * SLOT, pj, pi, r32, hi, acc, [](int s, int i) { return (s >> 4) > (i >> 4); });
#pragma unroll
                for (int g = 0; g < 4; ++g)
#pragma unroll
                    for (int q = 0; q < 4; ++q) { const int i = 32 * pi + 8 * g + 4 * hi + q; const float vv = acc[4 * g + q];
                        if ((row >> 4) == (i >> 4)) ((float*)(lds + L_FD))[(4 + (row >> 4)) * 272 + (i & 15) * 16 + (row & 15)] = (i < row) ? vv : 0.f; }
                st_tile(lds + SL_LRB * SLOT, pj, pi, r32, hi, acc2, [](int s, int i) { return i <= s; });
            } else {
                st_tile(lds + SL_MAK * SLOT, pj, pi, r32, hi, acc, [](int s, int i) { return i < s; });
                st_tile(lds + SL_LRK * SLOT, pj, pi, r32, hi, acc2, [](int s, int i) { return i <= s; });
            }
        }
        __syncthreads();
        if (c + 1 < SEQ / 64) C_LOAD(c + 1);
        if (wid == 0) {
            const int d = lane >> 4, j = lane & 15; const float* MdT = (const float*)(lds + L_FD) + (4 + d) * 272;
            float x[16];
#pragma unroll
            for (int q = 15; q >= 0; --q) { float acc = (q == j) ? 1.f : 0.f;
                const f32x4 m0 = *(const f32x4*)(MdT + q * 16), m1 = *(const f32x4*)(MdT + q * 16 + 4), m2 = *(const f32x4*)(MdT + q * 16 + 8), m3 = *(const f32x4*)(MdT + q * 16 + 12);
                const float mr[16] = {m0.x, m0.y, m0.z, m0.w, m1.x, m1.y, m1.z, m1.w, m2.x, m2.y, m2.z, m2.w, m3.x, m3.y, m3.z, m3.w};
#pragma unroll
                for (int s = 0; s < 16; ++s) if (s > q) acc = fmaf(x[s], mr[s], acc);
                x[q] = acc; asm volatile("" ::: "memory"); }
            char* rowp = lds + SL_DD * SLOT + (16 * d + j) * 144;
            const u32x4 z4 = {0u, 0u, 0u, 0u};
#pragma unroll
            for (int q = 0; q < 8; ++q) *(u32x4*)(rowp + 16 * q) = z4;
            u32x4 w0, w1; w0.x = pk2(x[0], x[1]); w0.y = pk2(x[2], x[3]); w0.z = pk2(x[4], x[5]); w0.w = pk2(x[6], x[7]); w1.x = pk2(x[8], x[9]); w1.y = pk2(x[10], x[11]); w1.z = pk2(x[12], x[13]); w1.w = pk2(x[14], x[15]);
            asm volatile("s_waitcnt lgkmcnt(0)" ::: "memory");
            *(u32x4*)(rowp + 32 * d) = w0; *(u32x4*)(rowp + 32 * d + 16) = w1;
        }
        f32x16 locA = zero16(), locB = zero16();
        if (wid < 4) { locA = mm_tile2<true, false>(locA, lds + SL_VT * SLOT, lds + SL_MAK * SLOT, pj, pi, lane, r32, hi); locB = mm_tile2<true, true>(locB, lds + SL_VT * SLOT, lds + SL_KH * SLOT, pj, pi, lane, r32, hi); }
        else locA = mm_tile2<false, true>(locA, lds + SL_LRK * SLOT, lds + SL_VT * SLOT, pj, pi, lane, r32, hi);
        __syncthreads();
        if (wid < 4) {
            f32x16 acc = mm_tile2<false, true>(zero16(), lds + SL_DD * SLOT, lds + SL_MOFF * SLOT, pj, pi, lane, r32, hi);
            st_tile(lds + SL_N * SLOT, pj, pi, r32, hi, acc, [](int, int) { return true; });
        }
        __syncthreads();
        {
            f32x16 acc = zero16();
            if (wid >= 4) { const int row = 32 * pj + r32; const char* addt = lds + SL_DD * SLOT;
#pragma unroll
                for (int g = 0; g < 4; ++g) { const u32x2 w = *(const u32x2*)(addt + row * 144 + (32 * pi + 8 * g + 4 * hi) * 2); acc[4 * g] = lo16(w.x); acc[4 * g + 1] = hi16(w.x); acc[4 * g + 2] = lo16(w.y); acc[4 * g + 3] = hi16(w.y); } }
            acc = (wid < 4) ? mm_tile2<false, true>(acc, lds + SL_N * SLOT, lds + SL_N * SLOT, pj, pi, lane, r32, hi) : mm_tile2<false, true>(acc, lds + SL_N * SLOT, lds + SL_DD * SLOT, pj, pi, lane, r32, hi);
            st_tile(lds + (wid < 4 ? SL_N2 : SL_W1) * SLOT, pj, pi, r32, hi, acc, [](int, int) { return true; });
        }
        __syncthreads();
        if (wid < 4) {
            f32x16 acc;
            { const int row = 32 * pj + r32; const char* addt = lds + SL_W1 * SLOT;
#pragma unroll
              for (int g = 0; g < 4; ++g) { const u32x2 w = *(const u32x2*)(addt + row * 144 + (32 * pi + 8 * g + 4 * hi) * 2); acc[4 * g] = lo16(w.x); acc[4 * g + 1] = hi16(w.x); acc[4 * g + 2] = lo16(w.y); acc[4 * g + 3] = hi16(w.y); } }
            acc = mm_tile2<false, true>(acc, lds + SL_N2 * SLOT, lds + SL_W1 * SLOT, pj, pi, lane, r32, hi);
            st_tile(lds + SL_T * SLOT, pj, pi, r32, hi, acc, [](int, int) { return true; });
        } else {
            locA = mm_tile(locA, lds + SL_RT * SLOT, lds + SL_S0 * SLOT, pj, pi, r32, hi);
        }
        if (wid < 4) {
            locA = mm_tile(locA, lds + SL_S0 * SLOT, lds + SL_AT * SLOT, pj, pi, r32, hi);
            st_tile(lds + SL_RHST * SLOT, pj, pi, r32, hi, locA, [](int, int) { return true; });
        }
        __syncthreads();
        if (wid < 4) {
            f32x16 acc = mm_tile(zero16(), lds + SL_RHST * SLOT, lds + SL_T * SLOT, pj, pi, r32, hi);
            st_tile(lds + SL_UT * SLOT, pj, pi, r32, hi, acc, [](int, int) { return true; });
        }
        __syncthreads();
        if (wid < 4) {
            const float* gam = (const float*)(lds + L_SEG);
#pragma unroll
            for (int g = 0; g < 4; ++g) { const f32x4 gq = *(const f32x4*)(gam + 32 * pi + 8 * g + 4 * hi);
                state[4 * g] = state[4 * g] * gq.x + locB[4 * g]; state[4 * g + 1] = state[4 * g + 1] * gq.y + locB[4 * g + 1]; state[4 * g + 2] = state[4 * g + 2] * gq.z + locB[4 * g + 2]; state[4 * g + 3] = state[4 * g + 3] * gq.w + locB[4 * g + 3]; }
            state = mm_tile2<false, true>(state, lds + SL_UT * SLOT, lds + SL_BH * SLOT, pj, pi, lane, r32, hi);
            st_tile(lds + SL_S0 * SLOT, pj, pi, r32, hi, state, [](int, int) { return true; });
        } else {
            locA = mm_tile(locA, lds + SL_LRB * SLOT, lds + SL_UT * SLOT, pj, pi, r32, hi);
            const int s = 32 * pj + r32; const int tn = t0 + (dir ? 63 - s : s);
            bf16_t* yp = yout + (rowb + tn) * 512 + h * 64 + 32 * pi;
#pragma unroll
            for (int g = 0; g < 4; ++g) { u32x2 w; w.x = pk2(locA[4 * g], locA[4 * g + 1]); w.y = pk2(locA[4 * g + 2], locA[4 * g + 3]); *(u32x2*)(yp + 8 * g + 4 * hi) = w; }
        }
        __syncthreads();
    }
#undef C_LOAD
#undef SHIFT8
}

DEVI void stage_rwkv_post(const Params& p, int bid, int nb) {
    const bf16_t* yf = (const bf16_t*)(p.ws + OFF_YF); const bf16_t* yb = (const bf16_t*)(p.ws + OFF_YB);
    const bf16_t* g = (const bf16_t*)(p.ws + OFF_G); const bf16_t* vs = (const bf16_t*)(p.ws + OFF_VS);
    const float* sf = (const float*)(p.ws + OFF_SDIR); const float* sb = sf + (size_t)T_ * 8;
    bf16_t* orw = (bf16_t*)(p.ws + OFF_YF);
    for (int i = bid * NTHREADS + my_tid(); i < T_ * 64; i += nb * NTHREADS) {
        const int c8 = i & 7, th = i >> 3, c = (th & 7) * 64 + 8 * c8;
        const size_t o = (size_t)(th >> 3) * 512 + c;
        float a[8], b[8], y[8], gv[8], vv[8];
        unpack8(*(const u32x4*)(yf + o), a); unpack8(*(const u32x4*)(yb + o), b); unpack8(*(const u32x4*)(g + o), gv); unpack8(*(const u32x4*)(vs + o), vv);
        float s = 0.f;
#pragma unroll
        for (int j = 0; j < 8; ++j) { y[j] = a[j] + b[j]; s += y[j]; }
        const float mu = red8(s) * (1.f / 64.f);
        float q = 0.f;
#pragma unroll
        for (int j = 0; j < 8; ++j) { y[j] -= mu; q += y[j] * y[j]; }
        const float rstd = rsqrtf(red8(q) * (1.f / 64.f) + 64e-5f);
        const float bs = sf[th] + sb[th];
        const f32x4 lga = *(const f32x4*)(p.in[18] + c), lgb = *(const f32x4*)(p.in[18] + c + 4), lba = *(const f32x4*)(p.in[19] + c), lbb = *(const f32x4*)(p.in[19] + c + 4);
        const float lg[8] = {lga.x, lga.y, lga.z, lga.w, lgb.x, lgb.y, lgb.z, lgb.w}, lb[8] = {lba.x, lba.y, lba.z, lba.w, lbb.x, lbb.y, lbb.z, lbb.w};
        float r[8];
#pragma unroll
        for (int j = 0; j < 8; ++j) r[j] = (y[j] * rstd * lg[j] + lb[j] + bs * vv[j]) * gv[j];
        *(u32x4*)(orw + o) = pack8(r);
    }
}

typedef float f32x2v __attribute__((ext_vector_type(2)));
DEVI void stage_route(const Params& p, char* lds, int bid, int nb, bool do_count = true) {
    const int tid = my_tid(), lane = tid & 63, wave = tid >> 6;
    const bf16_t* x1 = (const bf16_t*)(p.ws + OFF_X1); bf16_t* h2 = (bf16_t*)((char*)p.out + DOFF_H2);
    int* toke = (int*)(p.ws + OFF_TOKE); float* tokw = (float*)(p.ws + OFF_TOKW); int* tokr = (int*)(p.ws + OFF_TOKR);
    int* cntwg = (int*)(p.ws + OFF_CNTWG);
    const bf16_t* wrt = (const bf16_t*)(p.ws + OFF_WRT);
    const float* g2 = p.in[23];
    int* hist = (int*)lds;
    float* lgs = (float*)(lds + 256) + wave * (16 * 48);
    if (bid == 0 && do_count) { u32x4* zr = (u32x4*)(h2 + (size_t)T_ * DM); if (tid < 128) zr[tid] = (u32x4){0u, 0u, 0u, 0u}; }
    for (int b = bid; b < T_ / 128; b += nb) {
        if (tid < 32) hist[tid] = 0;
        __syncthreads();
        const int t0 = b * 128 + wave * 16;
        f32x4 gv[4];
#pragma unroll
        for (int j = 0; j < 4; ++j) gv[j] = *(const f32x4*)(g2 + 4 * lane + 256 * j);
        float my_rstd = 0.f;
        for (int ib = 0; ib < 16; ib += 4) {
            u32x2 xw[4][4];
#pragma unroll
            for (int q = 0; q < 4; ++q) { const u32x2* xr = (const u32x2*)(x1 + (size_t)(t0 + ib + q) * DM) + lane;
#pragma unroll
                for (int j = 0; j < 4; ++j) xw[q][j] = xr[64 * j]; }
#pragma unroll
            for (int q = 0; q < 4; ++q) { const int i = ib + q;
                f32x4 v[4]; float s = 0.f;
#pragma unroll
                for (int j = 0; j < 4; ++j) { const u32x2 w = xw[q][j]; v[j] = (f32x4){lo16(w.x), hi16(w.x), lo16(w.y), hi16(w.y)}; s += (v[j].x * v[j].x + v[j].y * v[j].y) + (v[j].z * v[j].z + v[j].w * v[j].w); }
                const float rstd = rsqrtf(wave_sum(s) * (1.f / DM) + 1e-6f);
                if ((lane & 15) == i) my_rstd = rstd;
                u32x2* o8 = (u32x2*)(h2 + (size_t)(t0 + i) * DM) + lane;
#pragma unroll
                for (int j = 0; j < 4; ++j) { const f32x4 qv = v[j] * rstd * gv[j]; u32x2 w; w.x = pk2(qv.x, qv.y); w.y = pk2(qv.z, qv.w); o8[64 * j] = w; } }
        }
        const int li = lane & 15, kq = lane >> 4;
        const bf16_t* xrow = x1 + (size_t)(t0 + li) * DM + 8 * kq;
        const bf16_t* whp = (const bf16_t*)wrt + (size_t)li * DM + 8 * kq; const bf16_t* wlp = whp + 48 * DM;
        f32x4 acc0 = {0.f, 0.f, 0.f, 0.f}, acc1 = acc0, acc2 = acc0;
#pragma unroll 2
        for (int ks = 0; ks < 32; ++ks) {
            float xv[8]; unpack8(*(const u32x4*)(xrow + 32 * ks), xv);
            const f32x4 ga = *(const f32x4*)(g2 + 32 * ks + 8 * kq), gb = *(const f32x4*)(g2 + 32 * ks + 8 * kq + 4);
            const float gq[8] = {ga.x, ga.y, ga.z, ga.w, gb.x, gb.y, gb.z, gb.w};
            float vh[8], vl[8];
#pragma unroll
            for (int j = 0; j < 8; ++j) { const float v = xv[j] * gq[j] * my_rstd; const float hf = bf2f(f2bf(v)); vh[j] = hf; vl[j] = v - hf; }
            const bf16x8 ah = __builtin_bit_cast(bf16x8, pack8(vh)), al = __builtin_bit_cast(bf16x8, pack8(vl));
#pragma unroll
            for (int ob = 0; ob < 3; ++ob) {
                const bf16x8 bh = *(const bf16x8*)(whp + (size_t)ob * 16 * DM + 32 * ks), bl = *(const bf16x8*)(wlp + (size_t)ob * 16 * DM + 32 * ks);
                f32x4& a = (ob == 0) ? acc0 : (ob == 1 ? acc1 : acc2);
                a = __builtin_amdgcn_mfma_f32_16x16x32_bf16(ah, bh, a, 0, 0, 0);
                a = __builtin_amdgcn_mfma_f32_16x16x32_bf16(ah, bl, a, 0, 0, 0);
                a = __builtin_amdgcn_mfma_f32_16x16x32_bf16(al, bh, a, 0, 0, 0);
            }
        }
#pragma unroll
        for (int r = 0; r < 4; ++r) { float* lr = lgs + (4 * kq + r) * 48 + li; lr[0] = acc0[r]; lr[16] = acc1[r]; lr[32] = acc2[r]; }
        asm volatile("s_waitcnt lgkmcnt(0)" ::: "memory");
        if (lane < 16) {
            const float* lg = lgs + lane * 48; const int t = t0 + lane;
            float gl[4];
#pragma unroll
            for (int j = 0; j < 4; ++j) gl[j] = lg[j] + p.in[25][j];
            int gi = 0; float gm = gl[0];
#pragma unroll
            for (int j = 1; j < 4; ++j) if (gl[j] > gm) { gm = gl[j]; gi = j; }
            float gs = 0.f;
#pragma unroll
            for (int j = 0; j < 4; ++j) gs += __expf(gl[j] - gm);
            const float gp = 1.f / gs;
            float el[8];
#pragma unroll
            for (int j = 0; j < 8; ++j) el[j] = lg[4 + gi * 8 + j] + p.in[27][gi * 8 + j];
            int i1 = 0; float m1 = el[0];
#pragma unroll
            for (int j = 1; j < 8; ++j) if (el[j] > m1) { m1 = el[j]; i1 = j; }
            int i2 = -1; float m2 = -INFINITY;
#pragma unroll
            for (int j = 0; j < 8; ++j) if (j != i1 && el[j] > m2) { m2 = el[j]; i2 = j; }
            const float e2 = __expf(m2 - m1), tp1 = 1.f / (1.f + e2), tp2 = e2 / (1.f + e2);
            const int e1i = gi * 8 + i1, e2i = gi * 8 + i2;
            toke[2 * t] = e1i; toke[2 * t + 1] = e2i; tokw[2 * t] = gp * tp1; tokw[2 * t + 1] = gp * tp2;
            if (do_count) { tokr[2 * t] = atomicAdd(hist + e1i, 1); tokr[2 * t + 1] = atomicAdd(hist + e2i, 1); }
        }
        __syncthreads();
        if (do_count && tid < 32) cntwg[b * 32 + tid] = hist[tid];
        __syncthreads();
    }
}
DEVI void stage_scatter(const Params& p, char* lds, int bid, int nb, bool dry = false) {
    const int tid = my_tid(), lane = tid & 63, wave = tid >> 6;
    const int gw = bid * NWAVES + wave, NGW = nb * NWAVES;
    int* ctl = (int*)(p.ws + OFF_CTL); const int* toke = (const int*)(p.ws + OFF_TOKE); const int* tokr = (const int*)(p.ws + OFF_TOKR); int* toks = (int*)(p.ws + OFF_TOKS);
    const int* cntwg = (const int*)(p.ws + OFF_CNTWG);
    int* slottok = (int*)(p.ws + OFF_SLOTTOK);
    int* part = (int*)lds;
    int* tot = part + 512;
    int* cnts = tot + 32;
    int* bases = cnts + 32;
    constexpr int NB = T_ / 128;
    {
        const int e = tid & 31, q = tid >> 5;
        int s = 0;
        for (int w = 16 * q; w < 16 * q + 16; ++w) s += cntwg[w * 32 + e];
        part[q * 32 + e] = s;
    }
    __syncthreads();
    if (tid == 0) {
        int run = 0;
        for (int e = 0; e < NEXP; ++e) {
            int c = 0; for (int q = 0; q < 16; ++q) c += part[q * 32 + e];
            cnts[e] = c; tot[e] = run;
            const int pad = (c + 255) / 256 * 256;
            if (bid == 0) for (int bq = run / 256; bq < (run + pad) / 256; ++bq) ctl[C_BLKE + bq] = e;
            run += pad;
        }
        if (bid == 0) { for (int bq = run / 256; bq < NBLK; ++bq) ctl[C_BLKE + bq] = -1; ctl[C_NBLK] = run / 256; }
    }
    __syncthreads();
    for (int b = bid; b < NB; b += nb) {
        if (tid < 32) { int s = tot[tid]; for (int q = 0; q < (b >> 4); ++q) s += part[q * 32 + tid]; for (int w = b & ~15; w < b; ++w) s += cntwg[w * 32 + tid]; bases[tid] = s; }
        __syncthreads();
        if (tid < 256) { const int a = b * 256 + tid; const int slot = bases[toke[a]] + tokr[a]; if (!dry) { toks[a] = slot; slottok[slot] = a >> 1; } else asm volatile("" :: "v"(slot)); }
        __syncthreads();
    }
    {
        const int e = gw & 31; const int c = cnts[e], pad = (c + 255) / 256 * 256;
        for (int s = tot[e] + c + (gw >> 5) * 64 + lane; s < tot[e] + pad; s += (NGW >> 5) * 64) slottok[s] = T_;
    }
    __syncthreads();
}
DEVI void stage_final(const Params& p, int bid, int nb, bool dry = false) {
    const int lane = my_tid() & 63, wave = my_tid() >> 6;
    const int gw = bid * NWAVES + wave, NGW = nb * NWAVES;
    const bf16_t* ye = (const bf16_t*)(p.ws + OFF_YE); const int* toks = (const int*)(p.ws + OFF_TOKS); const float* tokw = (const float*)(p.ws + OFF_TOKW);
    const bf16_t* x1 = (const bf16_t*)(p.ws + OFF_X1);
    const float* gf = p.in[31];
    f32x4 gv[4];
#pragma unroll
    for (int j = 0; j < 4; ++j) gv[j] = *(const f32x4*)(gf + 4 * lane + 256 * j);
    for (int tb = gw * 2; tb < T_; tb += NGW * 2) {
        u32x2 xa[2][4], ya[2][4], yb[2][4]; float w0[2], w1[2];
#pragma unroll
        for (int q = 0; q < 2; ++q) { const int t = tb + q; const int s0 = toks[2 * t], s1 = toks[2 * t + 1]; w0[q] = tokw[2 * t]; w1[q] = tokw[2 * t + 1];
            const u32x2* xr = (const u32x2*)(x1 + (size_t)t * DM) + lane; const u32x2* y0 = (const u32x2*)(ye + (size_t)s0 * DM) + lane; const u32x2* y1 = (const u32x2*)(ye + (size_t)s1 * DM) + lane;
#pragma unroll
            for (int j = 0; j < 4; ++j) { xa[q][j] = xr[64 * j]; ya[q][j] = y0[64 * j]; yb[q][j] = y1[64 * j]; } }
#pragma unroll
        for (int q = 0; q < 2; ++q) {
            f32x4 v[4]; float s = 0.f;
#pragma unroll
            for (int j = 0; j < 4; ++j) { const u32x2 x = xa[q][j], a = ya[q][j], b = yb[q][j];
                v[j].x = lo16(x.x) + w0[q] * lo16(a.x) + w1[q] * lo16(b.x); v[j].y = hi16(x.x) + w0[q] * hi16(a.x) + w1[q] * hi16(b.x);
                v[j].z = lo16(x.y) + w0[q] * lo16(a.y) + w1[q] * lo16(b.y); v[j].w = hi16(x.y) + w0[q] * hi16(a.y) + w1[q] * hi16(b.y);
                s += (v[j].x * v[j].x + v[j].y * v[j].y) + (v[j].z * v[j].z + v[j].w * v[j].w); }
            const float rstd = rsqrtf(wave_sum(s) * (1.f / DM) + 1e-6f);
            f32x4* orow = (f32x4*)(p.out + (size_t)(tb + q) * DM) + lane;
#pragma unroll
            for (int j = 0; j < 4; ++j) { const f32x4 o = v[j] * rstd * gv[j]; if (!dry) orow[64 * j] = o; else asm volatile("" :: "v"(o)); }
        }
    }
}

#define LAS __attribute__((address_space(3)))
#define XB_TMO      128
#define XB_XCNT(j)  (256  + 64 * (j))
#define XB_XSUB(j)  (1280 + 64 * (j))
#define XB_XGEN(j)  (2304 + 64 * (j))
#define XB_TOP      3328
#define XB_TOPGEN   3392
#define XCD_BAR_WORDS 3456
#define XB_SPIN_CAP (1u << 18)
DEVI unsigned xb_ld(unsigned* p)              { return __hip_atomic_load(p, __ATOMIC_RELAXED, __HIP_MEMORY_SCOPE_AGENT); }
DEVI unsigned xb_add(unsigned* p, unsigned v) { return __hip_atomic_fetch_add(p, v, __ATOMIC_RELAXED, __HIP_MEMORY_SCOPE_AGENT); }
DEVI unsigned xb_xcc_id() { return (unsigned)__builtin_amdgcn_s_getreg((3 << 11) | 20) & 0xFu; }
#define XB_SPIN(cond, bar) do { unsigned _sp = 0; while (cond) { __builtin_amdgcn_s_sleep(1); \
    if ((++_sp & 255u) == 0u) { if (xb_ld(&(bar)[XB_TMO])) break; if (_sp > XB_SPIN_CAP) { atomicAdd(&(bar)[XB_TMO], 1u); break; } } } } while (0)
struct XcdBarrier { unsigned* bar; unsigned x; volatile LAS unsigned* st; };
DEVI XcdBarrier xcd_barrier_post(unsigned* bar, volatile LAS unsigned* st) {
    XcdBarrier b; b.bar = bar; b.x = xb_xcc_id(); b.st = st;
    if (my_tid() == 0) (void)xb_add(&bar[XB_XCNT(b.x)], 1u);
    return b;
}
DEVI void xcd_barrier_complete(unsigned* bar, unsigned x, unsigned& nloc, unsigned& nx) {
    const unsigned G = gridDim.x * gridDim.y * gridDim.z;
    unsigned sum, cnt, mine, sp = 0u;
    for (;;) {
        sum = 0u; cnt = 0u; mine = 0u;
#pragma unroll
        for (unsigned j = 0; j < 16; ++j) { const unsigned c = xb_ld(&bar[XB_XCNT(j)]); sum += c; cnt += (c > 0u) ? 1u : 0u; mine = (j == x) ? c : mine; }
        if (sum == G) break;
        __builtin_amdgcn_s_sleep(1);
        if ((++sp & 255u) == 0u) { if (xb_ld(&bar[XB_TMO])) break; if (sp > XB_SPIN_CAP) { atomicAdd(&bar[XB_TMO], 1u); break; } }
    }
    nloc = mine > 0u ? mine : 1u; nx = cnt > 0u ? cnt : 1u;
}
DEVI void xcd_barrier(const XcdBarrier& b) {
    asm volatile("s_waitcnt vmcnt(0)" ::: "memory");
    __syncthreads();
    if (my_tid() == 0) {
        unsigned* bar = b.bar;
        __builtin_amdgcn_s_waitcnt(0);
        unsigned nloc = b.st[0], nx = b.st[1];
        if (nloc == 0u) { xcd_barrier_complete(bar, b.x, nloc, nx); b.st[0] = nloc; b.st[1] = nx; }
        const unsigned old = xb_add(&bar[XB_XSUB(b.x)], 1u);
        const unsigned gen = old / nloc;
        if (old + 1u == (gen + 1u) * nloc) {
            __builtin_amdgcn_fence(__ATOMIC_RELEASE, "agent");
            asm volatile("s_waitcnt vmcnt(0)" ::: "memory");
            const unsigned og = xb_add(&bar[XB_TOP], 1u);
            const unsigned tg = og / nx;
            if (og + 1u == (tg + 1u) * nx) xb_add(&bar[XB_TOPGEN], 1u);
            else XB_SPIN(xb_ld(&bar[XB_TOPGEN]) == tg, bar);
            __builtin_amdgcn_fence(__ATOMIC_ACQUIRE, "agent");
            xb_add(&bar[XB_XGEN(b.x)], 1u);
            asm volatile("s_waitcnt vmcnt(0)" ::: "memory");
        } else {
            XB_SPIN(xb_ld(&bar[XB_XGEN(b.x)]) == gen, bar);
            __builtin_amdgcn_fence(__ATOMIC_ACQUIRE, "agent");
            asm volatile("s_waitcnt vmcnt(0)" ::: "memory");
        }
    }
    __syncthreads();
}

constexpr int LDS_BYTES = 147456;
constexpr int LDS_MISC = 147200;
constexpr int C_BAR = 4096;
constexpr size_t CTL_ZERO_BYTES = 65536;
constexpr size_t DOFF_H2ND = 0;
constexpr size_t DOFF_ORWKV = 64 * MiB;

template <int PH>
DEVI void run_phase(const Params& p, char* lds, int bid, int nb) {
    unsigned char* ws = p.ws;
    if constexpr (PH == 0) { stage_transposes(p, 0, p.njobs_mid, 0, p.items_mid, lds, bid, nb); stage_rope_table(p, bid, nb);
        { u32x4* wz = (u32x4*)(ws + OFF_WIN + (size_t)NZ * DM * 2); const u32x4 z4 = {0u, 0u, 0u, 0u}; for (int i = bid * NTHREADS + my_tid(); i < (LDZ - NZ) * DM / 8; i += nb * NTHREADS) wz[i] = z4; }
        { bf16_t* gp = (bf16_t*)(ws + OFF_GUP); const u32x4 z4 = {0u, 0u, 0u, 0u}; for (int i = bid * NTHREADS + my_tid(); i < 512 * 16; i += nb * NTHREADS) *(u32x4*)(gp + (size_t)(i >> 4) * 256 + 128 + 8 * (i & 15)) = z4; }
        { bf16_t* wrh = (bf16_t*)(ws + OFF_WRT); bf16_t* wrl = wrh + 48 * DM; for (int i = bid * NTHREADS + my_tid(); i < 48 * DM; i += nb * NTHREADS) { const int o = i >> 10, c = i & 1023; const float w = (o < 4) ? p.in[24][c * 4 + o] : (o < 36 ? p.in[26][c * 32 + (o - 4)] : 0.f); const unsigned h = f2bf(w); wrh[i] = (bf16_t)h; wrl[i] = (bf16_t)f2bf(w - bf2f(h)); } }
        __syncthreads(); stage_rms_rows(p.in[0], p.in[1], (bf16_t*)(ws + OFF_H), bid, nb); }
    if constexpr (PH == 1) { F8Bf16 e{(bf16_t*)(ws + OFF_Z), LDZ}; big_gemm(lds, (const bf16_t*)(ws + OFF_H), DM, (const bf16_t*)(ws + OFF_WIN), DM, T_, LDZ, DM, e, bid, nb); }
    if constexpr (PH == 2) { if ((PROBE_MASK >> 25) & 1) { stage_mla_prep(p, bid, nb, true); stage_sg_prep(p, bid, nb); } stage_mla_prep(p, bid, nb); stage_sg_prep(p, bid, nb); }
    if constexpr (PH == 3) {
        const bf16_t* z = (const bf16_t*)(ws + OFF_Z);
        { F8Bf16 e{(bf16_t*)((char*)p.out + DOFF_QRAW), 768}; big_gemm(lds, z, LDZ, (const bf16_t*)(ws + OFF_WUQ), 384, T_, 768, 384, e, bid, nb); }
        { F8Bf16 e{(bf16_t*)((char*)p.out + DOFF_KVRAW), 1024}; big_gemm_<F8Bf16, false, false>(lds, z + 384, LDZ, (const bf16_t*)(ws + OFF_WUKV), 256, T_, 1024, 256, e, bid, nb, nullptr, 0, nullptr); }
        { F8Bf16 e{(bf16_t*)(ws + OFF_G), 512}; big_gemm(lds, (const bf16_t*)(ws + OFF_SG), 256, (const bf16_t*)(ws + OFF_GUP), 256, T_, 512, 256, e, bid, nb); }
        for (int rep = 0; rep < 1 + ((PROBE_MASK >> 20) & 1); ++rep) for (int u = bid; u < BATCH * NH * 2; u += nb) chain_unit(p, u, lds);
    }
    if constexpr (PH == 4) {
        for (int rep = 0; rep < 1 + ((PROBE_MASK >> 21) & 1); ++rep) for (int u = bid; u < BATCH * NH * 8; u += nb) attn_unit(p, u, lds);
        stage_rwkv_post(p, bid, nb);
    }
    if constexpr (PH == 6) {
        { F8Bf16 e{(bf16_t*)(ws + OFF_GL), 2048}; big_gemm(lds, (const bf16_t*)(ws + OFF_H), DM, (const bf16_t*)(ws + OFF_WG), DM, T_, 2048, DM, e, bid, nb); }
        { F8Bf16 e{(bf16_t*)(ws + OFF_BM), 1024}; big_gemm(lds, (const bf16_t*)(ws + OFF_OMLA), 512, (const bf16_t*)(ws + OFF_WBM), 512, T_, 1024, 512, e, bid, nb); }
    }
    if constexpr (PH == 7) { F8Mix e{(const bf16_t*)(ws + OFF_GL), (const bf16_t*)(ws + OFF_BM), (bf16_t*)(ws + OFF_MIXED), p.in[21]};
        big_gemm(lds, (const bf16_t*)(ws + OFF_YF), 512, (const bf16_t*)(ws + OFF_WBR), 512, T_, 1024, 512, e, bid, nb); }
    if constexpr (PH == 8) { F8Resid e{p.in[0], (bf16_t*)(ws + OFF_X1)};
        big_gemm(lds, (const bf16_t*)(ws + OFF_MIXED), DM, (const bf16_t*)(ws + OFF_WOUT), DM, T_, DM, DM, e, bid, nb); }
    if constexpr (PH == 9) { stage_route(p, lds, bid, nb); if ((PROBE_MASK >> 22) & 1) stage_route(p, lds, bid, nb, false); }
    if constexpr (PH == 10) { if ((PROBE_MASK >> 27) & 1) stage_scatter(p, lds, bid, nb, true); stage_scatter(p, lds, bid, nb); }
    if constexpr (PH == 11) { F8Swiglu e{(bf16_t*)((char*)p.out + DOFF_HID)}; const int* ctl = (const int*)(ws + OFF_CTL);
        big_gemm_<F8Swiglu, true>(lds, (const bf16_t*)((const char*)p.out + DOFF_H2), DM, (const bf16_t*)(ws + OFF_W13), DM, ctl[C_NBLK] * 256, 512, DM, e, bid, nb, ctl + C_BLKE, (size_t)512 * DM, (const int*)(ws + OFF_SLOTTOK));
        {
            const int nwg = ctl[C_NBLK] * 2; int n3 = nwg - 2 * nb; n3 = n3 < 0 ? 0 : (n3 > nb - 32 ? nb - 32 : n3);
            if (bid >= n3) stage_transposes(p, p.njobs_mid, p.njobs_all, p.items_mid, p.items_all, lds, bid - n3, nb - n3);
        } }
    if constexpr (PH == 12) { F8Bf16 e{(bf16_t*)(ws + OFF_YE), DM}; const int* ctl = (const int*)(ws + OFF_CTL);
        big_gemm_<F8Bf16, false, false>(lds, (const bf16_t*)((const char*)p.out + DOFF_HID), DEXP, (const bf16_t*)(ws + OFF_W2), DEXP, ctl[C_NBLK] * 256, DM, DEXP, e, bid, nb, ctl + C_BLKE, (size_t)DM * DEXP, nullptr); }
    if constexpr (PH == 13) { if ((PROBE_MASK >> 26) & 1) stage_final(p, bid, nb, true); stage_final(p, bid, nb); }
}

__global__ void __launch_bounds__(NTHREADS, 2) mega_fwd(Params p) {
    extern __shared__ __attribute__((aligned(16))) char lds[];
    const int bid = blockIdx.x, nb = gridDim.x;
    volatile LAS unsigned* misc = (volatile LAS unsigned*)((LAS char*)lds + LDS_MISC);
    if (my_tid() < 64) misc[my_tid()] = 0u;
    __syncthreads();
    XcdBarrier bar = xcd_barrier_post((unsigned*)(p.ws + OFF_CTL) + C_BAR, misc + 8);
#define PHASE(k) do { run_phase<k>(p, lds, bid, nb); if ((PROBE_MASK >> k) & 1) { __syncthreads(); run_phase<k>(p, lds, bid, nb); } xcd_barrier(bar); if ((PROBE_MASK >> 24) & 1) xcd_barrier(bar); } while (0)
    PHASE(0); PHASE(1); PHASE(2); PHASE(3); PHASE(4); PHASE(6); PHASE(7); PHASE(8); PHASE(9); PHASE(10); PHASE(11); PHASE(12);
    run_phase<13>(p, lds, bid, nb);
#undef PHASE
}

static int add_job(Params& P, int& nj, int& items, int in_idx, int K, int ldsrc, int col0, int ncols, int row_mul, int row_off, int nbatch, long long sbs, long long dbs, size_t dst_off, int dst_ld = 0) {
    TJob& J = P.jobs[nj]; J.in_idx = in_idx; J.K = K; J.ldsrc = ldsrc; J.col0 = col0; J.ncols = ncols; J.row_mul = row_mul; J.row_off = row_off; J.nbatch = nbatch;
    J.sbs = sbs; J.dbs = dbs; J.dst_off = (long long)dst_off; J.item0 = items; J.dst_ld = dst_ld ? dst_ld : K;
    items += nbatch * (K / 64) * (ncols / 32); return ++nj;
}
extern "C" void kernel_launch(void* const* d_in, const int* in_sizes, int n_in, void* d_out, int out_size, void* d_ws, size_t ws_size, hipStream_t stream) {
    static int grid = 0;
    if (grid == 0) {
        if (n_in != 32 || out_size != T_ * DM || ws_size < WS_NEED) { fprintf(stderr, "kernel_launch: unexpected shapes (n_in %d out %d ws %zu)\n", n_in, out_size, ws_size); grid = -1; return; }
        int dev = 0, cus = 0, per_cu = 0;
        if (hipGetDevice(&dev) != hipSuccess || hipDeviceGetAttribute(&cus, hipDeviceAttributeMultiprocessorCount, dev) != hipSuccess) { grid = -1; return; }
        if (hipFuncSetAttribute((const void*)mega_fwd, hipFuncAttributeMaxDynamicSharedMemorySize, LDS_BYTES) != hipSuccess) { fprintf(stderr, "kernel_launch: hipFuncSetAttribute failed\n"); grid = -1; return; }
        if (hipOccupancyMaxActiveBlocksPerMultiprocessor(&per_cu, (const void*)mega_fwd, NTHREADS, LDS_BYTES) != hipSuccess || per_cu < 1)
            fprintf(stderr, "kernel_launch: note: occupancy query reports %d workgroups per CU\n", per_cu);
        (void)hipGetLastError();
        grid = cus;
    }
    if (grid < 0) return;
    Params P{};
    for (int i = 0; i < 32; ++i) P.in[i] = (const float*)d_in[i];
    P.out = (float*)d_out; P.ws = (unsigned char*)d_ws;
    int nj = 0, items = 0;
    add_job(P, nj, items, 2, 1024, 4640, 0, 640, 1, 0, 1, 0, 0, OFF_WIN);
    add_job(P, nj, items, 2, 1024, 4640, 672, 1920, 1, 640, 1, 0, 0, OFF_WIN);
    add_job(P, nj, items, 2, 1024, 4640, 640, 32, 1, 0, 1, 0, 0, OFF_WKR);
    add_job(P, nj, items, 2, 1024, 4640, 2592, 2048, 1, 0, 1, 0, 0, OFF_WG);
    add_job(P, nj, items, 5, 384, 768, 0, 768, 1, 0, 1, 0, 0, OFF_WUQ);
    add_job(P, nj, items, 6, 256, 1024, 0, 1024, 1, 0, 1, 0, 0, OFF_WUKV);
    add_job(P, nj, items, 7, 512, 1024, 0, 1024, 1, 0, 1, 0, 0, OFF_WBM);
    add_job(P, nj, items, 20, 512, 1024, 0, 1024, 1, 0, 1, 0, 0, OFF_WBR);
    add_job(P, nj, items, 22, 1024, 1024, 0, 1024, 1, 0, 1, 0, 0, OFF_WOUT);
    add_job(P, nj, items, 11, 64, 512, 0, 512, 1, 0, 2, 64 * 512, 512 * 64, OFF_WUP);
    add_job(P, nj, items, 13, 64, 512, 0, 512, 1, 0, 2, 64 * 512, 512 * 64, OFF_AUP);
    add_job(P, nj, items, 14, 128, 512, 0, 512, 1, 0, 1, 0, 0, OFF_GUP, 256);
    P.njobs_early = nj; P.items_early = items;
    add_job(P, nj, items, 28, 1024, 256, 0, 256, 2, 0, 32, 1024 * 256, 512 * 1024, OFF_W13);
    add_job(P, nj, items, 29, 1024, 256, 0, 256, 2, 1, 32, 1024 * 256, 512 * 1024, OFF_W13);
    P.njobs_mid = nj; P.items_mid = items;
    add_job(P, nj, items, 30, 256, 1024, 0, 1024, 1, 0, 32, 256 * 1024, 1024 * 256, OFF_W2);
    P.njobs_all = nj; P.items_all = items;
    if (hipMemsetAsync((char*)d_ws + OFF_CTL, 0, CTL_ZERO_BYTES, stream) != hipSuccess) { fprintf(stderr, "kernel_launch: memset failed\n"); return; }
    hipLaunchKernelGGL(mega_fwd, dim3(grid), dim3(NTHREADS), LDS_BYTES, stream, P);
}
```

```cpp
#include <hip/hip_runtime.h>
#include <cstdio>
#include <cstdint>

#define DEVI __device__ __forceinline__
#ifndef PROBE_MASK
#define PROBE_MASK 0
#endif
typedef unsigned short bf16_t;
typedef short bf16x8 __attribute__((ext_vector_type(8)));
typedef short s16x4 __attribute__((ext_vector_type(4)));
typedef float f32x4 __attribute__((ext_vector_type(4)));
typedef float f32x16 __attribute__((ext_vector_type(16)));
typedef unsigned u32x4 __attribute__((ext_vector_type(4)));
typedef unsigned u32x2 __attribute__((ext_vector_type(2)));

constexpr int BATCH = 16, SEQ = 2048, DM = 1024, T_ = BATCH * SEQ;
constexpr int NH = 8;
constexpr int LDZ = 2560;
constexpr int NZ = 2560;
constexpr int ZR = 640;
constexpr int NEXP = 32, DEXP = 256;
constexpr int CAP = T_ * 2 + NEXP * 256;
constexpr int NBLK = CAP / 256;
constexpr int NTHREADS = 512, NWAVES = 8;

constexpr size_t MiB = 1u << 20;
constexpr size_t OFF_CTL = 0;
constexpr size_t OFF_WIN = 1 * MiB;
constexpr size_t OFF_WG = 7 * MiB;
constexpr size_t OFF_WUQ = 11 * MiB;
constexpr size_t OFF_WUKV = 12 * MiB;
constexpr size_t OFF_WBM = 13 * MiB;
constexpr size_t OFF_WBR = 14 * MiB;
constexpr size_t OFF_WOUT = 15 * MiB;
constexpr size_t OFF_WUP = 17 * MiB;
constexpr size_t OFF_AUP = 17 * MiB + 131072;
constexpr size_t OFF_GUP = 17 * MiB + 262144;
constexpr size_t OFF_WKR = 17 * MiB + 524288;
constexpr size_t OFF_ROPE = 18 * MiB;
constexpr size_t OFF_TOKE = 18 * MiB + 262144;
constexpr size_t OFF_TOKW = 18 * MiB + 524288;
constexpr size_t OFF_TOKS = 18 * MiB + 786432;
constexpr size_t OFF_TOKR = 19 * MiB;
constexpr size_t OFF_WRT = 19 * MiB + 524288;
constexpr size_t OFF_CNTWG = 19 * MiB + 786432;
constexpr size_t OFF_KROPE = 20 * MiB;
constexpr size_t OFF_YB = 22 * MiB;
constexpr size_t OFF_W13 = 366 * MiB;
constexpr size_t OFF_W2 = 54 * MiB;
constexpr size_t OFF_TW = 70 * MiB;
constexpr size_t OFF_AD = 78 * MiB;
constexpr size_t OFF_SG = 54 * MiB;
constexpr size_t OFF_Z = 94 * MiB;
constexpr size_t OFF_H = 302 * MiB;
constexpr size_t OFF_WL = 270 * MiB;
constexpr size_t OFF_G = 398 * MiB;
constexpr size_t OFF_OMLA = 430 * MiB;
constexpr size_t OFF_YF = 462 * MiB;
constexpr size_t OFF_H2ND = 94 * MiB;
constexpr size_t OFF_BR = 158 * MiB;
constexpr size_t OFF_BM = 94 * MiB;
constexpr size_t OFF_X1 = 94 * MiB;
constexpr size_t DOFF_H2 = 0;
constexpr size_t OFF_YE = 158 * MiB;
constexpr size_t DOFF_HID = 65 * MiB;
constexpr size_t OFF_VS = 270 * MiB;
constexpr size_t OFF_SDIR = 70 * MiB;
constexpr size_t OFF_MIXED = 222 * MiB;
constexpr size_t OFF_SLOTTOK = 338 * MiB;
constexpr size_t WS_NEED = 494 * MiB;
constexpr size_t DOFF_QRAW = 0, DOFF_KVRAW = 48 * MiB;

constexpr int C_CNT = 0, C_CUR = 64, C_PST = 128, C_NBLK = 192, C_BLKE = 256;

DEVI int my_tid() { int t = threadIdx.x; asm volatile("" : "+v"(t)); return t; }
DEVI float bf2f(unsigned h) { return __uint_as_float(h << 16); }
DEVI unsigned f2bf(float f) { unsigned u = __float_as_uint(f); return (u + 0x7fffu + ((u >> 16) & 1u)) >> 16; }
typedef float f32x2p __attribute__((ext_vector_type(2))); typedef __bf16 bf16x2p __attribute__((ext_vector_type(2)));
DEVI unsigned pk2(float lo, float hi) { const f32x2p v = {lo, hi}; return __builtin_bit_cast(unsigned, __builtin_convertvector(v, bf16x2p)); }
DEVI float lo16(unsigned w) { return __uint_as_float(w << 16); }
DEVI float hi16(unsigned w) { return __uint_as_float(w & 0xffff0000u); }
DEVI float wave_sum(float v) {
    v += __int_as_float(__builtin_amdgcn_update_dpp(0, __float_as_int(v), 0xB1, 0xF, 0xF, false));
    v += __int_as_float(__builtin_amdgcn_update_dpp(0, __float_as_int(v), 0x4E, 0xF, 0xF, false));
    v += __int_as_float(__builtin_amdgcn_update_dpp(0, __float_as_int(v), 0x141, 0xF, 0xF, false));
    v += __int_as_float(__builtin_amdgcn_update_dpp(0, __float_as_int(v), 0x140, 0xF, 0xF, false));
    v += __shfl_xor(v, 16); v += __shfl_xor(v, 32);
    return v;
}
DEVI float sigmoidf_(float x) { return __builtin_amdgcn_rcpf(1.f + __expf(-x)); }

struct TJob { int in_idx, K, ldsrc, col0, ncols, row_mul, row_off, nbatch; long long sbs, dbs, dst_off; int item0, dst_ld; };
constexpr int MAXJOBS = 16;
struct Params {
    const float* in[32];
    float* out;
    unsigned char* ws;
    TJob jobs[MAXJOBS];
    int njobs_early, njobs_all, items_early, items_all;
    int njobs_mid, items_mid;
};

DEVI void transpose_item(const float* W, int K, int ld, bf16_t* WT, int dst_ld, int row_off, int row_mul, float* scr, int kb, int nb, int lane) {
    const int k0 = 64 * kb, n0 = 32 * nb;
    float tv[32];
#pragma unroll
    for (int i = 0; i < 32; ++i) tv[i] = W[(size_t)(k0 + 2 * i + (lane >> 5)) * ld + n0 + (lane & 31)];
#pragma unroll
    for (int i = 0; i < 32; ++i) scr[(2 * i + (lane >> 5)) * 33 + (lane & 31)] = tv[i];
    asm volatile("s_waitcnt lgkmcnt(0)" ::: "memory");
    const int c = lane & 7;
#pragma unroll
    for (int j = 0; j < 4; ++j) {
        const int n = (lane >> 3) + 8 * j; const float* s = scr + (8 * c) * 33 + n;
        u32x4 o; o.x = pk2(s[0], s[33]); o.y = pk2(s[66], s[99]); o.z = pk2(s[132], s[165]); o.w = pk2(s[198], s[231]);
        const int nn = n0 + n;
        const int drow = row_mul > 0 ? row_off + nn * row_mul : row_off + ((nn >> 7) << 8) + (nn & 127);
        *(u32x4*)(WT + (size_t)drow * dst_ld + k0 + 8 * c) = o;
    }
    asm volatile("s_waitcnt lgkmcnt(0)" ::: "memory");
}
DEVI void stage_transposes(const Params& p, int j0, int j1, int item_base, int item_end, char* lds, int bid, int nb) {
    const int lane = my_tid() & 63, wave = my_tid() >> 6;
    float* scr = (float*)(lds + wave * 8704);
    const int gw = bid * NWAVES + wave, NGW = nb * NWAVES;
    for (int it = item_base + gw; it < item_end; it += NGW) {
        int j = j0;
        while (j + 1 < j1 && it >= p.jobs[j + 1].item0) ++j;
        const TJob& J = p.jobs[j];
        int r = it - J.item0;
        const int nblk = J.ncols / 32, per = (J.K / 64) * nblk;
        const int e = r / per; r -= e * per;
        const int kb = r / nblk, nbk = r % nblk;
        transpose_item(p.in[J.in_idx] + (size_t)e * J.sbs + J.col0, J.K, J.ldsrc, (bf16_t*)(p.ws + J.dst_off) + (size_t)e * J.dbs, J.dst_ld, J.row_off, J.row_mul, scr, kb, nbk, lane);
    }
}
DEVI void stage_rope_table(const Params& p, int bid, int nb) {
    float* ct = (float*)(p.ws + OFF_ROPE); float* st = ct + SEQ * 16;
    for (int i = bid * NTHREADS + my_tid(); i < SEQ * 16; i += nb * NTHREADS) {
        const int pos = i >> 4, f = i & 15;
        const double inv = pow(10000.0, -(double)(2 * f) / 32.0);
        const double ang = (double)pos * inv;
        ct[i] = (float)cos(ang); st[i] = (float)sin(ang);
    }
}

DEVI void stage_rms_rows(const float* x, const float* g, bf16_t* out, int bid, int nb) {
    const int lane = my_tid() & 63, wave = my_tid() >> 6;
    const int gw = bid * NWAVES + wave, NGW = nb * NWAVES;
    f32x4 gv[4];
#pragma unroll
    for (int j = 0; j < 4; ++j) gv[j] = *(const f32x4*)(g + 4 * lane + 256 * j);
    for (int mb = gw * 4; mb < T_; mb += NGW * 4) {
        f32x4 v[4][4];
#pragma unroll
        for (int q = 0; q < 4; ++q) { const f32x4* xr = (const f32x4*)(x + (size_t)(mb + q) * DM) + lane;
#pragma unroll
            for (int j = 0; j < 4; ++j) v[q][j] = xr[64 * j]; }
#pragma unroll
        for (int q = 0; q < 4; ++q) { float s = 0.f;
#pragma unroll
            for (int j = 0; j < 4; ++j) s += (v[q][j].x * v[q][j].x + v[q][j].y * v[q][j].y) + (v[q][j].z * v[q][j].z + v[q][j].w * v[q][j].w);
            const float rstd = rsqrtf(wave_sum(s) * (1.f / DM) + 1e-6f);
            u32x2* o8 = (u32x2*)(out + (size_t)(mb + q) * DM) + lane;
#pragma unroll
            for (int j = 0; j < 4; ++j) { u32x2 w; w.x = pk2(v[q][j].x * rstd * gv[j].x, v[q][j].y * rstd * gv[j].y); w.y = pk2(v[q][j].z * rstd * gv[j].z, v[q][j].w * rstd * gv[j].w); o8[64 * j] = w; } }
    }
}

typedef short v4i16_t_ __attribute__((ext_vector_type(4)));
DEVI s16x4 vtr_(const char* p) { return __builtin_bit_cast(s16x4, __builtin_amdgcn_ds_read_tr16_b64_v4i16((__attribute__((address_space(3))) v4i16_t_*)p)); }
struct EpiBf16 { bf16_t* out; int ld;
    DEVI void operator()(int row, int col, f32x4 v) const { u32x2 w; w.x = pk2(v.x, v.y); w.y = pk2(v.z, v.w); *(u32x2*)(out + (size_t)row * ld + col) = w; } };
struct EpiBiasAct { bf16_t* out; int ld; const float* bias; int act;
    DEVI void operator()(int row, int col, f32x4 v) const {
        const f32x4 b = *(const f32x4*)(bias + col); v = v + b;
        if (act) { v.x = sigmoidf_(v.x); v.y = sigmoidf_(v.y); v.z = sigmoidf_(v.z); v.w = sigmoidf_(v.w); }
        u32x2 w; w.x = pk2(v.x, v.y); w.y = pk2(v.z, v.w); *(u32x2*)(out + (size_t)row * ld + col) = w; } };
struct EpiMix { const bf16_t* gl; bf16_t* bm; const float* gb;
    DEVI void operator()(int row, int col, f32x4 v) const {
        const u32x2 g1 = *(const u32x2*)(gl + (size_t)row * 2048 + col), g2 = *(const u32x2*)(gl + (size_t)row * 2048 + 1024 + col);
        const u32x2 m = *(const u32x2*)(bm + (size_t)row * 1024 + col);
        const f32x4 b0 = *(const f32x4*)(gb + col), b1 = *(const f32x4*)(gb + 1024 + col);
        f32x4 r;
        r.x = sigmoidf_(lo16(g1.x) + b0.x) * lo16(m.x) + sigmoidf_(lo16(g2.x) + b1.x) * v.x;
        r.y = sigmoidf_(hi16(g1.x) + b0.y) * hi16(m.x) + sigmoidf_(hi16(g2.x) + b1.y) * v.y;
        r.z = sigmoidf_(lo16(g1.y) + b0.z) * lo16(m.y) + sigmoidf_(lo16(g2.y) + b1.z) * v.z;
        r.w = sigmoidf_(hi16(g1.y) + b0.w) * hi16(m.y) + sigmoidf_(hi16(g2.y) + b1.w) * v.w;
        u32x2 w; w.x = pk2(r.x, r.y); w.y = pk2(r.z, r.w); *(u32x2*)(bm + (size_t)row * 1024 + col) = w; } };
struct EpiResid { const float* x; float* out;
    DEVI void operator()(int row, int col, f32x4 v) const { const f32x4 b = *(const f32x4*)(x + (size_t)row * DM + col); *(f32x4*)(out + (size_t)row * DM + col) = b + v; } };
struct EpiSwiglu { bf16_t* hid;
    DEVI void operator()(int row, int col, f32x4 v) const {
        const float a = v.x * sigmoidf_(v.x) * v.y, b = v.z * sigmoidf_(v.z) * v.w;
        *(unsigned*)(hid + (size_t)row * DEXP + (col >> 1)) = pk2(a, b); } };

template <class Epi>
DEVI void gemm_stage(const bf16_t* A, int lda, const bf16_t* Bt, int ldb, int M, int N, int K, const Epi& epi, char* lds, int bid, int nb,
                     const int* rowidx, const int* blk_e, size_t estride) {
    const int tid = my_tid(), lane = tid & 63, wid = tid >> 6, wr = wid >> 1, wc = wid & 1;
    const int nM = M / 256, nN = (N + 127) / 128, nt = K / 64;
    for (int u = bid; u < nM * nN; u += nb) {
        const int pm = u / nN, pn = u % nN, m0 = pm * 256, n0 = pn * 128;
        const bf16_t* Bu = Bt;
        if (blk_e) { const int e = blk_e[pm]; if (e < 0) continue; Bu = Bt + (size_t)e * estride; }
        const bf16_t* ga[4]; const bf16_t* gb[2]; int offA[4], offB[2];
#pragma unroll
        for (int i = 0; i < 4; ++i) { const int pc = tid + 512 * i, row = pc >> 3, ch = pc & 7;
            int r = m0 + row; if (rowidx) r = rowidx[m0 + row];
            ga[i] = (r >= 0) ? A + (size_t)r * lda + ch * 8 : nullptr; offA[i] = row * 128 + ((ch ^ (row & 7)) << 4); }
#pragma unroll
        for (int i = 0; i < 2; ++i) { const int pc = tid + 512 * i, row = pc >> 3, ch = pc & 7; const int n = n0 + row;
            gb[i] = (n < N) ? Bu + (size_t)n * ldb + ch * 8 : nullptr; offB[i] = row * 128 + ((ch ^ (row & 7)) << 4); }
        u32x4 ra[4], rb[2];
        const u32x4 zero4 = {0u, 0u, 0u, 0u};
#define G_LOAD(kt) do { _Pragma("unroll") for (int i = 0; i < 4; ++i) ra[i] = ga[i] ? *(const u32x4*)(ga[i] + (kt) * 64) : zero4; \
                        _Pragma("unroll") for (int i = 0; i < 2; ++i) rb[i] = gb[i] ? *(const u32x4*)(gb[i] + (kt) * 64) : zero4; } while (0)
#define G_STORE(buf) do { _Pragma("unroll") for (int i = 0; i < 4; ++i) *(u32x4*)(lds + (buf) * 32768 + offA[i]) = ra[i]; \
                          _Pragma("unroll") for (int i = 0; i < 2; ++i) *(u32x4*)(lds + 65536 + (buf) * 16384 + offB[i]) = rb[i]; } while (0)
        f32x4 acc[4][4];
#pragma unroll
        for (int a = 0; a < 4; ++a)
#pragma unroll
            for (int b = 0; b < 4; ++b) acc[a][b] = (f32x4){0.f, 0.f, 0.f, 0.f};
        G_LOAD(0); G_STORE(0); __syncthreads();
        for (int kt = 0; kt < nt; ++kt) {
            const int buf = kt & 1;
            if (kt + 1 < nt) G_LOAD(kt + 1);
            const char* As = lds + buf * 32768; const char* Bs = lds + 65536 + buf * 16384;
#pragma unroll
            for (int kk = 0; kk < 2; ++kk) {
                bf16x8 af[4], bfr[4];
#pragma unroll
                for (int mi = 0; mi < 4; ++mi) { const int row = 64 * wr + 16 * mi + (lane & 15), ch = 4 * kk + (lane >> 4); af[mi] = *(const bf16x8*)(As + row * 128 + ((ch ^ (row & 7)) << 4)); }
#pragma unroll
                for (int ni = 0; ni < 4; ++ni) { const int row = 64 * wc + 16 * ni + (lane & 15), ch = 4 * kk + (lane >> 4); bfr[ni] = *(const bf16x8*)(Bs + row * 128 + ((ch ^ (row & 7)) << 4)); }
#pragma unroll
                for (int mi = 0; mi < 4; ++mi)
#pragma unroll
                    for (int ni = 0; ni < 4; ++ni) acc[mi][ni] = __builtin_amdgcn_mfma_f32_16x16x32_bf16(bfr[ni], af[mi], acc[mi][ni], 0, 0, 0);
            }
            if (kt + 1 < nt) G_STORE(buf ^ 1);
            __syncthreads();
        }
#undef G_LOAD
#undef G_STORE
#pragma unroll
        for (int mi = 0; mi < 4; ++mi)
#pragma unroll
            for (int ni = 0; ni < 4; ++ni) {
                const int row = m0 + 64 * wr + 16 * mi + (lane & 15), col = n0 + 64 * wc + 16 * ni + 4 * (lane >> 4);
                if (col < N) epi(row, col, acc[mi][ni]);
            }
    }
}


namespace pg8 {
#define PG8_LAS __attribute__((address_space(3)))
constexpr int BM = 256, BK = 64, HALF = 128, HTB = HALF * BK * 2, STAGE_BYTES = 8 * HTB, NXCD = 8, WGM = 8;
__host__ __device__ __forceinline__ int lds_byte(int r, int c) { const int st = (r >> 4) * 2 + (c >> 5), rr = r & 15, cc = c & 31, ob = rr * 64 + cc * 2; return st * 1024 + (ob ^ (((ob >> 9) & 1) << 5)); }
__host__ __device__ __forceinline__ void stage_rc(int b, int& R, int& C) { const int st = b / 1024, sb = b % 1024, swz = sb ^ (((sb >> 9) & 1) << 5); R = (st >> 1) * 16 + swz / 64; C = (st & 1) * 32 + (swz % 64) / 2; }
__host__ __device__ __forceinline__ int perm32(int rho) { const int n = rho >> 4, i = rho & 15; return 8 * (i >> 2) + 4 * n + (i & 3); }
struct Unit { int pm, pn, e; };
struct Gemm { const bf16_t* A; const bf16_t* Bt; int M, N, K, lda, ldb; size_t estride; const int* rowidx; };
struct StaticOrder {
    int nM, nN, nwg, G, c; const int* blk_e;
    __device__ void init(int M, int N, int G_, int c_, const int* be = nullptr) { nM = M / BM; nN = N / BM; nwg = nM * nN; G = G_; c = c_; blk_e = be; }
    __device__ bool next(int i, Unit& u) const {
        const long L = (long)i * G + c; if (L >= nwg) return false;
        int wgid = (int)L; { const int q = nwg / NXCD, r = nwg % NXCD, xcd = wgid % NXCD, off = wgid / NXCD; wgid = (xcd < r ? xcd * (q + 1) : r * (q + 1) + (xcd - r) * q) + off; }
        const int nig = WGM * nN, gid = wgid / nig, fm = gid * WGM, gsz = (nM - fm) < WGM ? (nM - fm) : WGM;
        u.pm = fm + ((wgid % nig) % gsz); u.pn = (wgid % nig) / gsz; u.e = blk_e ? blk_e[u.pm] : 0; return true;
    }
    __device__ __forceinline__ void a_ready(const Unit&) const {}
    __device__ __forceinline__ void done(const Unit&) const {}
};
template <class F> struct Epi8 {
    static constexpr bool PERM = true, AFTER_DRAIN = false; F f;
    __device__ __forceinline__ void operator()(const f32x4 (&acc)[2][2][4][2], const Unit& u, int wr, int wc, int fr, int fq) const {
#pragma unroll
        for (int ai = 0; ai < 2; ++ai)
#pragma unroll
            for (int m = 0; m < 4; ++m) { const int row = u.pm * BM + ai * HALF + wr * 64 + m * 16 + fr;
#pragma unroll
                for (int bj = 0; bj < 2; ++bj) f(row, u.pn * BM + bj * HALF + wc * 32 + 8 * fq, acc[ai][bj][m][0], acc[ai][bj][m][1]); }
    }
};
template <class Epi, class Sched, bool ALIGN_EPI = false, bool SP2 = false, bool GATHER = false>
__device__ __forceinline__ void gemm_phase(PG8_LAS unsigned char* lds, const Gemm g, const Sched& S, const Epi& E) {
    const int tid = my_tid(), wid = __builtin_amdgcn_readfirstlane(tid >> 6), lane = tid & 63, wr = wid >> 2, wc = wid & 3, fr = lane & 15, fq = lane >> 4;
    const int K = g.K, nt = K / BK;
    unsigned voffA[2], voffB[2]; int rA[2], cA2[2];
#pragma unroll
    for (int i = 0; i < 2; ++i) { int R, C; stage_rc(tid * 16 + i * 8192, R, C); const int Rb = Epi::PERM ? ((R & ~31) + perm32(R & 31)) : R; rA[i] = R; cA2[i] = C * 2;
        voffA[i] = (unsigned)(R * g.lda + C) * 2u; voffB[i] = (unsigned)(Rb * g.ldb + C) * 2u; }
    unsigned vAc[2][2], vAn[2][2];
#define PG8_VA(dst, pmv) do { _Pragma("unroll") for (int h_ = 0; h_ < 2; ++h_) _Pragma("unroll") for (int i_ = 0; i_ < 2; ++i_) { \
        if constexpr (GATHER) dst[h_][i_] = (unsigned)g.rowidx[(pmv) * BM + h_ * HALF + rA[i_]] * (unsigned)(g.lda * 2) + (unsigned)cA2[i_]; \
        else dst[h_][i_] = voffA[i_] + (unsigned)(h_ * HALF * g.lda * 2); } } while (0)
    const size_t kstep = (size_t)(BK * 2);
    const size_t hstepA = (size_t)HALF * g.lda * 2, hstepB = (size_t)HALF * g.ldb * 2;
    const size_t tstepA = 2 * hstepA, tstepB = 2 * hstepB, estep = g.estride * 2;
    const unsigned ldsw = (unsigned)wid * 1024u;
    const int aoff = lds_byte(wr * 64 + fr, fq * 8), boff = lds_byte(wc * 32 + fr, fq * 8);
#define PG8_SA(b, h) (((b) * 2 + (h)) * HTB)
#define PG8_SB(b, h) ((4 + (b) * 2 + (h)) * HTB)
#define PG8_STAGE(bufoff, gbase, voff) do { _Pragma("unroll") for (int _i = 0; _i < 2; ++_i) \
        __builtin_amdgcn_global_load_lds((const unsigned*)((const char*)(gbase) + (voff)[_i]), (PG8_LAS unsigned*)(lds + (bufoff) + ldsw + _i * 8192), 16, 0, 0); } while (0)
#define PG8_LDA(dst, b, h) do { _Pragma("unroll") for (int m = 0; m < 4; ++m) _Pragma("unroll") for (int k = 0; k < 2; ++k) dst[m][k] = *(const PG8_LAS bf16x8*)(lds + PG8_SA(b, h) + aoff + m * 2048 + k * 1024); } while (0)
#define PG8_LDB(dst, b, h) do { _Pragma("unroll") for (int n = 0; n < 2; ++n) _Pragma("unroll") for (int k = 0; k < 2; ++k) dst[n][k] = *(const PG8_LAS bf16x8*)(lds + PG8_SB(b, h) + boff + n * 2048 + k * 1024); } while (0)
#define PG8_MMA(ai, bj, At, Bt) do { __builtin_amdgcn_s_setprio(1); _Pragma("unroll") for (int m = 0; m < 4; ++m) _Pragma("unroll") for (int n = 0; n < 2; ++n) _Pragma("unroll") for (int k = 0; k < 2; ++k) \
        acc[ai][bj][m][n] = __builtin_amdgcn_mfma_f32_16x16x32_bf16(Bt[n][k], At[m][k], acc[ai][bj][m][n], 0, 0, 0); __builtin_amdgcn_s_setprio(0); } while (0)
#define PG8_WAIT_V(n) asm volatile("s_waitcnt vmcnt(" #n ")" ::: "memory")
#define PG8_WAIT_L(n) asm volatile("s_waitcnt lgkmcnt(" #n ")" ::: "memory")
#define PG8_BAR __builtin_amdgcn_s_barrier()
#define PG8_SCHED __builtin_amdgcn_sched_barrier(0)
    Unit cur, nxt; int ui = 0;
    if (!S.next(0, cur)) return;
    f32x4 acc[2][2][4][2];
#pragma unroll
    for (int a = 0; a < 2; ++a)
#pragma unroll
        for (int b = 0; b < 2; ++b)
#pragma unroll
            for (int m = 0; m < 4; ++m)
#pragma unroll
                for (int n = 0; n < 2; ++n) acc[a][b][m][n] = (f32x4){0.f, 0.f, 0.f, 0.f};
    bf16x8 At[4][2], B0[2][2], B1[2][2];
    const char* cA = (const char*)g.A + (GATHER ? (size_t)0 : (size_t)cur.pm * tstepA); const char* cB = (const char*)g.Bt + (size_t)cur.e * estep + (size_t)cur.pn * tstepB;
    PG8_VA(vAc, cur.pm);
    S.a_ready(cur);
    if constexpr (SP2) {
        PG8_STAGE(PG8_SB(0, 0), cB, voffB); PG8_STAGE(PG8_SB(0, 1), cB + hstepB, voffB); PG8_STAGE(PG8_SA(0, 0), cA, vAc[0]); PG8_STAGE(PG8_SA(0, 1), cA, vAc[1]);
        if (wr == 1) PG8_BAR;
        PG8_WAIT_V(2); PG8_BAR;
        PG8_STAGE(PG8_SB(1, 0), cB + kstep, voffB); PG8_STAGE(PG8_SA(1, 0), cA + kstep, vAc[0]); PG8_STAGE(PG8_SB(1, 1), cB + hstepB + kstep, voffB);
        PG8_WAIT_V(6); PG8_BAR;
    } else {
        PG8_STAGE(PG8_SB(0, 0), cB, voffB); PG8_STAGE(PG8_SA(0, 0), cA, voffA); PG8_STAGE(PG8_SB(0, 1), cB + hstepB, voffB); PG8_STAGE(PG8_SA(0, 1), cA + hstepA, voffA);
        if (wr == 1) PG8_BAR;
        PG8_WAIT_V(4); PG8_BAR;
        PG8_STAGE(PG8_SB(1, 0), cB + kstep, voffB); PG8_STAGE(PG8_SA(1, 0), cA + kstep, voffA); PG8_STAGE(PG8_SB(1, 1), cB + hstepB + kstep, voffB);
        PG8_WAIT_V(6); PG8_BAR;
    }
    for (;;) {
        const bool has_next = S.next(ui + 1, nxt);
        const char* nA = (has_next && !GATHER) ? (const char*)g.A + (size_t)nxt.pm * tstepA : cA; PG8_VA(vAn, (has_next ? nxt.pm : cur.pm)); const char* nB = has_next ? (const char*)g.Bt + (size_t)nxt.e * estep + (size_t)nxt.pn * tstepB : cB;
        for (int t = 0; t < nt; t += 2) {
            const bool last = (t == nt - 2);
            const char* a1 = cA + (size_t)(t + 1) * kstep;
            const char* a2 = last ? nA : cA + (size_t)(t + 2) * kstep; const char* b2 = last ? nB : cB + (size_t)(t + 2) * kstep;
            const char* a3 = a2 + kstep; const char* b3 = b2 + kstep;
            unsigned v2[2][2];
#pragma unroll
            for (int h_ = 0; h_ < 2; ++h_)
#pragma unroll
                for (int i_ = 0; i_ < 2; ++i_) v2[h_][i_] = last ? vAn[h_][i_] : vAc[h_][i_];
            if (last && has_next) S.a_ready(nxt);
            if constexpr (SP2) {
            PG8_LDB(B0, 0, 0); PG8_LDB(B1, 0, 1); PG8_SCHED; PG8_LDA(At, 0, 0); PG8_STAGE(PG8_SA(1, 1), a1, vAc[1]);
            PG8_WAIT_V(8); PG8_WAIT_L(0); PG8_BAR; PG8_MMA(0, 0, At, B0); PG8_MMA(0, 1, At, B1); PG8_BAR; PG8_SCHED;
            PG8_LDA(At, 0, 1); PG8_STAGE(PG8_SB(0, 0), b2, voffB); PG8_STAGE(PG8_SB(0, 1), b2 + hstepB, voffB); PG8_STAGE(PG8_SA(0, 0), a2, v2[0]);
            PG8_WAIT_V(8); PG8_WAIT_L(0); PG8_BAR; PG8_MMA(1, 0, At, B0); PG8_MMA(1, 1, At, B1); PG8_BAR; PG8_SCHED;
            PG8_LDB(B0, 1, 0); PG8_LDB(B1, 1, 1); PG8_SCHED; PG8_LDA(At, 1, 0); PG8_STAGE(PG8_SA(0, 1), a2, v2[1]);
            PG8_WAIT_V(8); PG8_WAIT_L(0); PG8_BAR; PG8_MMA(0, 0, At, B0); PG8_MMA(0, 1, At, B1); PG8_BAR; PG8_SCHED;
            PG8_LDA(At, 1, 1); PG8_STAGE(PG8_SB(1, 0), b3, voffB); PG8_STAGE(PG8_SB(1, 1), b3 + hstepB, voffB); PG8_STAGE(PG8_SA(1, 0), a3, v2[0]);
            PG8_WAIT_V(8); PG8_WAIT_L(0); PG8_BAR; PG8_MMA(1, 0, At, B0); PG8_MMA(1, 1, At, B1); PG8_BAR; PG8_SCHED;
            } else {
            PG8_LDB(B0, 0, 0); PG8_SCHED; PG8_LDA(At, 0, 0); PG8_STAGE(PG8_SA(1, 1), a1 + hstepA, voffA);
            PG8_WAIT_L(8); PG8_BAR; PG8_WAIT_L(0); PG8_MMA(0, 0, At, B0); PG8_BAR; PG8_SCHED;
            PG8_LDB(B1, 0, 1); PG8_STAGE(PG8_SB(0, 0), b2, voffB);
            PG8_BAR; PG8_WAIT_L(0); PG8_MMA(0, 1, At, B1); PG8_BAR;
            PG8_LDA(At, 0, 1); PG8_STAGE(PG8_SA(0, 0), a2, voffA);
            PG8_BAR; PG8_WAIT_L(0); PG8_MMA(1, 0, At, B0); PG8_BAR; PG8_SCHED;
            PG8_STAGE(PG8_SB(0, 1), b2 + hstepB, voffB);
            PG8_WAIT_V(6); PG8_BAR; PG8_MMA(1, 1, At, B1); PG8_BAR;
            PG8_LDB(B0, 1, 0); PG8_SCHED; PG8_LDA(At, 1, 0); PG8_STAGE(PG8_SA(0, 1), a2 + hstepA, voffA);
            PG8_WAIT_L(8); PG8_BAR; PG8_WAIT_L(0); PG8_MMA(0, 0, At, B0); PG8_BAR; PG8_SCHED;
            PG8_LDB(B1, 1, 1); PG8_STAGE(PG8_SB(1, 0), b3, voffB);
            PG8_BAR; PG8_WAIT_L(0); PG8_MMA(0, 1, At, B1); PG8_BAR;
            PG8_LDA(At, 1, 1); PG8_STAGE(PG8_SA(1, 0), a3, voffA);
            PG8_BAR; PG8_WAIT_L(0); PG8_MMA(1, 0, At, B0); PG8_BAR; PG8_SCHED;
            PG8_STAGE(PG8_SB(1, 1), b3 + hstepB, voffB);
            PG8_WAIT_V(6); PG8_BAR; PG8_MMA(1, 1, At, B1); PG8_BAR;
            }
        }
        if constexpr (ALIGN_EPI) { if (wr == 0) PG8_BAR; }
        if constexpr (!Epi::AFTER_DRAIN) { E(acc, cur, wr, wc, fr, fq); S.done(cur); }
        if (!has_next) break;
#pragma unroll
        for (int a = 0; a < 2; ++a)
#pragma unroll
            for (int b = 0; b < 2; ++b)
#pragma unroll
                for (int m = 0; m < 4; ++m)
#pragma unroll
                    for (int n = 0; n < 2; ++n) acc[a][b][m][n] = (f32x4){0.f, 0.f, 0.f, 0.f};
        cur = nxt; cA = nA; cB = nB; ++ui;
#pragma unroll
        for (int h_ = 0; h_ < 2; ++h_)
#pragma unroll
            for (int i_ = 0; i_ < 2; ++i_) vAc[h_][i_] = vAn[h_][i_];
        if constexpr (ALIGN_EPI) { if (wr == 1) PG8_BAR; }
    }
    PG8_WAIT_V(0);
    if constexpr (!ALIGN_EPI) { if (wr == 0) PG8_BAR; }
    PG8_BAR;
    if constexpr (Epi::AFTER_DRAIN) { E.fused(acc, cur, wr, wc, fr, fq, lds, wid, lane); S.done(cur); }
#undef PG8_VA
#undef PG8_SA
#undef PG8_SB
#undef PG8_STAGE
#undef PG8_LDA
#undef PG8_LDB
#undef PG8_MMA
#undef PG8_WAIT_V
#undef PG8_WAIT_L
#undef PG8_BAR
#undef PG8_SCHED
}
}

struct F8Bf16 { bf16_t* out; int ld;
    DEVI void operator()(int row, int col, f32x4 a, f32x4 b) const { u32x4 w; w.x = pk2(a.x, a.y); w.y = pk2(a.z, a.w); w.z = pk2(b.x, b.y); w.w = pk2(b.z, b.w); *(u32x4*)(out + (size_t)row * ld + col) = w; } };
struct F8Resid { const float* x; bf16_t* out;
    DEVI void operator()(int row, int col, f32x4 a, f32x4 b) const { const float* xp = x + (size_t)row * DM + col;
        a = a + *(const f32x4*)xp; b = b + *(const f32x4*)(xp + 4);
        u32x4 w; w.x = pk2(a.x, a.y); w.y = pk2(a.z, a.w); w.z = pk2(b.x, b.y); w.w = pk2(b.z, b.w); *(u32x4*)(out + (size_t)row * DM + col) = w; } };
struct F8Swiglu { bf16_t* hid;
    DEVI void operator()(int row, int col, f32x4 a, f32x4 b) const {
        u32x2 w; w.x = pk2(a.x * sigmoidf_(a.x) * a.y, a.z * sigmoidf_(a.z) * a.w); w.y = pk2(b.x * sigmoidf_(b.x) * b.y, b.z * sigmoidf_(b.z) * b.w);
        *(u32x2*)(hid + (size_t)row * DEXP + (col >> 1)) = w; } };
struct F8Mix { const bf16_t* gl; const bf16_t* bm; bf16_t* mixed; const float* gb;
    DEVI void operator()(int row, int col, f32x4 a, f32x4 b) const {
        const u32x4 g1 = *(const u32x4*)(gl + (size_t)row * 2048 + col), g2 = *(const u32x4*)(gl + (size_t)row * 2048 + 1024 + col);
        const u32x4 m = *(const u32x4*)(bm + (size_t)row * 1024 + col);
        const f32x4 b0a = *(const f32x4*)(gb + col), b0b = *(const f32x4*)(gb + col + 4), b1a = *(const f32x4*)(gb + 1024 + col), b1b = *(const f32x4*)(gb + 1024 + col + 4);
        float r[8];
        r[0] = sigmoidf_(lo16(g1.x) + b0a.x) * lo16(m.x) + sigmoidf_(lo16(g2.x) + b1a.x) * a.x;
        r[1] = sigmoidf_(hi16(g1.x) + b0a.y) * hi16(m.x) + sigmoidf_(hi16(g2.x) + b1a.y) * a.y;
        r[2] = sigmoidf_(lo16(g1.y) + b0a.z) * lo16(m.y) + sigmoidf_(lo16(g2.y) + b1a.z) * a.z;
        r[3] = sigmoidf_(hi16(g1.y) + b0a.w) * hi16(m.y) + sigmoidf_(hi16(g2.y) + b1a.w) * a.w;
        r[4] = sigmoidf_(lo16(g1.z) + b0b.x) * lo16(m.z) + sigmoidf_(lo16(g2.z) + b1b.x) * b.x;
        r[5] = sigmoidf_(hi16(g1.z) + b0b.y) * hi16(m.z) + sigmoidf_(hi16(g2.z) + b1b.y) * b.y;
        r[6] = sigmoidf_(lo16(g1.w) + b0b.z) * lo16(m.w) + sigmoidf_(lo16(g2.w) + b1b.z) * b.z;
        r[7] = sigmoidf_(hi16(g1.w) + b0b.w) * hi16(m.w) + sigmoidf_(hi16(g2.w) + b1b.w) * b.w;
        u32x4 w; w.x = pk2(r[0], r[1]); w.y = pk2(r[2], r[3]); w.z = pk2(r[4], r[5]); w.w = pk2(r[6], r[7]);
        *(u32x4*)(mixed + (size_t)row * 1024 + col) = w; } };
template <class F, bool GATHER = false>
DEVI void big_gemm_(char* lds, const bf16_t* A, int lda, const bf16_t* Bt, int ldb, int M, int N, int K, const F& f, int bid, int nb, const int* blk_e, size_t estride, const int* rowidx) {
    int Kr = K; asm volatile("" : "+s"(Kr));
    pg8::Gemm g{A, Bt, M, N, Kr, lda, ldb, estride, rowidx}; pg8::StaticOrder S; S.init(M, N, nb, bid, blk_e);
    pg8::Epi8<F> E{f};
    pg8::gemm_phase<pg8::Epi8<F>, pg8::StaticOrder, true, true, GATHER>((PG8_LAS unsigned char*)lds, g, S, E);
}
template <class F>
DEVI void big_gemm(char* lds, const bf16_t* A, int lda, const bf16_t* Bt, int ldb, int M, int N, int K, const F& f, int bid, int nb, const int* blk_e = nullptr, size_t estride = 0) {
    big_gemm_<F, false>(lds, A, lda, Bt, ldb, M, N, K, f, bid, nb, blk_e, estride, nullptr);
}

struct EpiGate { static constexpr bool PERM = true, AFTER_DRAIN = false; const bf16_t* bm; const bf16_t* br; bf16_t* mixed; const float* gb;
    __device__ __forceinline__ void operator()(const f32x4 (&acc)[2][2][4][2], const pg8::Unit& u, int wr, int wc, int fr, int fq) const {
        const int oc = u.pn * 128 + wc * 32 + 8 * fq;
        const f32x4 b0a = *(const f32x4*)(gb + oc), b0b = *(const f32x4*)(gb + oc + 4), b1a = *(const f32x4*)(gb + 1024 + oc), b1b = *(const f32x4*)(gb + 1024 + oc + 4);
#pragma unroll
        for (int ai = 0; ai < 2; ++ai)
#pragma unroll
            for (int m = 0; m < 4; ++m) { const int row = u.pm * pg8::BM + ai * pg8::HALF + wr * 64 + m * 16 + fr;
                const u32x4 mm = *(const u32x4*)(bm + (size_t)row * 1024 + oc), rr = *(const u32x4*)(br + (size_t)row * 1024 + oc);
                const f32x4 g1a = acc[ai][0][m][0], g1b = acc[ai][0][m][1], g2a = acc[ai][1][m][0], g2b = acc[ai][1][m][1];
                float r[8];
                r[0] = sigmoidf_(g1a.x + b0a.x) * lo16(mm.x) + sigmoidf_(g2a.x + b1a.x) * lo16(rr.x);
                r[1] = sigmoidf_(g1a.y + b0a.y) * hi16(mm.x) + sigmoidf_(g2a.y + b1a.y) * hi16(rr.x);
                r[2] = sigmoidf_(g1a.z + b0a.z) * lo16(mm.y) + sigmoidf_(g2a.z + b1a.z) * lo16(rr.y);
                r[3] = sigmoidf_(g1a.w + b0a.w) * hi16(mm.y) + sigmoidf_(g2a.w + b1a.w) * hi16(rr.y);
                r[4] = sigmoidf_(g1b.x + b0b.x) * lo16(mm.z) + sigmoidf_(g2b.x + b1b.x) * lo16(rr.z);
                r[5] = sigmoidf_(g1b.y + b0b.y) * hi16(mm.z) + sigmoidf_(g2b.y + b1b.y) * hi16(rr.z);
                r[6] = sigmoidf_(g1b.z + b0b.z) * lo16(mm.w) + sigmoidf_(g2b.z + b1b.z) * lo16(rr.w);
                r[7] = sigmoidf_(g1b.w + b0b.w) * hi16(mm.w) + sigmoidf_(g2b.w + b1b.w) * hi16(rr.w);
                u32x4 w; w.x = pk2(r[0], r[1]); w.y = pk2(r[2], r[3]); w.z = pk2(r[4], r[5]); w.w = pk2(r[6], r[7]);
                *(u32x4*)(mixed + (size_t)row * 1024 + oc) = w; }
    }
};
template <class E>
DEVI void big_gemm_epi(char* lds, const bf16_t* A, int lda, const bf16_t* Bt, int ldb, int M, int N, int K, const E& e, int bid, int nb) {
    int Kr = K; asm volatile("" : "+s"(Kr));
    pg8::Gemm g{A, Bt, M, N, Kr, lda, ldb, 0, nullptr}; pg8::StaticOrder S; S.init(M, N, nb, bid, nullptr);
    pg8::gemm_phase<E, pg8::StaticOrder, true, true, false>((PG8_LAS unsigned char*)lds, g, S, e);
}

DEVI void stage_mla_prep(const Params& p, int bid, int nb, bool dry = false) {
    const int lane = my_tid() & 63, wave = my_tid() >> 6;
    const int gw = bid * NWAVES + wave, NGW = nb * NWAVES;
    bf16_t* z = (bf16_t*)(p.ws + OFF_Z); bf16_t* krope = (bf16_t*)(p.ws + OFF_KROPE);
    const float* ct = (const float*)(p.ws + OFF_ROPE); const float* st = ct + SEQ * 16;
    const float* gq = p.in[3]; const float* gkv = p.in[4];
    for (int t = gw; t < T_; t += NGW) {
        bf16_t* zr = z + (size_t)t * LDZ;
        const u32x4 A = *(const u32x4*)(zr + 8 * lane);
        u32x4 B = {0u, 0u, 0u, 0u}; if (lane < 16) B = *(const u32x4*)(zr + 512 + 8 * lane);
        float a[8], b[8];
        a[0] = lo16(A.x); a[1] = hi16(A.x); a[2] = lo16(A.y); a[3] = hi16(A.y); a[4] = lo16(A.z); a[5] = hi16(A.z); a[6] = lo16(A.w); a[7] = hi16(A.w);
        b[0] = lo16(B.x); b[1] = hi16(B.x); b[2] = lo16(B.y); b[3] = hi16(B.y); b[4] = lo16(B.z); b[5] = hi16(B.z); b[6] = lo16(B.w); b[7] = hi16(B.w);
        float sa = 0.f, sb = 0.f;
#pragma unroll
        for (int j = 0; j < 8; ++j) { sa += a[j] * a[j]; sb += b[j] * b[j]; }
        const bool isq = lane < 48;
        const float ssq = wave_sum(isq ? sa : 0.f), sskv = wave_sum((isq ? 0.f : sa) + sb);
        const float rq = rsqrtf(ssq * (1.f / 384.f) + 1e-6f), rkv = rsqrtf(sskv * (1.f / 256.f) + 1e-6f);
        {
            const float r = isq ? rq : rkv; const float* g = isq ? gq + 8 * lane : gkv + 8 * (lane - 48);
            u32x4 o; o.x = pk2(a[0] * r * g[0], a[1] * r * g[1]); o.y = pk2(a[2] * r * g[2], a[3] * r * g[3]); o.z = pk2(a[4] * r * g[4], a[5] * r * g[5]); o.w = pk2(a[6] * r * g[6], a[7] * r * g[7]);
            if (!dry) *(u32x4*)(zr + 8 * lane) = o; else asm volatile("" :: "v"(o));
        }
        if (lane < 16) {
            const float* g = gkv + 8 * (lane + 16);
            u32x4 o; o.x = pk2(b[0] * rkv * g[0], b[1] * rkv * g[1]); o.y = pk2(b[2] * rkv * g[2], b[3] * rkv * g[3]); o.z = pk2(b[4] * rkv * g[4], b[5] * rkv * g[5]); o.w = pk2(b[6] * rkv * g[6], b[7] * rkv * g[7]);
            if (!dry) *(u32x4*)(zr + 512 + 8 * lane) = o; else asm volatile("" :: "v"(o));
        }
    }
    const bf16_t* hb = (const bf16_t*)(p.ws + OFF_H); const bf16_t* wkr = (const bf16_t*)(p.ws + OFF_WKR);
    for (int tb = gw * 16; tb < T_; tb += NGW * 16) {
        const int li = lane & 15, kq = lane >> 4;
        const bf16_t* ap = hb + (size_t)(tb + li) * DM + 8 * kq; const bf16_t* b0p = wkr + (size_t)li * DM + 8 * kq; const bf16_t* b1p = b0p + 16 * DM;
        f32x4 a0 = {0.f, 0.f, 0.f, 0.f}, a1 = a0;
#pragma unroll 8
        for (int ks = 0; ks < 32; ++ks) {
            const bf16x8 av = *(const bf16x8*)(ap + 32 * ks);
            a0 = __builtin_amdgcn_mfma_f32_16x16x32_bf16(av, *(const bf16x8*)(b0p + 32 * ks), a0, 0, 0, 0);
            a1 = __builtin_amdgcn_mfma_f32_16x16x32_bf16(av, *(const bf16x8*)(b1p + 32 * ks), a1, 0, 0, 0);
        }
#pragma unroll
        for (int r = 0; r < 4; ++r) { const int t = tb + 4 * kq + r, pos = t & (SEQ - 1);
            const float c = ct[pos * 16 + li], s = st[pos * 16 + li];
            if (!dry) { krope[(size_t)t * 32 + li] = (bf16_t)f2bf(a0[r] * c - a1[r] * s); krope[(size_t)t * 32 + 16 + li] = (bf16_t)f2bf(a0[r] * s + a1[r] * c); } }
    }
}

DEVI void stage_sg_prep(const Params& p, int bid, int nb) {
    const bf16_t* z = (const bf16_t*)(p.ws + OFF_Z); bf16_t* sg = (bf16_t*)(p.ws + OFF_SG);
    const float* mup = p.in[8] + 1792; const float* mun = p.in[9] + 1792;
    for (int i = bid * NTHREADS + my_tid(); i < T_ * 32; i += nb * NTHREADS) {
        const int t = i >> 5, c = (i & 31) * 8, s = t & (SEQ - 1);
        u32x4 o = {0u, 0u, 0u, 0u};
        if (c < 128) {
            const bf16_t* zp = z + (size_t)t * LDZ + ZR + 1792 + c;
            const u32x4 z4 = {0u, 0u, 0u, 0u};
            const u32x4 w0 = *(const u32x4*)zp, wm = (s > 0) ? *(const u32x4*)(zp - LDZ) : z4, wn = (s < SEQ - 1) ? *(const u32x4*)(zp + LDZ) : z4;
            const float z0[8] = {lo16(w0.x), hi16(w0.x), lo16(w0.y), hi16(w0.y), lo16(w0.z), hi16(w0.z), lo16(w0.w), hi16(w0.w)};
            const float zm[8] = {lo16(wm.x), hi16(wm.x), lo16(wm.y), hi16(wm.y), lo16(wm.z), hi16(wm.z), lo16(wm.w), hi16(wm.w)};
            const float zn[8] = {lo16(wn.x), hi16(wn.x), lo16(wn.y), hi16(wn.y), lo16(wn.z), hi16(wn.z), lo16(wn.w), hi16(wn.w)};
            float r[8];
#pragma unroll
            for (int j = 0; j < 8; ++j) r[j] = sigmoidf_(z0[j] + mup[c + j] * (zm[j] - z0[j]) + mun[c + j] * (zn[j] - z0[j]));
            o.x = pk2(r[0], r[1]); o.y = pk2(r[2], r[3]); o.z = pk2(r[4], r[5]); o.w = pk2(r[6], r[7]);
        }
        *(u32x4*)(sg + (size_t)t * 256 + c) = o;
    }
}

DEVI float max3f_(float a, float b, float c) { return __builtin_fmaxf(__builtin_fmaxf(a, b), c); }
constexpr int KROW = 208, VROW = 192;
constexpr int ATT_KB = 64 * KROW, ATT_VB = 64 * VROW;
DEVI void attn_unit(const Params& p, int u, char* lds) {
    const int tid = my_tid(), lane = tid & 63, wid = tid >> 6, r32 = lane & 31, hi = lane >> 5;
    const int bh = u >> 3, qb = u & 7, b = bh >> 3, h = bh & 7;
    const bf16_t* qraw = (const bf16_t*)((const char*)p.out + DOFF_QRAW);
    const bf16_t* kvraw = (const bf16_t*)((const char*)p.out + DOFF_KVRAW);
    const bf16_t* krope = (const bf16_t*)(p.ws + OFF_KROPE);
    const float* ct = (const float*)(p.ws + OFF_ROPE); const float* st = ct + SEQ * 16;
    bf16_t* omla = (bf16_t*)(p.ws + OFF_OMLA);
    const size_t rowb = (size_t)b * SEQ;
    const int sq = qb * 256 + wid * 32 + r32;
    const float QS = 0.10206207261596577f * 1.4426950408889634f;
    bf16x8 qf[6];
    {
        const bf16_t* qp = qraw + (rowb + sq) * 768 + h * 96;
        u32x4 w[6];
#pragma unroll
        for (int ks = 0; ks < 6; ++ks) w[ks] = *(const u32x4*)(qp + 16 * ks + 8 * hi);
#pragma unroll
        for (int ks = 0; ks < 4; ++ks) {
            u32x4 o; o.x = pk2(lo16(w[ks].x) * QS, hi16(w[ks].x) * QS); o.y = pk2(lo16(w[ks].y) * QS, hi16(w[ks].y) * QS);
            o.z = pk2(lo16(w[ks].z) * QS, hi16(w[ks].z) * QS); o.w = pk2(lo16(w[ks].w) * QS, hi16(w[ks].w) * QS);
            qf[ks] = __builtin_bit_cast(bf16x8, o);
        }
        float x1[8], x2[8], y1[8], y2[8];
        x1[0] = lo16(w[4].x); x1[1] = hi16(w[4].x); x1[2] = lo16(w[4].y); x1[3] = hi16(w[4].y); x1[4] = lo16(w[4].z); x1[5] = hi16(w[4].z); x1[6] = lo16(w[4].w); x1[7] = hi16(w[4].w);
        x2[0] = lo16(w[5].x); x2[1] = hi16(w[5].x); x2[2] = lo16(w[5].y); x2[3] = hi16(w[5].y); x2[4] = lo16(w[5].z); x2[5] = hi16(w[5].z); x2[6] = lo16(w[5].w); x2[7] = hi16(w[5].w);
#pragma unroll
        for (int j = 0; j < 8; ++j) { const float c = ct[sq * 16 + 8 * hi + j], s = st[sq * 16 + 8 * hi + j]; y1[j] = (x1[j] * c - x2[j] * s) * QS; y2[j] = (x1[j] * s + x2[j] * c) * QS; }
        u32x4 o4, o5;
        o4.x = pk2(y1[0], y1[1]); o4.y = pk2(y1[2], y1[3]); o4.z = pk2(y1[4], y1[5]); o4.w = pk2(y1[6], y1[7]);
        o5.x = pk2(y2[0], y2[1]); o5.y = pk2(y2[2], y2[3]); o5.z = pk2(y2[4], y2[5]); o5.w = pk2(y2[6], y2[7]);
        qf[4] = __builtin_bit_cast(bf16x8, o4); qf[5] = __builtin_bit_cast(bf16x8, o5);
    }
    const int kp0r = tid / 12, kp0c = tid % 12;
    const int kp1 = 512 + tid, kp1r = kp1 / 12, kp1c = kp1 % 12;
    const int vr = tid >> 3, vc = tid & 7;
    u32x4 rk0, rk1, rv;
#define A_LOAD(t) do { const size_t base = rowb + (size_t)(t) * 64; \
        rk0 = (kp0c < 8) ? *(const u32x4*)(kvraw + (base + kp0r) * 1024 + h * 128 + 8 * kp0c) : *(const u32x4*)(krope + (base + kp0r) * 32 + 8 * (kp0c - 8)); \
        if (tid < 256) rk1 = (kp1c < 8) ? *(const u32x4*)(kvraw + (base + kp1r) * 1024 + h * 128 + 8 * kp1c) : *(const u32x4*)(krope + (base + kp1r) * 32 + 8 * (kp1c - 8)); \
        rv = *(const u32x4*)(kvraw + (base + vr) * 1024 + h * 128 + 64 + 8 * vc); } while (0)
#define A_STORE(buf) do { char* Kb_ = lds + (buf) * ATT_KB; char* Vb_ = lds + 2 * ATT_KB + (buf) * ATT_VB; \
        *(u32x4*)(Kb_ + kp0r * KROW + kp0c * 16) = rk0; if (tid < 256) *(u32x4*)(Kb_ + kp1r * KROW + kp1c * 16) = rk1; \
        *(u32x4*)(Vb_ + vr * VROW + vc * 16) = rv; } while (0)
    float mhat = 0.f, l = 0.f;
    f32x16 o0, o1, negm;
#pragma unroll
    for (int r = 0; r < 16; ++r) { o0[r] = 0.f; o1[r] = 0.f; negm[r] = 0.f; }
    A_LOAD(0); A_STORE(0); __syncthreads();
    constexpr int NT = SEQ / 64;
    for (int t = 0; t < NT; ++t) {
        const int buf = t & 1;
        if (t + 1 < NT) A_LOAD(t + 1);
        const char* Kb = lds + buf * ATT_KB; const char* Vb = lds + 2 * ATT_KB + buf * ATT_VB;
        f32x16 p0 = negm, p1 = negm;
#pragma unroll
        for (int ks = 0; ks < 6; ++ks) {
            const bf16x8 k0 = *(const bf16x8*)(Kb + r32 * KROW + 32 * ks + 16 * hi);
            const bf16x8 k1 = *(const bf16x8*)(Kb + (32 + r32) * KROW + 32 * ks + 16 * hi);
            p0 = __builtin_amdgcn_mfma_f32_32x32x16_bf16(k0, qf[ks], p0, 0, 0, 0);
            p1 = __builtin_amdgcn_mfma_f32_32x32x16_bf16(k1, qf[ks], p1, 0, 0, 0);
        }
        float mxa = max3f_(p0[0], p0[1], p1[0]), mxb = max3f_(p0[2], p0[3], p1[1]); mxa = max3f_(mxa, p1[2], p1[3]);
#pragma unroll
        for (int r = 4; r < 16; r += 4) { mxa = max3f_(mxa, p0[r], p0[r + 1]); mxb = max3f_(mxb, p0[r + 2], p0[r + 3]); mxa = max3f_(mxa, p1[r], p1[r + 1]); mxb = max3f_(mxb, p1[r + 2], p1[r + 3]); }
        float rm = max3f_(mxa, mxb, mxb); rm = max3f_(rm, __shfl_xor(rm, 32), rm);
        if (t == 0 || __any(rm > 8.f)) {
            const float dl = (t == 0) ? rm : fmaxf(rm, 0.f); mhat += dl;
            const float f = __builtin_amdgcn_exp2f(-dl); l *= f;
#pragma unroll
            for (int r = 0; r < 16; ++r) { p0[r] -= dl; p1[r] -= dl; o0[r] *= f; o1[r] *= f; negm[r] = -mhat; }
        }
        float sum = 0.f;
#pragma unroll
        for (int r = 0; r < 16; ++r) { p0[r] = __builtin_amdgcn_exp2f(p0[r]); p1[r] = __builtin_amdgcn_exp2f(p1[r]); sum += p0[r] + p1[r]; }
        l += sum;
        bf16x8 pb[4];
        {
            u32x4 w;
            w.x = pk2(p0[0], p0[1]); w.y = pk2(p0[2], p0[3]); w.z = pk2(p0[4], p0[5]); w.w = pk2(p0[6], p0[7]); pb[0] = __builtin_bit_cast(bf16x8, w);
            w.x = pk2(p0[8], p0[9]); w.y = pk2(p0[10], p0[11]); w.z = pk2(p0[12], p0[13]); w.w = pk2(p0[14], p0[15]); pb[1] = __builtin_bit_cast(bf16x8, w);
            w.x = pk2(p1[0], p1[1]); w.y = pk2(p1[2], p1[3]); w.z = pk2(p1[4], p1[5]); w.w = pk2(p1[6], p1[7]); pb[2] = __builtin_bit_cast(bf16x8, w);
            w.x = pk2(p1[8], p1[9]); w.y = pk2(p1[10], p1[11]); w.z = pk2(p1[12], p1[13]); w.w = pk2(p1[14], p1[15]); pb[3] = __builtin_bit_cast(bf16x8, w);
        }
#pragma unroll
        for (int s = 0; s < 4; ++s) {
            const char* vtp = Vb + (16 * s + 4 * hi + ((lane & 15) >> 2)) * VROW + (16 * ((lane >> 4) & 1) + 4 * (lane & 3)) * 2;
            const s16x4 a0 = vtr_(vtp), a1 = vtr_(vtp + 8 * VROW);
            const s16x4 c0 = vtr_(vtp + 64), c1 = vtr_(vtp + 8 * VROW + 64);
            const bf16x8 va0 = {a0[0], a0[1], a0[2], a0[3], a1[0], a1[1], a1[2], a1[3]};
            const bf16x8 va1 = {c0[0], c0[1], c0[2], c0[3], c1[0], c1[1], c1[2], c1[3]};
            o0 = __builtin_amdgcn_mfma_f32_32x32x16_bf16(va0, pb[s], o0, 0, 0, 0);
            o1 = __builtin_amdgcn_mfma_f32_32x32x16_bf16(va1, pb[s], o1, 0, 0, 0);
        }
        if (t + 1 < NT) A_STORE(buf ^ 1);
        __syncthreads();
    }
#undef A_LOAD
#undef A_STORE
    l += __shfl_xor(l, 32);
    const float inv = 1.f / l;
    bf16_t* op = omla + (rowb + sq) * 512 + h * 64;
#pragma unroll
    for (int g = 0; g < 4; ++g) {
        const int d0 = 8 * g + 4 * hi;
        u32x2 w; w.x = pk2(o0[4 * g] * inv, o0[4 * g + 1] * inv); w.y = pk2(o0[4 * g + 2] * inv, o0[4 * g + 3] * inv);
        *(u32x2*)(op + d0) = w;
        w.x = pk2(o1[4 * g] * inv, o1[4 * g + 1] * inv); w.y = pk2(o1[4 * g + 2] * inv, o1[4 * g + 3] * inv);
        *(u32x2*)(op + 32 + d0) = w;
    }
}

typedef _Float16 f16x4 __attribute__((ext_vector_type(4)));
typedef _Float16 f16x8 __attribute__((ext_vector_type(8)));
DEVI float dppx1(float x) { return __int_as_float(__builtin_amdgcn_update_dpp(0, __float_as_int(x), 0xB1, 0xF, 0xF, false)); }
DEVI float dppx2(float x) { return __int_as_float(__builtin_amdgcn_update_dpp(0, __float_as_int(x), 0x4E, 0xF, 0xF, false)); }
DEVI float dpphm(float x) { return __int_as_float(__builtin_amdgcn_update_dpp(0, __float_as_int(x), 0x141, 0xF, 0xF, false)); }
DEVI float red8(float x) { x += dppx1(x); x += dppx2(x); x += dpphm(x); return x; }
DEVI float fmix_lo(float a, unsigned h, float c) { float d; asm("v_fma_mix_f32 %0, %1, %2, %3 op_sel_hi:[0,1,0]" : "=v"(d) : "v"(a), "v"(h), "v"(c)); return d; }
DEVI float fmix_hi(float a, unsigned h, float c) { float d; asm("v_fma_mix_f32 %0, %1, %2, %3 op_sel:[0,1,0] op_sel_hi:[0,1,0]" : "=v"(d) : "v"(a), "v"(h), "v"(c)); return d; }
DEVI float mmix_lo(float a, unsigned h) { float d; asm("v_fma_mix_f32 %0, %1, %2, 0 op_sel_hi:[0,1,0]" : "=v"(d) : "v"(a), "v"(h)); return d; }
DEVI float mmix_hi(float a, unsigned h) { float d; asm("v_fma_mix_f32 %0, %1, %2, 0 op_sel:[0,1,0] op_sel_hi:[0,1,0]" : "=v"(d) : "v"(a), "v"(h)); return d; }
DEVI float fmix2_lo(unsigned v, unsigned h, float c) { float d; asm("v_fma_mix_f32 %0, %1, %2, %3 op_sel_hi:[1,1,0]" : "=v"(d) : "v"(v), "v"(h), "v"(c)); return d; }
DEVI float fmix2_hi(unsigned v, unsigned h, float c) { float d; asm("v_fma_mix_f32 %0, %1, %2, %3 op_sel:[0,1,0] op_sel_hi:[1,1,0]" : "=v"(d) : "v"(v), "v"(h), "v"(c)); return d; }
DEVI float fmix_h0(unsigned hv, float b, float c) { float d; asm("v_fma_mix_f32 %0, %1, %2, %3 op_sel_hi:[1,0,0]" : "=v"(d) : "v"(hv), "v"(b), "v"(c)); return d; }
DEVI void unpack8(const u32x4 w, float (&f)[8]) { f[0] = lo16(w.x); f[1] = hi16(w.x); f[2] = lo16(w.y); f[3] = hi16(w.y); f[4] = lo16(w.z); f[5] = hi16(w.z); f[6] = lo16(w.w); f[7] = hi16(w.w); }
DEVI u32x4 pack8(const float (&f)[8]) { u32x4 w; w.x = pk2(f[0], f[1]); w.y = pk2(f[2], f[3]); w.z = pk2(f[4], f[5]); w.w = pk2(f[6], f[7]); return w; }
DEVI u32x4 pack8h(const float (&f)[8]) { f16x8 h;
#pragma unroll
    for (int j = 0; j < 8; ++j) h[j] = (_Float16)f[j];
    return __builtin_bit_cast(u32x4, h); }
constexpr int SLOT = 9216;
constexpr int SL_AT = 0, SL_BT = 1, SL_KT = 2, SL_RT = 3, SL_VT = 4, SL_BH = 5, SL_KH = 6, SL_S0 = 7, SL_MOFF = 8, SL_MOFFT = 9, SL_MAK = 10, SL_LRB = 11, SL_LRK = 12;
constexpr int SL_DD = 1, SL_DDT = 2, SL_N = 10, SL_NT = 12, SL_N2 = 6, SL_W1T = 8, SL_W1 = 9, SL_T = 4, SL_RHST = 1, SL_UT = 2;
constexpr int L_G = 8 * SLOT;
constexpr int L_TW = 10 * SLOT, L_AD = 11 * SLOT;
constexpr int L_ATMP = 12 * SLOT;
constexpr int L_FD = 13 * SLOT;
constexpr int L_C = L_FD + 8 * 272 * 4;
constexpr int L_SEG = L_C + (896 + 320) * 4;
constexpr int L_CHAIN_END = L_SEG + 8 * 64 * 4;
static_assert(L_CHAIN_END <= 147200, "chain LDS");
DEVI f32x16 mm_tile(f32x16 acc, const char* Yt, const char* Xt, int jt, int it, int r32, int hi) {
    const char* yp = Yt + (32 * jt + r32) * 144 + 16 * hi; const char* xp = Xt + (32 * it + r32) * 144 + 16 * hi;
#pragma unroll
    for (int ks = 0; ks < 4; ++ks) acc = __builtin_amdgcn_mfma_f32_32x32x16_bf16(*(const bf16x8*)(xp + 32 * ks), *(const bf16x8*)(yp + 32 * ks), acc, 0, 0, 0);
    return acc;
}
DEVI bf16x8 frag_tr(const char* T, int col0, int ks, int lane, int hi) {
    const char* p = T + (16 * ks + 8 * hi + ((lane & 15) >> 2)) * 144 + (col0 + 16 * ((lane >> 4) & 1) + 4 * (lane & 3)) * 2;
    const s16x4 a = vtr_(p), b = vtr_(p + 4 * 144);
    return (bf16x8){a[0], a[1], a[2], a[3], b[0], b[1], b[2], b[3]};
}
template <bool YT, bool XT>
DEVI f32x16 mm_tile2(f32x16 acc, const char* Yt, const char* Xt, int jt, int it, int lane, int r32, int hi) {
#pragma unroll
    for (int ks = 0; ks < 4; ++ks) {
        const bf16x8 yf = YT ? frag_tr(Yt, 32 * jt, ks, lane, hi) : *(const bf16x8*)(Yt + (32 * jt + r32) * 144 + 16 * hi + 32 * ks);
        const bf16x8 xf = XT ? frag_tr(Xt, 32 * it, ks, lane, hi) : *(const bf16x8*)(Xt + (32 * it + r32) * 144 + 16 * hi + 32 * ks);
        acc = __builtin_amdgcn_mfma_f32_32x32x16_bf16(xf, yf, acc, 0, 0, 0);
    }
    return acc;
}
template <class M> DEVI void st_tile(char* Ot, int jt, int it, int r32, int hi, const f32x16& acc, M mask) {
    const int row = 32 * jt + r32;
#pragma unroll
    for (int g = 0; g < 4; ++g) { const int c0 = 32 * it + 8 * g + 4 * hi;
        u32x2 w; w.x = pk2(mask(row, c0) ? acc[4 * g] : 0.f, mask(row, c0 + 1) ? acc[4 * g + 1] : 0.f); w.y = pk2(mask(row, c0 + 2) ? acc[4 * g + 2] : 0.f, mask(row, c0 + 3) ? acc[4 * g + 3] : 0.f);
        *(u32x2*)(Ot + row * 144 + c0 * 2) = w; }
}
DEVI f32x16 zero16() { f32x16 z;
#pragma unroll
    for (int r = 0; r < 16; ++r) z[r] = 0.f;
    return z; }
DEVI void chain_unit(const Params& p, int unit, char* lds) {
    const int tid0 = my_tid(); const int tid = tid0;
    const int dir = unit & 1, bh = unit >> 1, b = bh >> 3, h = bh & 7;
    const bool fwd = (dir == 0);
    const bf16_t* z = (const bf16_t*)(p.ws + OFF_Z);
    bf16_t* yout = (bf16_t*)(p.ws + (dir ? OFF_YB : OFF_YF));
    bf16_t* vout = (bf16_t*)(p.ws + OFF_VS);
    float* sout = (float*)(p.ws + OFF_SDIR) + (size_t)dir * T_ * 8;
    const size_t rowb = (size_t)b * SEQ;
    float* Cc = (float*)(lds + L_C);
    for (int i = tid; i < 448; i += NTHREADS) {
        int gi;
        if (i < 192) gi = (i >> 6) * 512 + h * 64 + (i & 63); else if (i < 256) gi = 1536 + dir * 64 + (i - 192); else if (i < 320) gi = 1664 + dir * 64 + (i - 256); else gi = 1792 + (i - 320);
        Cc[i] = p.in[8][gi]; Cc[448 + i] = p.in[9][gi];
    }
    if (tid < 64) { const int c = h * 64 + tid; Cc[896 + tid] = p.in[15][c]; Cc[960 + tid] = p.in[16][c]; Cc[1024 + tid] = p.in[17][c]; Cc[1088 + tid] = p.in[10][dir * 512 + c]; Cc[1152 + tid] = p.in[12][dir * 512 + c]; }
    for (int i = tid; i < SLOT / 16; i += NTHREADS) ((u32x4*)(lds + SL_S0 * SLOT))[i] = (u32x4){0u, 0u, 0u, 0u};
    bf16x8 wf[4];
    {
        const int lane = tid & 63, wid = __builtin_amdgcn_readfirstlane(tid >> 6), r32 = lane & 31, hi = lane >> 5, nt = (wid >> 1) & 1;
        const bf16_t* wsrc = (const bf16_t*)(p.ws + (wid < 4 ? OFF_WUP : OFF_AUP)) + ((size_t)dir * 512 + h * 64 + 32 * nt + r32) * 64 + 8 * hi;
#pragma unroll
        for (int ks = 0; ks < 4; ++ks) wf[ks] = *(const bf16x8*)(wsrc + 16 * ks);
    }
    u32x4 zl[5][3];
#define C_LOAD(c) do { const int t0_ = dir ? (SEQ - 64 * ((c) + 1)) : 64 * (c); const int ts_ = t0_ + tt; const bf16_t* zp_ = z + (rowb + ts_) * LDZ + ZR; \
        const bool hp_ = ts_ > 0, hn_ = ts_ < SEQ - 1; const u32x4 z4_ = {0u, 0u, 0u, 0u}; \
        _Pragma("unroll") for (int sg = 0; sg < 5; ++sg) { const int co_ = (sg < 3) ? (sg * 512 + h * 64 + 8 * c8) : (sg == 3 ? 1536 + dir * 64 + 8 * c8 : 1664 + dir * 64 + 8 * c8); \
            zl[sg][1] = *(const u32x4*)(zp_ + co_); zl[sg][0] = hp_ ? *(const u32x4*)(zp_ + co_ - LDZ) : z4_; zl[sg][2] = hn_ ? *(const u32x4*)(zp_ + co_ + LDZ) : z4_; } \
        } while (0)
#define SHIFT8(dst, regs, mi) do { float z0_[8], zm_[8], zn_[8]; unpack8(regs[1], z0_); unpack8(regs[0], zm_); unpack8(regs[2], zn_); \
        const f32x4 mpa_ = *(const f32x4*)(Cc + (mi)), mpb_ = *(const f32x4*)(Cc + (mi) + 4), mna_ = *(const f32x4*)(Cc + 448 + (mi)), mnb_ = *(const f32x4*)(Cc + 448 + (mi) + 4); \
        const float mp_[8] = {mpa_.x, mpa_.y, mpa_.z, mpa_.w, mpb_.x, mpb_.y, mpb_.z, mpb_.w}, mn_[8] = {mna_.x, mna_.y, mna_.z, mna_.w, mnb_.x, mnb_.y, mnb_.z, mnb_.w}; \
        _Pragma("unroll") for (int j = 0; j < 8; ++j) dst[j] = z0_[j] + mp_[j] * (zm_[j] - z0_[j]) + mn_[j] * (zn_[j] - z0_[j]); } while (0)
    f32x16 state = zero16();
    __syncthreads();
    { const int tt = tid >> 3, c8 = tid & 7; C_LOAD(0); }
    for (int c = 0; c < SEQ / 64; ++c) {
        int tid = tid0; asm volatile("" : "+v"(tid));
        const int lane = tid & 63, wid = __builtin_amdgcn_readfirstlane(tid >> 6), r32 = lane & 31, hi = lane >> 5;
        const int nt = (wid >> 1) & 1, tt2 = wid & 1, pj = nt, pi = tt2;
        const int tt = tid >> 3, c8 = tid & 7;
        const int sp = dir ? 63 - tt : tt;
        const int t0 = dir ? (SEQ - 64 * (c + 1)) : 64 * c;
        float r8[8], k8[8], v8[8], kk8[8];
        {
            float wd8[8], ad8[8];
            SHIFT8(r8, zl[0], 8 * c8); SHIFT8(k8, zl[1], 64 + 8 * c8); SHIFT8(v8, zl[2], 128 + 8 * c8); SHIFT8(wd8, zl[3], 192 + 8 * c8); SHIFT8(ad8, zl[4], 256 + 8 * c8);
#pragma unroll
            for (int j = 0; j < 8; ++j) wd8[j] = 1.f - 2.f * __builtin_amdgcn_rcpf(1.f + __expf(2.f * wd8[j]));
            *(u32x4*)(lds + L_TW + tt * 144 + c8 * 16) = pack8(wd8);
            *(u32x4*)(lds + L_AD + tt * 144 + c8 * 16) = pack8(ad8);
            float ss = 0.f;
#pragma unroll
            for (int j = 0; j < 8; ++j) { kk8[j] = k8[j] * Cc[896 + 8 * c8 + j]; ss += kk8[j] * kk8[j]; }
            ss = red8(ss);
            const float inv = 1.f / fmaxf(sqrtf(ss), 1e-12f);
#pragma unroll
            for (int j = 0; j < 8; ++j) kk8[j] *= inv;
        }
        __syncthreads();
        {
            f32x16 acc = zero16();
            const char* xt = lds + (wid < 4 ? L_TW : L_AD) + (32 * tt2 + r32) * 144 + 16 * hi;
#pragma unroll
            for (int ks = 0; ks < 4; ++ks) acc = __builtin_amdgcn_mfma_f32_32x32x16_bf16(wf[ks], *(const bf16x8*)(xt + 32 * ks), acc, 0, 0, 0);
            const int tl = 32 * tt2 + r32;
            if (wid < 4) {
                const int sl = dir ? 63 - tl : tl;
#pragma unroll
                for (int g = 0; g < 4; ++g) { const int n0 = 32 * nt + 8 * g + 4 * hi; f32x4 o;
#pragma unroll
                    for (int q = 0; q < 4; ++q) o[q] = -0.6065306597126334f * sigmoidf_(acc[4 * g + q] + Cc[1088 + n0 + q]);
                    *(f32x4*)(lds + L_G + sl * 256 + n0 * 4) = o; }
            } else {
#pragma unroll
                for (int g = 0; g < 4; ++g) { const int n0 = 32 * nt + 8 * g + 4 * hi; f16x4 o;
#pragma unroll
                    for (int q = 0; q < 4; ++q) o[q] = (_Float16)sigmoidf_(acc[4 * g + q] + Cc[1152 + n0 + q]);
                    *(f16x4*)(lds + L_ATMP + tl * 128 + n0 * 2) = o; }
            }
        }
        __syncthreads();
        float kd8[8], b8[8];
        {
            const f16x8 ah = *(const f16x8*)(lds + L_ATMP + tt * 128 + c8 * 16);
            float sp_ = 0.f;
#pragma unroll
            for (int j = 0; j < 8; ++j) { const float a = (float)ah[j];
                kd8[j] = k8[j] * (1.f + (a - 1.f) * Cc[960 + 8 * c8 + j]); b8[j] = kk8[j] * a; sp_ += r8[j] * kd8[j] * Cc[1024 + 8 * c8 + j]; }
            sp_ = red8(sp_);
            if (c8 == 0) sout[(rowb + t0 + tt) * 8 + h] = sp_;
            if (fwd) *(u32x4*)(vout + (rowb + t0 + tt) * 512 + h * 64 + 8 * c8) = pack8(v8);
            const int n = tid & 63, seg = tid >> 6; float* gp = (float*)(lds + L_G) + (8 * seg) * 64 + n; float run = 0.f;
#pragma unroll
            for (int q = 0; q < 8; ++q) { run += gp[q * 64]; gp[q * 64] = run; }
            ((float*)(lds + L_SEG))[seg * 64 + n] = run;
        }
        __syncthreads();
        {
            const int n = tid & 63, seg = tid >> 6; float off = 0.f;
            for (int q = 0; q < seg; ++q) off += ((const float*)(lds + L_SEG))[q * 64 + n];
            float* gp = (float*)(lds + L_G) + (8 * seg) * 64 + n;
#pragma unroll
            for (int q = 0; q < 8; ++q) gp[q * 64] += off;
        }
        __syncthreads();
        {
            const float* G = (const float*)(lds + L_G);
            const f32x4 ga = *(const f32x4*)(G + sp * 64 + 8 * c8), gb = *(const f32x4*)(G + sp * 64 + 8 * c8 + 4);
            const f32x4 ha = *(const f32x4*)(G + 63 * 64 + 8 * c8), hb = *(const f32x4*)(G + 63 * 64 + 8 * c8 + 4);
            f32x4 pa = {0.f, 0.f, 0.f, 0.f}, pb = pa;
            if (sp > 0) { pa = *(const f32x4*)(G + (sp - 1) * 64 + 8 * c8); pb = *(const f32x4*)(G + (sp - 1) * 64 + 8 * c8 + 4); }
            const float gs[8] = {ga.x, ga.y, ga.z, ga.w, gb.x, gb.y, gb.z, gb.w}, gm[8] = {pa.x, pa.y, pa.z, pa.w, pb.x, pb.y, pb.z, pb.w}, gl[8] = {ha.x, ha.y, ha.z, ha.w, hb.x, hb.y, hb.z, hb.w};
            {
                float at_[8], rt_[8];
#pragma unroll
                for (int j = 0; j < 8; ++j) { at_[j] = -kk8[j] * __expf(gm[j]); rt_[j] = r8[j] * __expf(gs[j]); }
                *(u32x4*)(lds + SL_AT * SLOT + sp * 144 + c8 * 16) = pack8(at_); *(u32x4*)(lds + SL_RT * SLOT + sp * 144 + c8 * 16) = pack8(rt_);
            }
            {
                float bt_[8], kt_[8];
#pragma unroll
                for (int j = 0; j < 8; ++j) { const float en = __expf(-gs[j]); bt_[j] = b8[j] * en; kt_[j] = kd8[j] * en; }
                *(u32x4*)(lds + SL_BT * SLOT + sp * 144 + c8 * 16) = pack8(bt_); *(u32x4*)(lds + SL_KT * SLOT + sp * 144 + c8 * 16) = pack8(kt_);
            }
            {
                float bh_[8], kh_[8];
#pragma unroll
                for (int j = 0; j < 8; ++j) { const float eh = __expf(gl[j] - gs[j]); bh_[j] = b8[j] * eh; kh_[j] = kd8[j] * eh; }
                *(u32x4*)(lds + SL_VT * SLOT + sp * 144 + c8 * 16) = pack8(v8);
                *(u32x4*)(lds + SL_BH * SLOT + sp * 144 + c8 * 16) = pack8(bh_); *(u32x4*)(lds + SL_KH * SLOT + sp * 144 + c8 * 16) = pack8(kh_);
            }
            if (tid < 64) ((float*)(lds + L_SEG))[tid] = __expf(G[63 * 64 + tid]);
        }
        __syncthreads();
        {
            const char* ATt = lds + SL_AT * SLOT; const char* RTt = lds + SL_RT * SLOT;
            f32x16 acc = mm_tile(zero16(), ATt, lds + (wid < 4 ? SL_BT : SL_KT) * SLOT, pj, pi, r32, hi);
            f32x16 acc2 = mm_tile(zero16(), RTt, lds + (wid < 4 ? SL_BT : SL_KT) * SLOT, pj, pi, r32, hi);
            const int row = 32 * pj + r32;
            if (wid < 4) {
                st_tile(lds + SL_MOFF * SLOT, pj, pi, r32, hi, acc, [](int s, int i) { return (s >> 4) > (i >> 4); });
#pragma unroll
                for (int g = 0; g < 4; ++g)
#pragma unroll
                    for (int q = 0; q < 4; ++q) { const int i = 32 * pi + 8 * g + 4 * hi + q; const float vv = acc[4 * g + q];
                        if ((row >> 4) == (i >> 4)) ((float*)(lds + L_FD))[(4 + (row >> 4)) * 272 + (i & 15) * 16 + (row & 15)] = (i < row) ? vv : 0.f; }
                st_tile(lds + SL_LRB * SLOT, pj, pi, r32, hi, acc2, [](int s, int i) { return i <= s; });
            } else {
                st_tile(lds + SL_MAK * SLOT, pj, pi, r32, hi, acc, [](int s, int i) { return i < s; });
                st_tile(lds + SL_LRK * SLOT, pj, pi, r32, hi, acc2, [](int s, int i) { return i <= s; });
            }
        }
        __syncthreads();
        if (c + 1 < SEQ / 64) C_LOAD(c + 1);
        if (wid == 0) {
            const int d = lane >> 4, j = lane & 15; const float* MdT = (const float*)(lds + L_FD) + (4 + d) * 272;
            float x[16];
#pragma unroll
            for (int q = 15; q >= 0; --q) { float acc = (q == j) ? 1.f : 0.f;
                const f32x4 m0 = *(const f32x4*)(MdT + q * 16), m1 = *(const f32x4*)(MdT + q * 16 + 4), m2 = *(const f32x4*)(MdT + q * 16 + 8), m3 = *(const f32x4*)(MdT + q * 16 + 12);
                const float mr[16] = {m0.x, m0.y, m0.z, m0.w, m1.x, m1.y, m1.z, m1.w, m2.x, m2.y, m2.z, m2.w, m3.x, m3.y, m3.z, m3.w};
#pragma unroll
                for (int s = 0; s < 16; ++s) if (s > q) acc = fmaf(x[s], mr[s], acc);
                x[q] = acc; asm volatile("" ::: "memory"); }
            char* rowp = lds + SL_DD * SLOT + (16 * d + j) * 144;
            const u32x4 z4 = {0u, 0u, 0u, 0u};
#pragma unroll
            for (int q = 0; q < 8; ++q) *(u32x4*)(rowp + 16 * q) = z4;
            u32x4 w0, w1; w0.x = pk2(x[0], x[1]); w0.y = pk2(x[2], x[3]); w0.z = pk2(x[4], x[5]); w0.w = pk2(x[6], x[7]); w1.x = pk2(x[8], x[9]); w1.y = pk2(x[10], x[11]); w1.z = pk2(x[12], x[13]); w1.w = pk2(x[14], x[15]);
            asm volatile("s_waitcnt lgkmcnt(0)" ::: "memory");
            *(u32x4*)(rowp + 32 * d) = w0; *(u32x4*)(rowp + 32 * d + 16) = w1;
        }
        f32x16 locA = zero16(), locB = zero16();
        if (wid < 4) { locA = mm_tile2<true, false>(locA, lds + SL_VT * SLOT, lds + SL_MAK * SLOT, pj, pi, lane, r32, hi); locB = mm_tile2<true, true>(locB, lds + SL_VT * SLOT, lds + SL_KH * SLOT, pj, pi, lane, r32, hi); }
        else locA = mm_tile2<false, true>(locA, lds + SL_LRK * SLOT, lds + SL_VT * SLOT, pj, pi, lane, r32, hi);
        __syncthreads();
        if (wid < 4) {
            f32x16 acc = mm_tile2<false, true>(zero16(), lds + SL_DD * SLOT, lds + SL_MOFF * SLOT, pj, pi, lane, r32, hi);
            st_tile(lds + SL_N * SLOT, pj, pi, r32, hi, acc, [](int, int) { return true; });
        }
        __syncthreads();
        {
            f32x16 acc = zero16();
            if (wid >= 4) { const int row = 32 * pj + r32; const char* addt = lds + SL_DD * SLOT;
#pragma unroll
                for (int g = 0; g < 4; ++g) { const u32x2 w = *(const u32x2*)(addt + row * 144 + (32 * pi + 8 * g + 4 * hi) * 2); acc[4 * g] = lo16(w.x); acc[4 * g + 1] = hi16(w.x); acc[4 * g + 2] = lo16(w.y); acc[4 * g + 3] = hi16(w.y); } }
            acc = (wid < 4) ? mm_tile2<false, true>(acc, lds + SL_N * SLOT, lds + SL_N * SLOT, pj, pi, lane, r32, hi) : mm_tile2<false, true>(acc, lds + SL_N * SLOT, lds + SL_DD * SLOT, pj, pi, lane, r32, hi);
            st_tile(lds + (wid < 4 ? SL_N2 : SL_W1) * SLOT, pj, pi, r32, hi, acc, [](int, int) { return true; });
        }
        __syncthreads();
        if (wid < 4) {
            f32x16 acc;
            { const int row = 32 * pj + r32; const char* addt = lds + SL_W1 * SLOT;
#pragma unroll
              for (int g = 0; g < 4; ++g) { const u32x2 w = *(const u32x2*)(addt + row * 144 + (32 * pi + 8 * g + 4 * hi) * 2); acc[4 * g] = lo16(w.x); acc[4 * g + 1] = hi16(w.x); acc[4 * g + 2] = lo16(w.y); acc[4 * g + 3] = hi16(w.y); } }
            acc = mm_tile2<false, true>(acc, lds + SL_N2 * SLOT, lds + SL_W1 * SLOT, pj, pi, lane, r32, hi);
            st_tile(lds + SL_T * SLOT, pj, pi, r32, hi, acc, [](int, int) { return true; });
        } else {
            locA = mm_tile(locA, lds + SL_RT * SLOT, lds + SL_S0 * SLOT, pj, pi, r32, hi);
        }
        if (wid < 4) {
            locA = mm_tile(locA, lds + SL_S0 * SLOT, lds + SL_AT * SLOT, pj, pi, r32, hi);
            st_tile(lds + SL_RHST * SLOT, pj, pi, r32, hi, locA, [](int, int) { return true; });
        }
        __syncthreads();
        if (wid < 4) {
            f32x16 acc = mm_tile(zero16(), lds + SL_RHST * SLOT, lds + SL_T * SLOT, pj, pi, r32, hi);
            st_tile(lds + SL_UT * SLOT, pj, pi, r32, hi, acc, [](int, int) { return true; });
        }
        __syncthreads();
        if (wid < 4) {
            const float* gam = (const float*)(lds + L_SEG);
#pragma unroll
            for (int g = 0; g < 4; ++g) { const f32x4 gq = *(const f32x4*)(gam + 32 * pi + 8 * g + 4 * hi);
                state[4 * g] = state[4 * g] * gq.x + locB[4 * g]; state[4 * g + 1] = state[4 * g + 1] * gq.y + locB[4 * g + 1]; state[4 * g + 2] = state[4 * g + 2] * gq.z + locB[4 * g + 2]; state[4 * g + 3] = state[4 * g + 3] * gq.w + locB[4 * g + 3]; }
            state = mm_tile2<false, true>(state, lds + SL_UT * SLOT, lds + SL_BH * SLOT, pj, pi, lane, r32, hi);
            st_tile(lds + SL_S0 * SLOT, pj, pi, r32, hi, state, [](int, int) { return true; });
        } else {
            locA = mm_tile(locA, lds + SL_LRB * SLOT, lds + SL_UT * SLOT, pj, pi, r32, hi);
            const int s = 32 * pj + r32; const int tn = t0 + (dir ? 63 - s : s);
            bf16_t* yp = yout + (rowb + tn) * 512 + h * 64 + 32 * pi;
#pragma unroll
            for (int g = 0; g < 4; ++g) { u32x2 w; w.x = pk2(locA[4 * g], locA[4 * g + 1]); w.y = pk2(locA[4 * g + 2], locA[4 * g + 3]); *(u32x2*)(yp + 8 * g + 4 * hi) = w; }
        }
        __syncthreads();
    }
#undef C_LOAD
#undef SHIFT8
}

DEVI void stage_rwkv_post(const Params& p, int bid, int nb) {
    const bf16_t* yf = (const bf16_t*)(p.ws + OFF_YF); const bf16_t* yb = (const bf16_t*)(p.ws + OFF_YB);
    const bf16_t* g = (const bf16_t*)(p.ws + OFF_G); const bf16_t* vs = (const bf16_t*)(p.ws + OFF_VS);
    const float* sf = (const float*)(p.ws + OFF_SDIR); const float* sb = sf + (size_t)T_ * 8;
    bf16_t* orw = (bf16_t*)(p.ws + OFF_YF);
    for (int i = bid * NTHREADS + my_tid(); i < T_ * 64; i += nb * NTHREADS) {
        const int c8 = i & 7, th = i >> 3, c = (th & 7) * 64 + 8 * c8;
        const size_t o = (size_t)(th >> 3) * 512 + c;
        float a[8], b[8], y[8], gv[8], vv[8];
        unpack8(*(const u32x4*)(yf + o), a); unpack8(*(const u32x4*)(yb + o), b); unpack8(*(const u32x4*)(g + o), gv); unpack8(*(const u32x4*)(vs + o), vv);
        float s = 0.f;
#pragma unroll
        for (int j = 0; j < 8; ++j) { y[j] = a[j] + b[j]; s += y[j]; }
        const float mu = red8(s) * (1.f / 64.f);
        float q = 0.f;
#pragma unroll
        for (int j = 0; j < 8; ++j) { y[j] -= mu; q += y[j] * y[j]; }
        const float rstd = rsqrtf(red8(q) * (1.f / 64.f) + 64e-5f);
        const float bs = sf[th] + sb[th];
        const f32x4 lga = *(const f32x4*)(p.in[18] + c), lgb = *(const f32x4*)(p.in[18] + c + 4), lba = *(const f32x4*)(p.in[19] + c), lbb = *(const f32x4*)(p.in[19] + c + 4);
        const float lg[8] = {lga.x, lga.y, lga.z, lga.w, lgb.x, lgb.y, lgb.z, lgb.w}, lb[8] = {lba.x, lba.y, lba.z, lba.w, lbb.x, lbb.y, lbb.z, lbb.w};
        float r[8];
#pragma unroll
        for (int j = 0; j < 8; ++j) r[j] = (y[j] * rstd * lg[j] + lb[j] + bs * vv[j]) * gv[j];
        *(u32x4*)(orw + o) = pack8(r);
    }
}

typedef float f32x2v __attribute__((ext_vector_type(2)));
DEVI void stage_route(const Params& p, char* lds, int bid, int nb, bool do_count = true) {
    const int tid = my_tid(), lane = tid & 63, wave = tid >> 6;
    const bf16_t* x1 = (const bf16_t*)(p.ws + OFF_X1); bf16_t* h2 = (bf16_t*)((char*)p.out + DOFF_H2);
    int* toke = (int*)(p.ws + OFF_TOKE); float* tokw = (float*)(p.ws + OFF_TOKW); int* tokr = (int*)(p.ws + OFF_TOKR);
    int* cntwg = (int*)(p.ws + OFF_CNTWG);
    const bf16_t* wrt = (const bf16_t*)(p.ws + OFF_WRT);
    const float* g2 = p.in[23];
    int* hist = (int*)lds;
    float* lgs = (float*)(lds + 256) + wave * (16 * 48);
    if (bid == 0 && do_count) { u32x4* zr = (u32x4*)(h2 + (size_t)T_ * DM); if (tid < 128) zr[tid] = (u32x4){0u, 0u, 0u, 0u}; }
    for (int b = bid; b < T_ / 128; b += nb) {
        if (tid < 32) hist[tid] = 0;
        __syncthreads();
        const int t0 = b * 128 + wave * 16;
        f32x4 gv[4];
#pragma unroll
        for (int j = 0; j < 4; ++j) gv[j] = *(const f32x4*)(g2 + 4 * lane + 256 * j);
        float my_rstd = 0.f;
        for (int ib = 0; ib < 16; ib += 4) {
            u32x2 xw[4][4];
#pragma unroll
            for (int q = 0; q < 4; ++q) { const u32x2* xr = (const u32x2*)(x1 + (size_t)(t0 + ib + q) * DM) + lane;
#pragma unroll
                for (int j = 0; j < 4; ++j) xw[q][j] = xr[64 * j]; }
#pragma unroll
            for (int q = 0; q < 4; ++q) { const int i = ib + q;
                f32x4 v[4]; float s = 0.f;
#pragma unroll
                for (int j = 0; j < 4; ++j) { const u32x2 w = xw[q][j]; v[j] = (f32x4){lo16(w.x), hi16(w.x), lo16(w.y), hi16(w.y)}; s += (v[j].x * v[j].x + v[j].y * v[j].y) + (v[j].z * v[j].z + v[j].w * v[j].w); }
                const float rstd = rsqrtf(wave_sum(s) * (1.f / DM) + 1e-6f);
                if ((lane & 15) == i) my_rstd = rstd;
                u32x2* o8 = (u32x2*)(h2 + (size_t)(t0 + i) * DM) + lane;
#pragma unroll
                for (int j = 0; j < 4; ++j) { const f32x4 qv = v[j] * rstd * gv[j]; u32x2 w; w.x = pk2(qv.x, qv.y); w.y = pk2(qv.z, qv.w); o8[64 * j] = w; } }
        }
        const int li = lane & 15, kq = lane >> 4;
        const bf16_t* xrow = x1 + (size_t)(t0 + li) * DM + 8 * kq;
        const bf16_t* whp = (const bf16_t*)wrt + (size_t)li * DM + 8 * kq; const bf16_t* wlp = whp + 48 * DM;
        f32x4 acc0 = {0.f, 0.f, 0.f, 0.f}, acc1 = acc0, acc2 = acc0;
#pragma unroll 2
        for (int ks = 0; ks < 32; ++ks) {
            float xv[8]; unpack8(*(const u32x4*)(xrow + 32 * ks), xv);
            const f32x4 ga = *(const f32x4*)(g2 + 32 * ks + 8 * kq), gb = *(const f32x4*)(g2 + 32 * ks + 8 * kq + 4);
            const float gq[8] = {ga.x, ga.y, ga.z, ga.w, gb.x, gb.y, gb.z, gb.w};
            float vh[8], vl[8];
#pragma unroll
            for (int j = 0; j < 8; ++j) { const float v = xv[j] * gq[j] * my_rstd; const float hf = bf2f(f2bf(v)); vh[j] = hf; vl[j] = v - hf; }
            const bf16x8 ah = __builtin_bit_cast(bf16x8, pack8(vh)), al = __builtin_bit_cast(bf16x8, pack8(vl));
#pragma unroll
            for (int ob = 0; ob < 3; ++ob) {
                const bf16x8 bh = *(const bf16x8*)(whp + (size_t)ob * 16 * DM + 32 * ks), bl = *(const bf16x8*)(wlp + (size_t)ob * 16 * DM + 32 * ks);
                f32x4& a = (ob == 0) ? acc0 : (ob == 1 ? acc1 : acc2);
                a = __builtin_amdgcn_mfma_f32_16x16x32_bf16(ah, bh, a, 0, 0, 0);
                a = __builtin_amdgcn_mfma_f32_16x16x32_bf16(ah, bl, a, 0, 0, 0);
                a = __builtin_amdgcn_mfma_f32_16x16x32_bf16(al, bh, a, 0, 0, 0);
            }
        }
#pragma unroll
        for (int r = 0; r < 4; ++r) { float* lr = lgs + (4 * kq + r) * 48 + li; lr[0] = acc0[r]; lr[16] = acc1[r]; lr[32] = acc2[r]; }
        asm volatile("s_waitcnt lgkmcnt(0)" ::: "memory");
        if (lane < 16) {
            const float* lg = lgs + lane * 48; const int t = t0 + lane;
            float gl[4];
#pragma unroll
            for (int j = 0; j < 4; ++j) gl[j] = lg[j] + p.in[25][j];
            int gi = 0; float gm = gl[0];
#pragma unroll
            for (int j = 1; j < 4; ++j) if (gl[j] > gm) { gm = gl[j]; gi = j; }
            float gs = 0.f;
#pragma unroll
            for (int j = 0; j < 4; ++j) gs += __expf(gl[j] - gm);
            const float gp = 1.f / gs;
            float el[8];
#pragma unroll
            for (int j = 0; j < 8; ++j) el[j] = lg[4 + gi * 8 + j] + p.in[27][gi * 8 + j];
            int i1 = 0; float m1 = el[0];
#pragma unroll
            for (int j = 1; j < 8; ++j) if (el[j] > m1) { m1 = el[j]; i1 = j; }
            int i2 = -1; float m2 = -INFINITY;
#pragma unroll
            for (int j = 0; j < 8; ++j) if (j != i1 && el[j] > m2) { m2 = el[j]; i2 = j; }
            const float e2 = __expf(m2 - m1), tp1 = 1.f / (1.f + e2), tp2 = e2 / (1.f + e2);
            const int e1i = gi * 8 + i1, e2i = gi * 8 + i2;
            toke[2 * t] = e1i; toke[2 * t + 1] = e2i; tokw[2 * t] = gp * tp1; tokw[2 * t + 1] = gp * tp2;
            if (do_count) { tokr[2 * t] = atomicAdd(hist + e1i, 1); tokr[2 * t + 1] = atomicAdd(hist + e2i, 1); }
        }
        __syncthreads();
        if (do_count && tid < 32) cntwg[b * 32 + tid] = hist[tid];
        __syncthreads();
    }
}
DEVI void stage_scatter(const Params& p, char* lds, int bid, int nb, bool dry = false) {
    const int tid = my_tid(), lane = tid & 63, wave = tid >> 6;
    const int gw = bid * NWAVES + wave, NGW = nb * NWAVES;
    int* ctl = (int*)(p.ws + OFF_CTL); const int* toke = (const int*)(p.ws + OFF_TOKE); const int* tokr = (const int*)(p.ws + OFF_TOKR); int* toks = (int*)(p.ws + OFF_TOKS);
    const int* cntwg = (const int*)(p.ws + OFF_CNTWG);
    int* slottok = (int*)(p.ws + OFF_SLOTTOK);
    int* part = (int*)lds;
    int* tot = part + 512;
    int* cnts = tot + 32;
    int* bases = cnts + 32;
    constexpr int NB = T_ / 128;
    {
        const int e = tid & 31, q = tid >> 5;
        int s = 0;
        for (int w = 16 * q; w < 16 * q + 16; ++w) s += cntwg[w * 32 + e];
        part[q * 32 + e] = s;
    }
    __syncthreads();
    if (tid == 0) {
        int run = 0;
        for (int e = 0; e < NEXP; ++e) {
            int c = 0; for (int q = 0; q < 16; ++q) c += part[q * 32 + e];
            cnts[e] = c; tot[e] = run;
            const int pad = (c + 255) / 256 * 256;
            if (bid == 0) for (int bq = run / 256; bq < (run + pad) / 256; ++bq) ctl[C_BLKE + bq] = e;
            run += pad;
        }
        if (bid == 0) { for (int bq = run / 256; bq < NBLK; ++bq) ctl[C_BLKE + bq] = -1; ctl[C_NBLK] = run / 256; }
    }
    __syncthreads();
    for (int b = bid; b < NB; b += nb) {
        if (tid < 32) { int s = tot[tid]; for (int q = 0; q < (b >> 4); ++q) s += part[q * 32 + tid]; for (int w = b & ~15; w < b; ++w) s += cntwg[w * 32 + tid]; bases[tid] = s; }
        __syncthreads();
        if (tid < 256) { const int a = b * 256 + tid; const int slot = bases[toke[a]] + tokr[a]; if (!dry) { toks[a] = slot; slottok[slot] = a >> 1; } else asm volatile("" :: "v"(slot)); }
        __syncthreads();
    }
    {
        const int e = gw & 31; const int c = cnts[e], pad = (c + 255) / 256 * 256;
        for (int s = tot[e] + c + (gw >> 5) * 64 + lane; s < tot[e] + pad; s += (NGW >> 5) * 64) slottok[s] = T_;
    }
    __syncthreads();
}
DEVI void stage_final(const Params& p, int bid, int nb, bool dry = false) {
    const int lane = my_tid() & 63, wave = my_tid() >> 6;
    const int gw = bid * NWAVES + wave, NGW = nb * NWAVES;
    const bf16_t* ye = (const bf16_t*)(p.ws + OFF_YE); const int* toks = (const int*)(p.ws + OFF_TOKS); const float* tokw = (const float*)(p.ws + OFF_TOKW);
    const bf16_t* x1 = (const bf16_t*)(p.ws + OFF_X1);
    const float* gf = p.in[31];
    f32x4 gv[4];
#pragma unroll
    for (int j = 0; j < 4; ++j) gv[j] = *(const f32x4*)(gf + 4 * lane + 256 * j);
    for (int tb = gw * 2; tb < T_; tb += NGW * 2) {
        u32x2 xa[2][4], ya[2][4], yb[2][4]; float w0[2], w1[2];
#pragma unroll
        for (int q = 0; q < 2; ++q) { const int t = tb + q; const int s0 = toks[2 * t], s1 = toks[2 * t + 1]; w0[q] = tokw[2 * t]; w1[q] = tokw[2 * t + 1];
            const u32x2* xr = (const u32x2*)(x1 + (size_t)t * DM) + lane; const u32x2* y0 = (const u32x2*)(ye + (size_t)s0 * DM) + lane; const u32x2* y1 = (const u32x2*)(ye + (size_t)s1 * DM) + lane;
#pragma unroll
            for (int j = 0; j < 4; ++j) { xa[q][j] = xr[64 * j]; ya[q][j] = y0[64 * j]; yb[q][j] = y1[64 * j]; } }
#pragma unroll
        for (int q = 0; q < 2; ++q) {
            f32x4 v[4]; float s = 0.f;
#pragma unroll
            for (int j = 0; j < 4; ++j) { const u32x2 x = xa[q][j], a = ya[q][j], b = yb[q][j];
                v[j].x = lo16(x.x) + w0[q] * lo16(a.x) + w1[q] * lo16(b.x); v[j].y = hi16(x.x) + w0[q] * hi16(a.x) + w1[q] * hi16(b.x);
                v[j].z = lo16(x.y) + w0[q] * lo16(a.y) + w1[q] * lo16(b.y); v[j].w = hi16(x.y) + w0[q] * hi16(a.y) + w1[q] * hi16(b.y);
                s += (v[j].x * v[j].x + v[j].y * v[j].y) + (v[j].z * v[j].z + v[j].w * v[j].w); }
            const float rstd = rsqrtf(wave_sum(s) * (1.f / DM) + 1e-6f);
            f32x4* orow = (f32x4*)(p.out + (size_t)(tb + q) * DM) + lane;
#pragma unroll
            for (int j = 0; j < 4; ++j) { const f32x4 o = v[j] * rstd * gv[j]; if (!dry) orow[64 * j] = o; else asm volatile("" :: "v"(o)); }
        }
    }
}

#define LAS __attribute__((address_space(3)))
#define XB_TMO      128
#define XB_XCNT(j)  (256  + 64 * (j))
#define XB_XSUB(j)  (1280 + 64 * (j))
#define XB_XGEN(j)  (2304 + 64 * (j))
#define XB_TOP      3328
#define XB_TOPGEN   3392
#define XCD_BAR_WORDS 3456
#define XB_SPIN_CAP (1u << 18)
DEVI unsigned xb_ld(unsigned* p)              { return __hip_atomic_load(p, __ATOMIC_RELAXED, __HIP_MEMORY_SCOPE_AGENT); }
DEVI unsigned xb_add(unsigned* p, unsigned v) { return __hip_atomic_fetch_add(p, v, __ATOMIC_RELAXED, __HIP_MEMORY_SCOPE_AGENT); }
DEVI unsigned xb_xcc_id() { return (unsigned)__builtin_amdgcn_s_getreg((3 << 11) | 20) & 0xFu; }
#define XB_SPIN(cond, bar) do { unsigned _sp = 0; while (cond) { __builtin_amdgcn_s_sleep(1); \
    if ((++_sp & 255u) == 0u) { if (xb_ld(&(bar)[XB_TMO])) break; if (_sp > XB_SPIN_CAP) { atomicAdd(&(bar)[XB_TMO], 1u); break; } } } } while (0)
struct XcdBarrier { unsigned* bar; unsigned x; volatile LAS unsigned* st; };
DEVI XcdBarrier xcd_barrier_post(unsigned* bar, volatile LAS unsigned* st) {
    XcdBarrier b; b.bar = bar; b.x = xb_xcc_id(); b.st = st;
    if (my_tid() == 0) (void)xb_add(&bar[XB_XCNT(b.x)], 1u);
    return b;
}
DEVI void xcd_barrier_complete(unsigned* bar, unsigned x, unsigned& nloc, unsigned& nx) {
    const unsigned G = gridDim.x * gridDim.y * gridDim.z;
    unsigned sum, cnt, mine, sp = 0u;
    for (;;) {
        sum = 0u; cnt = 0u; mine = 0u;
#pragma unroll
        for (unsigned j = 0; j < 16; ++j) { const unsigned c = xb_ld(&bar[XB_XCNT(j)]); sum += c; cnt += (c > 0u) ? 1u : 0u; mine = (j == x) ? c : mine; }
        if (sum == G) break;
        __builtin_amdgcn_s_sleep(1);
        if ((++sp & 255u) == 0u) { if (xb_ld(&bar[XB_TMO])) break; if (sp > XB_SPIN_CAP) { atomicAdd(&bar[XB_TMO], 1u); break; } }
    }
    nloc = mine > 0u ? mine : 1u; nx = cnt > 0u ? cnt : 1u;
}
DEVI void xcd_barrier(const XcdBarrier& b) {
    asm volatile("s_waitcnt vmcnt(0)" ::: "memory");
    __syncthreads();
    if (my_tid() == 0) {
        unsigned* bar = b.bar;
        __builtin_amdgcn_s_waitcnt(0);
        unsigned nloc = b.st[0], nx = b.st[1];
        if (nloc == 0u) { xcd_barrier_complete(bar, b.x, nloc, nx); b.st[0] = nloc; b.st[1] = nx; }
        const unsigned old = xb_add(&bar[XB_XSUB(b.x)], 1u);
        const unsigned gen = old / nloc;
        if (old + 1u == (gen + 1u) * nloc) {
            __builtin_amdgcn_fence(__ATOMIC_RELEASE, "agent");
            asm volatile("s_waitcnt vmcnt(0)" ::: "memory");
            const unsigned og = xb_add(&bar[XB_TOP], 1u);
            const unsigned tg = og / nx;
            if (og + 1u == (tg + 1u) * nx) xb_add(&bar[XB_TOPGEN], 1u);
            else XB_SPIN(xb_ld(&bar[XB_TOPGEN]) == tg, bar);
            __builtin_amdgcn_fence(__ATOMIC_ACQUIRE, "agent");
            xb_add(&bar[XB_XGEN(b.x)], 1u);
            asm volatile("s_waitcnt vmcnt(0)" ::: "memory");
        } else {
            XB_SPIN(xb_ld(&bar[XB_XGEN(b.x)]) == gen, bar);
            __builtin_amdgcn_fence(__ATOMIC_ACQUIRE, "agent");
            asm volatile("s_waitcnt vmcnt(0)" ::: "memory");
        }
    }
    __syncthreads();
}

constexpr int LDS_BYTES = 147456;
constexpr int LDS_MISC = 147200;
constexpr int C_BAR = 4096;
constexpr size_t CTL_ZERO_BYTES = 65536;
constexpr size_t DOFF_H2ND = 0;
constexpr size_t DOFF_ORWKV = 64 * MiB;

template <int PH>
DEVI void run_phase(const Params& p, char* lds, int bid, int nb) {
    unsigned char* ws = p.ws;
    if constexpr (PH == 0) { stage_transposes(p, 0, p.njobs_mid, 0, p.items_mid, lds, bid, nb); stage_rope_table(p, bid, nb);
        { u32x4* wz = (u32x4*)(ws + OFF_WIN + (size_t)NZ * DM * 2); const u32x4 z4 = {0u, 0u, 0u, 0u}; for (int i = bid * NTHREADS + my_tid(); i < (LDZ - NZ) * DM / 8; i += nb * NTHREADS) wz[i] = z4; }
        { bf16_t* gp = (bf16_t*)(ws + OFF_GUP); const u32x4 z4 = {0u, 0u, 0u, 0u}; for (int i = bid * NTHREADS + my_tid(); i < 512 * 16; i += nb * NTHREADS) *(u32x4*)(gp + (size_t)(i >> 4) * 256 + 128 + 8 * (i & 15)) = z4; }
        { bf16_t* wrh = (bf16_t*)(ws + OFF_WRT); bf16_t* wrl = wrh + 48 * DM; for (int i = bid * NTHREADS + my_tid(); i < 48 * DM; i += nb * NTHREADS) { const int o = i >> 10, c = i & 1023; const float w = (o < 4) ? p.in[24][c * 4 + o] : (o < 36 ? p.in[26][c * 32 + (o - 4)] : 0.f); const unsigned h = f2bf(w); wrh[i] = (bf16_t)h; wrl[i] = (bf16_t)f2bf(w - bf2f(h)); } }
        __syncthreads(); stage_rms_rows(p.in[0], p.in[1], (bf16_t*)(ws + OFF_H), bid, nb); }
    if constexpr (PH == 1) { F8Bf16 e{(bf16_t*)(ws + OFF_Z), LDZ}; big_gemm(lds, (const bf16_t*)(ws + OFF_H), DM, (const bf16_t*)(ws + OFF_WIN), DM, T_, LDZ, DM, e, bid, nb); }
    if constexpr (PH == 2) { if ((PROBE_MASK >> 25) & 1) { stage_mla_prep(p, bid, nb, true); stage_sg_prep(p, bid, nb); } stage_mla_prep(p, bid, nb); stage_sg_prep(p, bid, nb); }
    if constexpr (PH == 3) {
        const bf16_t* z = (const bf16_t*)(ws + OFF_Z);
        { F8Bf16 e{(bf16_t*)((char*)p.out + DOFF_QRAW), 768}; big_gemm(lds, z, LDZ, (const bf16_t*)(ws + OFF_WUQ), 384, T_, 768, 384, e, bid, nb); }
        { F8Bf16 e{(bf16_t*)((char*)p.out + DOFF_KVRAW), 1024}; big_gemm(lds, z + 384, LDZ, (const bf16_t*)(ws + OFF_WUKV), 256, T_, 1024, 256, e, bid, nb); }
        { F8Bf16 e{(bf16_t*)(ws + OFF_G), 512}; big_gemm(lds, (const bf16_t*)(ws + OFF_SG), 256, (const bf16_t*)(ws + OFF_GUP), 256, T_, 512, 256, e, bid, nb); }
        for (int rep = 0; rep < 1 + ((PROBE_MASK >> 20) & 1); ++rep) for (int u = bid; u < BATCH * NH * 2; u += nb) chain_unit(p, u, lds);
    }
    if constexpr (PH == 4) {
        for (int rep = 0; rep < 1 + ((PROBE_MASK >> 21) & 1); ++rep) for (int u = bid; u < BATCH * NH * 8; u += nb) attn_unit(p, u, lds);
        stage_rwkv_post(p, bid, nb);
    }
    if constexpr (PH == 6) {
        { F8Bf16 e{(bf16_t*)(ws + OFF_BM), 1024}; big_gemm(lds, (const bf16_t*)(ws + OFF_OMLA), 512, (const bf16_t*)(ws + OFF_WBM), 512, T_, 1024, 512, e, bid, nb); }
        { F8Bf16 e{(bf16_t*)(ws + OFF_BR), 1024}; big_gemm(lds, (const bf16_t*)(ws + OFF_YF), 512, (const bf16_t*)(ws + OFF_WBR), 512, T_, 1024, 512, e, bid, nb); }
    }
    if constexpr (PH == 7) { EpiGate e{(const bf16_t*)(ws + OFF_BM), (const bf16_t*)(ws + OFF_BR), (bf16_t*)(ws + OFF_MIXED), p.in[21]};
        big_gemm_epi(lds, (const bf16_t*)(ws + OFF_H), DM, (const bf16_t*)(ws + OFF_WG), DM, T_, 2048, DM, e, bid, nb); }
    if constexpr (PH == 8) { F8Resid e{p.in[0], (bf16_t*)(ws + OFF_X1)};
        big_gemm(lds, (const bf16_t*)(ws + OFF_MIXED), DM, (const bf16_t*)(ws + OFF_WOUT), DM, T_, DM, DM, e, bid, nb); }
    if constexpr (PH == 9) { stage_route(p, lds, bid, nb); if ((PROBE_MASK >> 22) & 1) stage_route(p, lds, bid, nb, false); }
    if constexpr (PH == 10) { if ((PROBE_MASK >> 27) & 1) stage_scatter(p, lds, bid, nb, true); stage_scatter(p, lds, bid, nb); }
    if constexpr (PH == 11) { F8Swiglu e{(bf16_t*)((char*)p.out + DOFF_HID)}; const int* ctl = (const int*)(ws + OFF_CTL);
        big_gemm_<F8Swiglu, true>(lds, (const bf16_t*)((const char*)p.out + DOFF_H2), DM, (const bf16_t*)(ws + OFF_W13), DM, ctl[C_NBLK] * 256, 512, DM, e, bid, nb, ctl + C_BLKE, (size_t)512 * DM, (const int*)(ws + OFF_SLOTTOK));
        {
            const int nwg = ctl[C_NBLK] * 2; int n3 = nwg - 2 * nb; n3 = n3 < 0 ? 0 : (n3 > nb - 32 ? nb - 32 : n3);
            if (bid >= n3) stage_transposes(p, p.njobs_mid, p.njobs_all, p.items_mid, p.items_all, lds, bid - n3, nb - n3);
        } }
    if constexpr (PH == 12) { F8Bf16 e{(bf16_t*)(ws + OFF_YE), DM}; const int* ctl = (const int*)(ws + OFF_CTL);
        big_gemm(lds, (const bf16_t*)((const char*)p.out + DOFF_HID), DEXP, (const bf16_t*)(ws + OFF_W2), DEXP, ctl[C_NBLK] * 256, DM, DEXP, e, bid, nb, ctl + C_BLKE, (size_t)DM * DEXP); }
    if constexpr (PH == 13) { if ((PROBE_MASK >> 26) & 1) stage_final(p, bid, nb, true); stage_final(p, bid, nb); }
}

__global__ void __launch_bounds__(NTHREADS, 2) mega_fwd(Params p) {
    extern __shared__ __attribute__((aligned(16))) char lds[];
    const int bid = blockIdx.x, nb = gridDim.x;
    volatile LAS unsigned* misc = (volatile LAS unsigned*)((LAS char*)lds + LDS_MISC);
    if (my_tid() < 64) misc[my_tid()] = 0u;
    __syncthreads();
    XcdBarrier bar = xcd_barrier_post((unsigned*)(p.ws + OFF_CTL) + C_BAR, misc + 8);
#define PHASE(k) do { run_phase<k>(p, lds, bid, nb); if ((PROBE_MASK >> k) & 1) { __syncthreads(); run_phase<k>(p, lds, bid, nb); } xcd_barrier(bar); if ((PROBE_MASK >> 24) & 1) xcd_barrier(bar); } while (0)
    PHASE(0); PHASE(1); PHASE(2); PHASE(3); PHASE(4); PHASE(6); PHASE(7); PHASE(8); PHASE(9); PHASE(10); PHASE(11); PHASE(12);
    run_phase<13>(p, lds, bid, nb);
#undef PHASE
}

static int add_job(Params& P, int& nj, int& items, int in_idx, int K, int ldsrc, int col0, int ncols, int row_mul, int row_off, int nbatch, long long sbs, long long dbs, size_t dst_off, int dst_ld = 0) {
    TJob& J = P.jobs[nj]; J.in_idx = in_idx; J.K = K; J.ldsrc = ldsrc; J.col0 = col0; J.ncols = ncols; J.row_mul = row_mul; J.row_off = row_off; J.nbatch = nbatch;
    J.sbs = sbs; J.dbs = dbs; J.dst_off = (long long)dst_off; J.item0 = items; J.dst_ld = dst_ld ? dst_ld : K;
    items += nbatch * (K / 64) * (ncols / 32); return ++nj;
}
extern "C" void kernel_launch(void* const* d_in, const int* in_sizes, int n_in, void* d_out, int out_size, void* d_ws, size_t ws_size, hipStream_t stream) {
    static int grid = 0;
    if (grid == 0) {
        if (n_in != 32 || out_size != T_ * DM || ws_size < WS_NEED) { fprintf(stderr, "kernel_launch: unexpected shapes (n_in %d out %d ws %zu)\n", n_in, out_size, ws_size); grid = -1; return; }
        int dev = 0, cus = 0, per_cu = 0;
        if (hipGetDevice(&dev) != hipSuccess || hipDeviceGetAttribute(&cus, hipDeviceAttributeMultiprocessorCount, dev) != hipSuccess) { grid = -1; return; }
        if (hipFuncSetAttribute((const void*)mega_fwd, hipFuncAttributeMaxDynamicSharedMemorySize, LDS_BYTES) != hipSuccess) { fprintf(stderr, "kernel_launch: hipFuncSetAttribute failed\n"); grid = -1; return; }
        if (hipOccupancyMaxActiveBlocksPerMultiprocessor(&per_cu, (const void*)mega_fwd, NTHREADS, LDS_BYTES) != hipSuccess || per_cu < 1)
            fprintf(stderr, "kernel_launch: note: occupancy query reports %d workgroups per CU\n", per_cu);
        (void)hipGetLastError();
        grid = cus;
    }
    if (grid < 0) return;
    Params P{};
    for (int i = 0; i < 32; ++i) P.in[i] = (const float*)d_in[i];
    P.out = (float*)d_out; P.ws = (unsigned char*)d_ws;
    int nj = 0, items = 0;
    add_job(P, nj, items, 2, 1024, 4640, 0, 640, 1, 0, 1, 0, 0, OFF_WIN);
    add_job(P, nj, items, 2, 1024, 4640, 672, 1920, 1, 640, 1, 0, 0, OFF_WIN);
    add_job(P, nj, items, 2, 1024, 4640, 640, 32, 1, 0, 1, 0, 0, OFF_WKR);
    add_job(P, nj, items, 2, 1024, 4640, 2592, 1024, -1, 0, 1, 0, 0, OFF_WG);
    add_job(P, nj, items, 2, 1024, 4640, 3616, 1024, -1, 128, 1, 0, 0, OFF_WG);
    add_job(P, nj, items, 5, 384, 768, 0, 768, 1, 0, 1, 0, 0, OFF_WUQ);
    add_job(P, nj, items, 6, 256, 1024, 0, 1024, 1, 0, 1, 0, 0, OFF_WUKV);
    add_job(P, nj, items, 7, 512, 1024, 0, 1024, 1, 0, 1, 0, 0, OFF_WBM);
    add_job(P, nj, items, 20, 512, 1024, 0, 1024, 1, 0, 1, 0, 0, OFF_WBR);
    add_job(P, nj, items, 22, 1024, 1024, 0, 1024, 1, 0, 1, 0, 0, OFF_WOUT);
    add_job(P, nj, items, 11, 64, 512, 0, 512, 1, 0, 2, 64 * 512, 512 * 64, OFF_WUP);
    add_job(P, nj, items, 13, 64, 512, 0, 512, 1, 0, 2, 64 * 512, 512 * 64, OFF_AUP);
    add_job(P, nj, items, 14, 128, 512, 0, 512, 1, 0, 1, 0, 0, OFF_GUP, 256);
    P.njobs_early = nj; P.items_early = items;
    add_job(P, nj, items, 28, 1024, 256, 0, 256, 2, 0, 32, 1024 * 256, 512 * 1024, OFF_W13);
    add_job(P, nj, items, 29, 1024, 256, 0, 256, 2, 1, 32, 1024 * 256, 512 * 1024, OFF_W13);
    P.njobs_mid = nj; P.items_mid = items;
    add_job(P, nj, items, 30, 256, 1024, 0, 1024, 1, 0, 32, 256 * 1024, 1024 * 256, OFF_W2);
    P.njobs_all = nj; P.items_all = items;
    if (hipMemsetAsync((char*)d_ws + OFF_CTL, 0, CTL_ZERO_BYTES, stream) != hipSuccess) { fprintf(stderr, "kernel_launch: memset failed\n"); return; }
    hipLaunchKernelGGL(mega_fwd, dim3(grid), dim3(NTHREADS), LDS_BYTES, stream, P);
}
```

```cpp
#include <hip/hip_runtime.h>
#include <cstdio>
#include <cstdint>

#define DEVI __device__ __forceinline__
#ifndef PROBE_MASK
#define PROBE_MASK 0
#endif
typedef unsigned short bf16_t;
typedef short bf16x8 __attribute__((ext_vector_type(8)));
typedef short s16x4 __attribute__((ext_vector_type(4)));
typedef float f32x4 __attribute__((ext_vector_type(4)));
typedef float f32x16 __attribute__((ext_vector_type(16)));
typedef unsigned u32x4 __attribute__((ext_vector_type(4)));
typedef unsigned u32x2 __attribute__((ext_vector_type(2)));

constexpr int BATCH = 16, SEQ = 2048, DM = 1024, T_ = BATCH * SEQ;
constexpr int NH = 8;
constexpr int LDZ = 2560;
constexpr int NZ = 2560;
constexpr int ZR = 640;
constexpr int NEXP = 32, DEXP = 256;
constexpr int CAP = T_ * 2 + NEXP * 256;
constexpr int NBLK = CAP / 256;
constexpr int NTHREADS = 512, NWAVES = 8;

constexpr size_t MiB = 1u << 20;
constexpr size_t OFF_CTL = 0;
constexpr size_t OFF_WIN = 1 * MiB;
constexpr size_t OFF_WG = 7 * MiB;
constexpr size_t OFF_WUQ = 11 * MiB;
constexpr size_t OFF_WUKV = 12 * MiB;
constexpr size_t OFF_WBM = 13 * MiB;
constexpr size_t OFF_WBR = 14 * MiB;
constexpr size_t OFF_WOUT = 15 * MiB;
constexpr size_t OFF_WUP = 17 * MiB;
constexpr size_t OFF_AUP = 17 * MiB + 131072;
constexpr size_t OFF_GUP = 17 * MiB + 262144;
constexpr size_t OFF_WKR = 17 * MiB + 524288;
constexpr size_t OFF_ROPE = 18 * MiB;
constexpr size_t OFF_TOKE = 18 * MiB + 262144;
constexpr size_t OFF_TOKW = 18 * MiB + 524288;
constexpr size_t OFF_TOKS = 18 * MiB + 786432;
constexpr size_t OFF_TOKR = 19 * MiB;
constexpr size_t OFF_WRT = 19 * MiB + 524288;
constexpr size_t OFF_CNTWG = 19 * MiB + 786432;
constexpr size_t OFF_KROPE = 20 * MiB;
constexpr size_t OFF_YB = 22 * MiB;
constexpr size_t OFF_W13 = 366 * MiB;
constexpr size_t OFF_W2 = 54 * MiB;
constexpr size_t OFF_TW = 70 * MiB;
constexpr size_t OFF_AD = 78 * MiB;
constexpr size_t OFF_SG = 54 * MiB;
constexpr size_t OFF_Z = 94 * MiB;
constexpr size_t OFF_H = 302 * MiB;
constexpr size_t OFF_WL = 270 * MiB;
constexpr size_t OFF_G = 398 * MiB;
constexpr size_t OFF_OMLA = 430 * MiB;
constexpr size_t OFF_YF = 462 * MiB;
constexpr size_t OFF_H2ND = 94 * MiB;
constexpr size_t OFF_BR = 158 * MiB;
constexpr size_t OFF_BM = 94 * MiB;
constexpr size_t OFF_X1 = 94 * MiB;
constexpr size_t DOFF_H2 = 0;
constexpr size_t OFF_YE = 158 * MiB;
constexpr size_t DOFF_HID = 65 * MiB;
constexpr size_t OFF_VS = 270 * MiB;
constexpr size_t OFF_SDIR = 70 * MiB;
constexpr size_t OFF_MIXED = 222 * MiB;
constexpr size_t OFF_SLOTTOK = 338 * MiB;
constexpr size_t WS_NEED = 494 * MiB;
constexpr size_t DOFF_QRAW = 0, DOFF_KVRAW = 48 * MiB;

constexpr int C_CNT = 0, C_CUR = 64, C_PST = 128, C_NBLK = 192, C_BLKE = 256;

DEVI int my_tid() { int t = threadIdx.x; asm volatile("" : "+v"(t)); return t; }
DEVI float bf2f(unsigned h) { return __uint_as_float(h << 16); }
DEVI unsigned f2bf(float f) { unsigned u = __float_as_uint(f); return (u + 0x7fffu + ((u >> 16) & 1u)) >> 16; }
typedef float f32x2p __attribute__((ext_vector_type(2))); typedef __bf16 bf16x2p __attribute__((ext_vector_type(2)));
DEVI unsigned pk2(float lo, float hi) { const f32x2p v = {lo, hi}; return __builtin_bit_cast(unsigned, __builtin_convertvector(v, bf16x2p)); }
DEVI float lo16(unsigned w) { return __uint_as_float(w << 16); }
DEVI float hi16(unsigned w) { return __uint_as_float(w & 0xffff0000u); }
DEVI float wave_sum(float v) {
    v += __int_as_float(__builtin_amdgcn_update_dpp(0, __float_as_int(v), 0xB1, 0xF, 0xF, false));
    v += __int_as_float(__builtin_amdgcn_update_dpp(0, __float_as_int(v), 0x4E, 0xF, 0xF, false));
    v += __int_as_float(__builtin_amdgcn_update_dpp(0, __float_as_int(v), 0x141, 0xF, 0xF, false));
    v += __int_as_float(__builtin_amdgcn_update_dpp(0, __float_as_int(v), 0x140, 0xF, 0xF, false));
    v += __shfl_xor(v, 16); v += __shfl_xor(v, 32);
    return v;
}
DEVI float sigmoidf_(float x) { return __builtin_amdgcn_rcpf(1.f + __expf(-x)); }

struct TJob { int in_idx, K, ldsrc, col0, ncols, row_mul, row_off, nbatch; long long sbs, dbs, dst_off; int item0, dst_ld; };
constexpr int MAXJOBS = 16;
struct Params {
    const float* in[32];
    float* out;
    unsigned char* ws;
    TJob jobs[MAXJOBS];
    int njobs_early, njobs_all, items_early, items_all;
    int njobs_mid, items_mid;
};

DEVI void transpose_item(const float* W, int K, int ld, bf16_t* WT, int dst_ld, int row_off, int row_mul, float* scr, int kb, int nb, int lane) {
    const int k0 = 64 * kb, n0 = 32 * nb;
    float tv[32];
#pragma unroll
    for (int i = 0; i < 32; ++i) tv[i] = W[(size_t)(k0 + 2 * i + (lane >> 5)) * ld + n0 + (lane & 31)];
#pragma unroll
    for (int i = 0; i < 32; ++i) scr[(2 * i + (lane >> 5)) * 33 + (lane & 31)] = tv[i];
    asm volatile("s_waitcnt lgkmcnt(0)" ::: "memory");
    const int c = lane & 7;
#pragma unroll
    for (int j = 0; j < 4; ++j) {
        const int n = (lane >> 3) + 8 * j; const float* s = scr + (8 * c) * 33 + n;
        u32x4 o; o.x = pk2(s[0], s[33]); o.y = pk2(s[66], s[99]); o.z = pk2(s[132], s[165]); o.w = pk2(s[198], s[231]);
        const int nn = n0 + n;
        const int drow = row_mul > 0 ? row_off + nn * row_mul : row_off + ((nn >> 7) << 8) + (nn & 127);
        *(u32x4*)(WT + (size_t)drow * dst_ld + k0 + 8 * c) = o;
    }
    asm volatile("s_waitcnt lgkmcnt(0)" ::: "memory");
}
DEVI void stage_transposes(const Params& p, int j0, int j1, int item_base, int item_end, char* lds, int bid, int nb) {
    const int lane = my_tid() & 63, wave = my_tid() >> 6;
    float* scr = (float*)(lds + wave * 8704);
    const int gw = bid * NWAVES + wave, NGW = nb * NWAVES;
    for (int it = item_base + gw; it < item_end; it += NGW) {
        int j = j0;
        while (j + 1 < j1 && it >= p.jobs[j + 1].item0) ++j;
        const TJob& J = p.jobs[j];
        int r = it - J.item0;
        const int nblk = J.ncols / 32, per = (J.K / 64) * nblk;
        const int e = r / per; r -= e * per;
        const int kb = r / nblk, nbk = r % nblk;
        transpose_item(p.in[J.in_idx] + (size_t)e * J.sbs + J.col0, J.K, J.ldsrc, (bf16_t*)(p.ws + J.dst_off) + (size_t)e * J.dbs, J.dst_ld, J.row_off, J.row_mul, scr, kb, nbk, lane);
    }
}
DEVI void stage_rope_table(const Params& p, int bid, int nb) {
    float* ct = (float*)(p.ws + OFF_ROPE); float* st = ct + SEQ * 16;
    for (int i = bid * NTHREADS + my_tid(); i < SEQ * 16; i += nb * NTHREADS) {
        const int pos = i >> 4, f = i & 15;
        const double inv = pow(10000.0, -(double)(2 * f) / 32.0);
        const double ang = (double)pos * inv;
        ct[i] = (float)cos(ang); st[i] = (float)sin(ang);
    }
}

DEVI void stage_rms_rows(const float* x, const float* g, bf16_t* out, int bid, int nb) {
    const int lane = my_tid() & 63, wave = my_tid() >> 6;
    const int gw = bid * NWAVES + wave, NGW = nb * NWAVES;
    f32x4 gv[4];
#pragma unroll
    for (int j = 0; j < 4; ++j) gv[j] = *(const f32x4*)(g + 4 * lane + 256 * j);
    for (int mb = gw * 4; mb < T_; mb += NGW * 4) {
        f32x4 v[4][4];
#pragma unroll
        for (int q = 0; q < 4; ++q) { const f32x4* xr = (const f32x4*)(x + (size_t)(mb + q) * DM) + lane;
#pragma unroll
            for (int j = 0; j < 4; ++j) v[q][j] = xr[64 * j]; }
#pragma unroll
        for (int q = 0; q < 4; ++q) { float s = 0.f;
#pragma unroll
            for (int j = 0; j < 4; ++j) s += (v[q][j].x * v[q][j].x + v[q][j].y * v[q][j].y) + (v[q][j].z * v[q][j].z + v[q][j].w * v[q][j].w);
            const float rstd = rsqrtf(wave_sum(s) * (1.f / DM) + 1e-6f);
            u32x2* o8 = (u32x2*)(out + (size_t)(mb + q) * DM) + lane;
#pragma unroll
            for (int j = 0; j < 4; ++j) { u32x2 w; w.x = pk2(v[q][j].x * rstd * gv[j].x, v[q][j].y * rstd * gv[j].y); w.y = pk2(v[q][j].z * rstd * gv[j].z, v[q][j].w * rstd * gv[j].w); o8[64 * j] = w; } }
    }
}

typedef short v4i16_t_ __attribute__((ext_vector_type(4)));
DEVI s16x4 vtr_(const char* p) { return __builtin_bit_cast(s16x4, __builtin_amdgcn_ds_read_tr16_b64_v4i16((__attribute__((address_space(3))) v4i16_t_*)p)); }
struct EpiBf16 { bf16_t* out; int ld;
    DEVI void operator()(int row, int col, f32x4 v) const { u32x2 w; w.x = pk2(v.x, v.y); w.y = pk2(v.z, v.w); *(u32x2*)(out + (size_t)row * ld + col) = w; } };
struct EpiBiasAct { bf16_t* out; int ld; const float* bias; int act;
    DEVI void operator()(int row, int col, f32x4 v) const {
        const f32x4 b = *(const f32x4*)(bias + col); v = v + b;
        if (act) { v.x = sigmoidf_(v.x); v.y = sigmoidf_(v.y); v.z = sigmoidf_(v.z); v.w = sigmoidf_(v.w); }
        u32x2 w; w.x = pk2(v.x, v.y); w.y = pk2(v.z, v.w); *(u32x2*)(out + (size_t)row * ld + col) = w; } };
struct EpiMix { const bf16_t* gl; bf16_t* bm; const float* gb;
    DEVI void operator()(int row, int col, f32x4 v) const {
        const u32x2 g1 = *(const u32x2*)(gl + (size_t)row * 2048 + col), g2 = *(const u32x2*)(gl + (size_t)row * 2048 + 1024 + col);
        const u32x2 m = *(const u32x2*)(bm + (size_t)row * 1024 + col);
        const f32x4 b0 = *(const f32x4*)(gb + col), b1 = *(const f32x4*)(gb + 1024 + col);
        f32x4 r;
        r.x = sigmoidf_(lo16(g1.x) + b0.x) * lo16(m.x) + sigmoidf_(lo16(g2.x) + b1.x) * v.x;
        r.y = sigmoidf_(hi16(g1.x) + b0.y) * hi16(m.x) + sigmoidf_(hi16(g2.x) + b1.y) * v.y;
        r.z = sigmoidf_(lo16(g1.y) + b0.z) * lo16(m.y) + sigmoidf_(lo16(g2.y) + b1.z) * v.z;
        r.w = sigmoidf_(hi16(g1.y) + b0.w) * hi16(m.y) + sigmoidf_(hi16(g2.y) + b1.w) * v.w;
        u32x2 w; w.x = pk2(r.x, r.y); w.y = pk2(r.z, r.w); *(u32x2*)(bm + (size_t)row * 1024 + col) = w; } };
struct EpiResid { const float* x; float* out;
    DEVI void operator()(int row, int col, f32x4 v) const { const f32x4 b = *(const f32x4*)(x + (size_t)row * DM + col); *(f32x4*)(out + (size_t)row * DM + col) = b + v; } };
struct EpiSwiglu { bf16_t* hid;
    DEVI void operator()(int row, int col, f32x4 v) const {
        const float a = v.x * sigmoidf_(v.x) * v.y, b = v.z * sigmoidf_(v.z) * v.w;
        *(unsigned*)(hid + (size_t)row * DEXP + (col >> 1)) = pk2(a, b); } };

template <class Epi>
DEVI void gemm_stage(const bf16_t* A, int lda, const bf16_t* Bt, int ldb, int M, int N, int K, const Epi& epi, char* lds, int bid, int nb,
                     const int* rowidx, const int* blk_e, size_t estride) {
    const int tid = my_tid(), lane = tid & 63, wid = tid >> 6, wr = wid >> 1, wc = wid & 1;
    const int nM = M / 256, nN = (N + 127) / 128, nt = K / 64;
    for (int u = bid; u < nM * nN; u += nb) {
        const int pm = u / nN, pn = u % nN, m0 = pm * 256, n0 = pn * 128;
        const bf16_t* Bu = Bt;
        if (blk_e) { const int e = blk_e[pm]; if (e < 0) continue; Bu = Bt + (size_t)e * estride; }
        const bf16_t* ga[4]; const bf16_t* gb[2]; int offA[4], offB[2];
#pragma unroll
        for (int i = 0; i < 4; ++i) { const int pc = tid + 512 * i, row = pc >> 3, ch = pc & 7;
            int r = m0 + row; if (rowidx) r = rowidx[m0 + row];
            ga[i] = (r >= 0) ? A + (size_t)r * lda + ch * 8 : nullptr; offA[i] = row * 128 + ((ch ^ (row & 7)) << 4); }
#pragma unroll
        for (int i = 0; i < 2; ++i) { const int pc = tid + 512 * i, row = pc >> 3, ch = pc & 7; const int n = n0 + row;
            gb[i] = (n < N) ? Bu + (size_t)n * ldb + ch * 8 : nullptr; offB[i] = row * 128 + ((ch ^ (row & 7)) << 4); }
        u32x4 ra[4], rb[2];
        const u32x4 zero4 = {0u, 0u, 0u, 0u};
#define G_LOAD(kt) do { _Pragma("unroll") for (int i = 0; i < 4; ++i) ra[i] = ga[i] ? *(const u32x4*)(ga[i] + (kt) * 64) : zero4; \
                        _Pragma("unroll") for (int i = 0; i < 2; ++i) rb[i] = gb[i] ? *(const u32x4*)(gb[i] + (kt) * 64) : zero4; } while (0)
#define G_STORE(buf) do { _Pragma("unroll") for (int i = 0; i < 4; ++i) *(u32x4*)(lds + (buf) * 32768 + offA[i]) = ra[i]; \
                          _Pragma("unroll") for (int i = 0; i < 2; ++i) *(u32x4*)(lds + 65536 + (buf) * 16384 + offB[i]) = rb[i]; } while (0)
        f32x4 acc[4][4];
#pragma unroll
        for (int a = 0; a < 4; ++a)
#pragma unroll
            for (int b = 0; b < 4; ++b) acc[a][b] = (f32x4){0.f, 0.f, 0.f, 0.f};
        G_LOAD(0); G_STORE(0); __syncthreads();
        for (int kt = 0; kt < nt; ++kt) {
            const int buf = kt & 1;
            if (kt + 1 < nt) G_LOAD(kt + 1);
            const char* As = lds + buf * 32768; const char* Bs = lds + 65536 + buf * 16384;
#pragma unroll
            for (int kk = 0; kk < 2; ++kk) {
                bf16x8 af[4], bfr[4];
#pragma unroll
                for (int mi = 0; mi < 4; ++mi) { const int row = 64 * wr + 16 * mi + (lane & 15), ch = 4 * kk + (lane >> 4); af[mi] = *(const bf16x8*)(As + row * 128 + ((ch ^ (row & 7)) << 4)); }
#pragma unroll
                for (int ni = 0; ni < 4; ++ni) { const int row = 64 * wc + 16 * ni + (lane & 15), ch = 4 * kk + (lane >> 4); bfr[ni] = *(const bf16x8*)(Bs + row * 128 + ((ch ^ (row & 7)) << 4)); }
#pragma unroll
                for (int mi = 0; mi < 4; ++mi)
#pragma unroll
                    for (int ni = 0; ni < 4; ++ni) acc[mi][ni] = __builtin_amdgcn_mfma_f32_16x16x32_bf16(bfr[ni], af[mi], acc[mi][ni], 0, 0, 0);
            }
            if (kt + 1 < nt) G_STORE(buf ^ 1);
            __syncthreads();
        }
#undef G_LOAD
#undef G_STORE
#pragma unroll
        for (int mi = 0; mi < 4; ++mi)
#pragma unroll
            for (int ni = 0; ni < 4; ++ni) {
                const int row = m0 + 64 * wr + 16 * mi + (lane & 15), col = n0 + 64 * wc + 16 * ni + 4 * (lane >> 4);
                if (col < N) epi(row, col, acc[mi][ni]);
            }
    }
}


namespace pg8 {
#define PG8_LAS __attribute__((address_space(3)))
constexpr int BM = 256, BK = 64, HALF = 128, HTB = HALF * BK * 2, STAGE_BYTES = 8 * HTB, NXCD = 8, WGM = 8;
__host__ __device__ __forceinline__ int lds_byte(int r, int c) { const int st = (r >> 4) * 2 + (c >> 5), rr = r & 15, cc = c & 31, ob = rr * 64 + cc * 2; return st * 1024 + (ob ^ (((ob >> 9) & 1) << 5)); }
__host__ __device__ __forceinline__ void stage_rc(int b, int& R, int& C) { const int st = b / 1024, sb = b % 1024, swz = sb ^ (((sb >> 9) & 1) << 5); R = (st >> 1) * 16 + swz / 64; C = (st & 1) * 32 + (swz % 64) / 2; }
__host__ __device__ __forceinline__ int perm32(int rho) { const int n = rho >> 4, i = rho & 15; return 8 * (i >> 2) + 4 * n + (i & 3); }
struct Unit { int pm, pn, e; };
struct Gemm { const bf16_t* A; const bf16_t* Bt; int M, N, K, lda, ldb; size_t estride; const int* rowidx; };
struct StaticOrder {
    int nM, nN, nwg, G, c; const int* blk_e;
    __device__ void init(int M, int N, int G_, int c_, const int* be = nullptr) { nM = M / BM; nN = N / BM; nwg = nM * nN; G = G_; c = c_; blk_e = be; }
    __device__ bool next(int i, Unit& u) const {
        const long L = (long)i * G + c; if (L >= nwg) return false;
        int wgid = (int)L; { const int q = nwg / NXCD, r = nwg % NXCD, xcd = wgid % NXCD, off = wgid / NXCD; wgid = (xcd < r ? xcd * (q + 1) : r * (q + 1) + (xcd - r) * q) + off; }
        const int nig = WGM * nN, gid = wgid / nig, fm = gid * WGM, gsz = (nM - fm) < WGM ? (nM - fm) : WGM;
        u.pm = fm + ((wgid % nig) % gsz); u.pn = (wgid % nig) / gsz; u.e = blk_e ? blk_e[u.pm] : 0; return true;
    }
    __device__ __forceinline__ void a_ready(const Unit&) const {}
    __device__ __forceinline__ void done(const Unit&) const {}
};
template <class F> struct Epi8 {
    static constexpr bool PERM = true, AFTER_DRAIN = false; F f;
    __device__ __forceinline__ void operator()(const f32x4 (&acc)[2][2][4][2], const Unit& u, int wr, int wc, int fr, int fq) const {
#pragma unroll
        for (int ai = 0; ai < 2; ++ai)
#pragma unroll
            for (int m = 0; m < 4; ++m) { const int row = u.pm * BM + ai * HALF + wr * 64 + m * 16 + fr;
#pragma unroll
                for (int bj = 0; bj < 2; ++bj) f(row, u.pn * BM + bj * HALF + wc * 32 + 8 * fq, acc[ai][bj][m][0], acc[ai][bj][m][1]); }
    }
};
template <class Epi, class Sched, bool ALIGN_EPI = false, bool SP2 = false, bool GATHER = false>
__device__ __forceinline__ void gemm_phase(PG8_LAS unsigned char* lds, const Gemm g, const Sched& S, const Epi& E) {
    const int tid = my_tid(), wid = __builtin_amdgcn_readfirstlane(tid >> 6), lane = tid & 63, wr = wid >> 2, wc = wid & 3, fr = lane & 15, fq = lane >> 4;
    const int K = g.K, nt = K / BK;
    unsigned voffA[2], voffB[2]; int rA[2], cA2[2];
#pragma unroll
    for (int i = 0; i < 2; ++i) { int R, C; stage_rc(tid * 16 + i * 8192, R, C); const int Rb = Epi::PERM ? ((R & ~31) + perm32(R & 31)) : R; rA[i] = R; cA2[i] = C * 2;
        voffA[i] = (unsigned)(R * g.lda + C) * 2u; voffB[i] = (unsigned)(Rb * g.ldb + C) * 2u; }
    unsigned vAc[2][2], vAn[2][2];
#define PG8_VA(dst, pmv) do { _Pragma("unroll") for (int h_ = 0; h_ < 2; ++h_) _Pragma("unroll") for (int i_ = 0; i_ < 2; ++i_) { \
        if constexpr (GATHER) dst[h_][i_] = (unsigned)g.rowidx[(pmv) * BM + h_ * HALF + rA[i_]] * (unsigned)(g.lda * 2) + (unsigned)cA2[i_]; \
        else dst[h_][i_] = voffA[i_] + (unsigned)(h_ * HALF * g.lda * 2); } } while (0)
    const size_t kstep = (size_t)(BK * 2);
    const size_t hstepA = (size_t)HALF * g.lda * 2, hstepB = (size_t)HALF * g.ldb * 2;
    const size_t tstepA = 2 * hstepA, tstepB = 2 * hstepB, estep = g.estride * 2;
    const unsigned ldsw = (unsigned)wid * 1024u;
    const int aoff = lds_byte(wr * 64 + fr, fq * 8), boff = lds_byte(wc * 32 + fr, fq * 8);
#define PG8_SA(b, h) (((b) * 2 + (h)) * HTB)
#define PG8_SB(b, h) ((4 + (b) * 2 + (h)) * HTB)
#define PG8_STAGE(bufoff, gbase, voff) do { _Pragma("unroll") for (int _i = 0; _i < 2; ++_i) \
        __builtin_amdgcn_global_load_lds((const unsigned*)((const char*)(gbase) + (voff)[_i]), (PG8_LAS unsigned*)(lds + (bufoff) + ldsw + _i * 8192), 16, 0, 0); } while (0)
#define PG8_LDA(dst, b, h) do { _Pragma("unroll") for (int m = 0; m < 4; ++m) _Pragma("unroll") for (int k = 0; k < 2; ++k) dst[m][k] = *(const PG8_LAS bf16x8*)(lds + PG8_SA(b, h) + aoff + m * 2048 + k * 1024); } while (0)
#define PG8_LDB(dst, b, h) do { _Pragma("unroll") for (int n = 0; n < 2; ++n) _Pragma("unroll") for (int k = 0; k < 2; ++k) dst[n][k] = *(const PG8_LAS bf16x8*)(lds + PG8_SB(b, h) + boff + n * 2048 + k * 1024); } while (0)
#define PG8_MMA(ai, bj, At, Bt) do { __builtin_amdgcn_s_setprio(1); _Pragma("unroll") for (int m = 0; m < 4; ++m) _Pragma("unroll") for (int n = 0; n < 2; ++n) _Pragma("unroll") for (int k = 0; k < 2; ++k) \
        acc[ai][bj][m][n] = __builtin_amdgcn_mfma_f32_16x16x32_bf16(Bt[n][k], At[m][k], acc[ai][bj][m][n], 0, 0, 0); __builtin_amdgcn_s_setprio(0); } while (0)
#define PG8_WAIT_V(n) asm volatile("s_waitcnt vmcnt(" #n ")" ::: "memory")
#define PG8_WAIT_L(n) asm volatile("s_waitcnt lgkmcnt(" #n ")" ::: "memory")
#define PG8_BAR __builtin_amdgcn_s_barrier()
#define PG8_SCHED __builtin_amdgcn_sched_barrier(0)
    Unit cur, nxt; int ui = 0;
    if (!S.next(0, cur)) return;
    f32x4 acc[2][2][4][2];
#pragma unroll
    for (int a = 0; a < 2; ++a)
#pragma unroll
        for (int b = 0; b < 2; ++b)
#pragma unroll
            for (int m = 0; m < 4; ++m)
#pragma unroll
                for (int n = 0; n < 2; ++n) acc[a][b][m][n] = (f32x4){0.f, 0.f, 0.f, 0.f};
    bf16x8 At[4][2], B0[2][2], B1[2][2];
    const char* cA = (const char*)g.A + (GATHER ? (size_t)0 : (size_t)cur.pm * tstepA); const char* cB = (const char*)g.Bt + (size_t)cur.e * estep + (size_t)cur.pn * tstepB;
    PG8_VA(vAc, cur.pm);
    S.a_ready(cur);
    if constexpr (SP2) {
        PG8_STAGE(PG8_SB(0, 0), cB, voffB); PG8_STAGE(PG8_SB(0, 1), cB + hstepB, voffB); PG8_STAGE(PG8_SA(0, 0), cA, vAc[0]); PG8_STAGE(PG8_SA(0, 1), cA, vAc[1]);
        if (wr == 1) PG8_BAR;
        PG8_WAIT_V(2); PG8_BAR;
        PG8_STAGE(PG8_SB(1, 0), cB + kstep, voffB); PG8_STAGE(PG8_SA(1, 0), cA + kstep, vAc[0]); PG8_STAGE(PG8_SB(1, 1), cB + hstepB + kstep, voffB);
        PG8_WAIT_V(6); PG8_BAR;
    } else {
        PG8_STAGE(PG8_SB(0, 0), cB, voffB); PG8_STAGE(PG8_SA(0, 0), cA, voffA); PG8_STAGE(PG8_SB(0, 1), cB + hstepB, voffB); PG8_STAGE(PG8_SA(0, 1), cA + hstepA, voffA);
        if (wr == 1) PG8_BAR;
        PG8_WAIT_V(4); PG8_BAR;
        PG8_STAGE(PG8_SB(1, 0), cB + kstep, voffB); PG8_STAGE(PG8_SA(1, 0), cA + kstep, voffA); PG8_STAGE(PG8_SB(1, 1), cB + hstepB + kstep, voffB);
        PG8_WAIT_V(6); PG8_BAR;
    }
    for (;;) {
        const bool has_next = S.next(ui + 1, nxt);
        const char* nA = (has_next && !GATHER) ? (const char*)g.A + (size_t)nxt.pm * tstepA : cA; PG8_VA(vAn, (has_next ? nxt.pm : cur.pm)); const char* nB = has_next ? (const char*)g.Bt + (size_t)nxt.e * estep + (size_t)nxt.pn * tstepB : cB;
        for (int t = 0; t < nt; t += 2) {
            const bool last = (t == nt - 2);
            const char* a1 = cA + (size_t)(t + 1) * kstep;
            const char* a2 = last ? nA : cA + (size_t)(t + 2) * kstep; const char* b2 = last ? nB : cB + (size_t)(t + 2) * kstep;
            const char* a3 = a2 + kstep; const char* b3 = b2 + kstep;
            unsigned v2[2][2];
#pragma unroll
            for (int h_ = 0; h_ < 2; ++h_)
#pragma unroll
                for (int i_ = 0; i_ < 2; ++i_) v2[h_][i_] = last ? vAn[h_][i_] : vAc[h_][i_];
            if (last && has_next) S.a_ready(nxt);
            if constexpr (SP2) {
            PG8_LDB(B0, 0, 0); PG8_LDB(B1, 0, 1); PG8_SCHED; PG8_LDA(At, 0, 0); PG8_STAGE(PG8_SA(1, 1), a1, vAc[1]);
            PG8_WAIT_V(8); PG8_WAIT_L(0); PG8_BAR; PG8_MMA(0, 0, At, B0); PG8_MMA(0, 1, At, B1); PG8_BAR; PG8_SCHED;
            PG8_LDA(At, 0, 1); PG8_STAGE(PG8_SB(0, 0), b2, voffB); PG8_STAGE(PG8_SB(0, 1), b2 + hstepB, voffB); PG8_STAGE(PG8_SA(0, 0), a2, v2[0]);
            PG8_WAIT_V(8); PG8_WAIT_L(0); PG8_BAR; PG8_MMA(1, 0, At, B0); PG8_MMA(1, 1, At, B1); PG8_BAR; PG8_SCHED;
            PG8_LDB(B0, 1, 0); PG8_LDB(B1, 1, 1); PG8_SCHED; PG8_LDA(At, 1, 0); PG8_STAGE(PG8_SA(0, 1), a2, v2[1]);
            PG8_WAIT_V(8); PG8_WAIT_L(0); PG8_BAR; PG8_MMA(0, 0, At, B0); PG8_MMA(0, 1, At, B1); PG8_BAR; PG8_SCHED;
            PG8_LDA(At, 1, 1); PG8_STAGE(PG8_SB(1, 0), b3, voffB); PG8_STAGE(PG8_SB(1, 1), b3 + hstepB, voffB); PG8_STAGE(PG8_SA(1, 0), a3, v2[0]);
            PG8_WAIT_V(8); PG8_WAIT_L(0); PG8_BAR; PG8_MMA(1, 0, At, B0); PG8_MMA(1, 1, At, B1); PG8_BAR; PG8_SCHED;
            } else {
            PG8_LDB(B0, 0, 0); PG8_SCHED; PG8_LDA(At, 0, 0); PG8_STAGE(PG8_SA(1, 1), a1 + hstepA, voffA);
            PG8_WAIT_L(8); PG8_BAR; PG8_WAIT_L(0); PG8_MMA(0, 0, At, B0); PG8_BAR; PG8_SCHED;
            PG8_LDB(B1, 0, 1); PG8_STAGE(PG8_SB(0, 0), b2, voffB);
            PG8_BAR; PG8_WAIT_L(0); PG8_MMA(0, 1, At, B1); PG8_BAR;
            PG8_LDA(At, 0, 1); PG8_STAGE(PG8_SA(0, 0), a2, voffA);
            PG8_BAR; PG8_WAIT_L(0); PG8_MMA(1, 0, At, B0); PG8_BAR; PG8_SCHED;
            PG8_STAGE(PG8_SB(0, 1), b2 + hstepB, voffB);
            PG8_WAIT_V(6); PG8_BAR; PG8_MMA(1, 1, At, B1); PG8_BAR;
            PG8_LDB(B0, 1, 0); PG8_SCHED; PG8_LDA(At, 1, 0); PG8_STAGE(PG8_SA(0, 1), a2 + hstepA, voffA);
            PG8_WAIT_L(8); PG8_BAR; PG8_WAIT_L(0); PG8_MMA(0, 0, At, B0); PG8_BAR; PG8_SCHED;
            PG8_LDB(B1, 1, 1); PG8_STAGE(PG8_SB(1, 0), b3, voffB);
            PG8_BAR; PG8_WAIT_L(0); PG8_MMA(0, 1, At, B1); PG8_BAR;
            PG8_LDA(At, 1, 1); PG8_STAGE(PG8_SA(1, 0), a3, voffA);
            PG8_BAR; PG8_WAIT_L(0); PG8_MMA(1, 0, At, B0); PG8_BAR; PG8_SCHED;
            PG8_STAGE(PG8_SB(1, 1), b3 + hstepB, voffB);
            PG8_WAIT_V(6); PG8_BAR; PG8_MMA(1, 1, At, B1); PG8_BAR;
            }
        }
        if constexpr (ALIGN_EPI) { if (wr == 0) PG8_BAR; }
        if constexpr (!Epi::AFTER_DRAIN) { E(acc, cur, wr, wc, fr, fq); S.done(cur); }
        if (!has_next) break;
#pragma unroll
        for (int a = 0; a < 2; ++a)
#pragma unroll
            for (int b = 0; b < 2; ++b)
#pragma unroll
                for (int m = 0; m < 4; ++m)
#pragma unroll
                    for (int n = 0; n < 2; ++n) acc[a][b][m][n] = (f32x4){0.f, 0.f, 0.f, 0.f};
        cur = nxt; cA = nA; cB = nB; ++ui;
#pragma unroll
        for (int h_ = 0; h_ < 2; ++h_)
#pragma unroll
            for (int i_ = 0; i_ < 2; ++i_) vAc[h_][i_] = vAn[h_][i_];
        if constexpr (ALIGN_EPI) { if (wr == 1) PG8_BAR; }
    }
    PG8_WAIT_V(0);
    if constexpr (!ALIGN_EPI) { if (wr == 0) PG8_BAR; }
    PG8_BAR;
    if constexpr (Epi::AFTER_DRAIN) { E.fused(acc, cur, wr, wc, fr, fq, lds, wid, lane); S.done(cur); }
#undef PG8_VA
#undef PG8_SA
#undef PG8_SB
#undef PG8_STAGE
#undef PG8_LDA
#undef PG8_LDB
#undef PG8_MMA
#undef PG8_WAIT_V
#undef PG8_WAIT_L
#undef PG8_BAR
#undef PG8_SCHED
}
}

struct F8Bf16 { bf16_t* out; int ld;
    DEVI void operator()(int row, int col, f32x4 a, f32x4 b) const { u32x4 w; w.x = pk2(a.x, a.y); w.y = pk2(a.z, a.w); w.z = pk2(b.x, b.y); w.w = pk2(b.z, b.w); *(u32x4*)(out + (size_t)row * ld + col) = w; } };
struct F8Resid { const float* x; bf16_t* out;
    DEVI void operator()(int row, int col, f32x4 a, f32x4 b) const { const float* xp = x + (size_t)row * DM + col;
        a = a + *(const f32x4*)xp; b = b + *(const f32x4*)(xp + 4);
        u32x4 w; w.x = pk2(a.x, a.y); w.y = pk2(a.z, a.w); w.z = pk2(b.x, b.y); w.w = pk2(b.z, b.w); *(u32x4*)(out + (size_t)row * DM + col) = w; } };
struct F8Swiglu { bf16_t* hid;
    DEVI void operator()(int row, int col, f32x4 a, f32x4 b) const {
        u32x2 w; w.x = pk2(a.x * sigmoidf_(a.x) * a.y, a.z * sigmoidf_(a.z) * a.w); w.y = pk2(b.x * sigmoidf_(b.x) * b.y, b.z * sigmoidf_(b.z) * b.w);
        *(u32x2*)(hid + (size_t)row * DEXP + (col >> 1)) = w; } };
struct F8Mix { const bf16_t* gl; const bf16_t* bm; bf16_t* mixed; const float* gb;
    DEVI void operator()(int row, int col, f32x4 a, f32x4 b) const {
        const u32x4 g1 = *(const u32x4*)(gl + (size_t)row * 2048 + col), g2 = *(const u32x4*)(gl + (size_t)row * 2048 + 1024 + col);
        const u32x4 m = *(const u32x4*)(bm + (size_t)row * 1024 + col);
        const f32x4 b0a = *(const f32x4*)(gb + col), b0b = *(const f32x4*)(gb + col + 4), b1a = *(const f32x4*)(gb + 1024 + col), b1b = *(const f32x4*)(gb + 1024 + col + 4);
        float r[8];
        r[0] = sigmoidf_(lo16(g1.x) + b0a.x) * lo16(m.x) + sigmoidf_(lo16(g2.x) + b1a.x) * a.x;
        r[1] = sigmoidf_(hi16(g1.x) + b0a.y) * hi16(m.x) + sigmoidf_(hi16(g2.x) + b1a.y) * a.y;
        r[2] = sigmoidf_(lo16(g1.y) + b0a.z) * lo16(m.y) + sigmoidf_(lo16(g2.y) + b1a.z) * a.z;
        r[3] = sigmoidf_(hi16(g1.y) + b0a.w) * hi16(m.y) + sigmoidf_(hi16(g2.y) + b1a.w) * a.w;
        r[4] = sigmoidf_(lo16(g1.z) + b0b.x) * lo16(m.z) + sigmoidf_(lo16(g2.z) + b1b.x) * b.x;
        r[5] = sigmoidf_(hi16(g1.z) + b0b.y) * hi16(m.z) + sigmoidf_(hi16(g2.z) + b1b.y) * b.y;
        r[6] = sigmoidf_(lo16(g1.w) + b0b.z) * lo16(m.w) + sigmoidf_(lo16(g2.w) + b1b.z) * b.z;
        r[7] = sigmoidf_(hi16(g1.w) + b0b.w) * hi16(m.w) + sigmoidf_(hi16(g2.w) + b1b.w) * b.w;
        u32x4 w; w.x = pk2(r[0], r[1]); w.y = pk2(r[2], r[3]); w.z = pk2(r[4], r[5]); w.w = pk2(r[6], r[7]);
        *(u32x4*)(mixed + (size_t)row * 1024 + col) = w; } };
template <class F, bool GATHER = false>
DEVI void big_gemm_(char* lds, const bf16_t* A, int lda, const bf16_t* Bt, int ldb, int M, int N, int K, const F& f, int bid, int nb, const int* blk_e, size_t estride, const int* rowidx) {
    int Kr = K; asm volatile("" : "+s"(Kr));
    pg8::Gemm g{A, Bt, M, N, Kr, lda, ldb, estride, rowidx}; pg8::StaticOrder S; S.init(M, N, nb, bid, blk_e);
    pg8::Epi8<F> E{f};
    pg8::gemm_phase<pg8::Epi8<F>, pg8::StaticOrder, true, true, GATHER>((PG8_LAS unsigned char*)lds, g, S, E);
}
template <class F>
DEVI void big_gemm(char* lds, const bf16_t* A, int lda, const bf16_t* Bt, int ldb, int M, int N, int K, const F& f, int bid, int nb, const int* blk_e = nullptr, size_t estride = 0) {
    big_gemm_<F, false>(lds, A, lda, Bt, ldb, M, N, K, f, bid, nb, blk_e, estride, nullptr);
}

struct EpiGate { static constexpr bool PERM = true, AFTER_DRAIN = false; const bf16_t* bm; const bf16_t* br; bf16_t* mixed; const float* gb;
    __device__ __forceinline__ void operator()(const f32x4 (&acc)[2][2][4][2], const pg8::Unit& u, int wr, int wc, int fr, int fq) const {
        const int oc = u.pn * 128 + wc * 32 + 8 * fq;
        const f32x4 b0a = *(const f32x4*)(gb + oc), b0b = *(const f32x4*)(gb + oc + 4), b1a = *(const f32x4*)(gb + 1024 + oc), b1b = *(const f32x4*)(gb + 1024 + oc + 4);
#pragma unroll
        for (int ai = 0; ai < 2; ++ai)
#pragma unroll
            for (int m = 0; m < 4; ++m) { const int row = u.pm * pg8::BM + ai * pg8::HALF + wr * 64 + m * 16 + fr;
                const u32x4 mm = *(const u32x4*)(bm + (size_t)row * 1024 + oc), rr = *(const u32x4*)(br + (size_t)row * 1024 + oc);
                const f32x4 g1a = acc[ai][0][m][0], g1b = acc[ai][0][m][1], g2a = acc[ai][1][m][0], g2b = acc[ai][1][m][1];
                float r[8];
                r[0] = sigmoidf_(g1a.x + b0a.x) * lo16(mm.x) + sigmoidf_(g2a.x + b1a.x) * lo16(rr.x);
                r[1] = sigmoidf_(g1a.y + b0a.y) * hi16(mm.x) + sigmoidf_(g2a.y + b1a.y) * hi16(rr.x);
                r[2] = sigmoidf_(g1a.z + b0a.z) * lo16(mm.y) + sigmoidf_(g2a.z + b1a.z) * lo16(rr.y);
                r[3] = sigmoidf_(g1a.w + b0a.w) * hi16(mm.y) + sigmoidf_(g2a.w + b1a.w) * hi16(rr.y);
                r[4] = sigmoidf_(g1b.x + b0b.x) * lo16(mm.z) + sigmoidf_(g2b.x + b1b.x) * lo16(rr.z);
                r[5] = sigmoidf_(g1b.y + b0b.y) * hi16(mm.z) + sigmoidf_(g2b.y + b1b.y) * hi16(rr.z);
                r[6] = sigmoidf_(g1b.z + b0b.z) * lo16(mm.w) + sigmoidf_(g2b.z + b1b.z) * lo16(rr.w);
                r[7] = sigmoidf_(g1b.w + b0b.w) * hi16(mm.w) + sigmoidf_(g2b.w + b1b.w) * hi16(rr.w);
                u32x4 w; w.x = pk2(r[0], r[1]); w.y = pk2(r[2], r[3]); w.z = pk2(r[4], r[5]); w.w = pk2(r[6], r[7]);
                *(u32x4*)(mixed + (size_t)row * 1024 + oc) = w; }
    }
};
template <class E>
DEVI void big_gemm_epi(char* lds, const bf16_t* A, int lda, const bf16_t* Bt, int ldb, int M, int N, int K, const E& e, int bid, int nb) {
    int Kr = K; asm volatile("" : "+s"(Kr));
    pg8::Gemm g{A, Bt, M, N, Kr, lda, ldb, 0, nullptr}; pg8::StaticOrder S; S.init(M, N, nb, bid, nullptr);
    pg8::gemm_phase<E, pg8::StaticOrder, true, true, false>((PG8_LAS unsigned char*)lds, g, S, e);
}

DEVI void stage_mla_prep(const Params& p, int bid, int nb, bool dry = false) {
    const int lane = my_tid() & 63, wave = my_tid() >> 6;
    const int gw = bid * NWAVES + wave, NGW = nb * NWAVES;
    bf16_t* z = (bf16_t*)(p.ws + OFF_Z); bf16_t* krope = (bf16_t*)(p.ws + OFF_KROPE);
    const float* ct = (const float*)(p.ws + OFF_ROPE); const float* st = ct + SEQ * 16;
    const float* gq = p.in[3]; const float* gkv = p.in[4];
    for (int t = gw; t < T_; t += NGW) {
        bf16_t* zr = z + (size_t)t * LDZ;
        const u32x4 A = *(const u32x4*)(zr + 8 * lane);
        u32x4 B = {0u, 0u, 0u, 0u}; if (lane < 16) B = *(const u32x4*)(zr + 512 + 8 * lane);
        float a[8], b[8];
        a[0] = lo16(A.x); a[1] = hi16(A.x); a[2] = lo16(A.y); a[3] = hi16(A.y); a[4] = lo16(A.z); a[5] = hi16(A.z); a[6] = lo16(A.w); a[7] = hi16(A.w);
        b[0] = lo16(B.x); b[1] = hi16(B.x); b[2] = lo16(B.y); b[3] = hi16(B.y); b[4] = lo16(B.z); b[5] = hi16(B.z); b[6] = lo16(B.w); b[7] = hi16(B.w);
        float sa = 0.f, sb = 0.f;
#pragma unroll
        for (int j = 0; j < 8; ++j) { sa += a[j] * a[j]; sb += b[j] * b[j]; }
        const bool isq = lane < 48;
        const float ssq = wave_sum(isq ? sa : 0.f), sskv = wave_sum((isq ? 0.f : sa) + sb);
        const float rq = rsqrtf(ssq * (1.f / 384.f) + 1e-6f), rkv = rsqrtf(sskv * (1.f / 256.f) + 1e-6f);
        {
            const float r = isq ? rq : rkv; const float* g = isq ? gq + 8 * lane : gkv + 8 * (lane - 48);
            u32x4 o; o.x = pk2(a[0] * r * g[0], a[1] * r * g[1]); o.y = pk2(a[2] * r * g[2], a[3] * r * g[3]); o.z = pk2(a[4] * r * g[4], a[5] * r * g[5]); o.w = pk2(a[6] * r * g[6], a[7] * r * g[7]);
            if (!dry) *(u32x4*)(zr + 8 * lane) = o; else asm volatile("" :: "v"(o));
        }
        if (lane < 16) {
            const float* g = gkv + 8 * (lane + 16);
            u32x4 o; o.x = pk2(b[0] * rkv * g[0], b[1] * rkv * g[1]); o.y = pk2(b[2] * rkv * g[2], b[3] * rkv * g[3]); o.z = pk2(b[4] * rkv * g[4], b[5] * rkv * g[5]); o.w = pk2(b[6] * rkv * g[6], b[7] * rkv * g[7]);
            if (!dry) *(u32x4*)(zr + 512 + 8 * lane) = o; else asm volatile("" :: "v"(o));
        }
    }
    const bf16_t* hb = (const bf16_t*)(p.ws + OFF_H); const bf16_t* wkr = (const bf16_t*)(p.ws + OFF_WKR);
    for (int tb = gw * 16; tb < T_; tb += NGW * 16) {
        const int li = lane & 15, kq = lane >> 4;
        const bf16_t* ap = hb + (size_t)(tb + li) * DM + 8 * kq; const bf16_t* b0p = wkr + (size_t)li * DM + 8 * kq; const bf16_t* b1p = b0p + 16 * DM;
        f32x4 a0 = {0.f, 0.f, 0.f, 0.f}, a1 = a0;
#pragma unroll 8
        for (int ks = 0; ks < 32; ++ks) {
            const bf16x8 av = *(const bf16x8*)(ap + 32 * ks);
            a0 = __builtin_amdgcn_mfma_f32_16x16x32_bf16(av, *(const bf16x8*)(b0p + 32 * ks), a0, 0, 0, 0);
            a1 = __builtin_amdgcn_mfma_f32_16x16x32_bf16(av, *(const bf16x8*)(b1p + 32 * ks), a1, 0, 0, 0);
        }
#pragma unroll
        for (int r = 0; r < 4; ++r) { const int t = tb + 4 * kq + r, pos = t & (SEQ - 1);
            const float c = ct[pos * 16 + li], s = st[pos * 16 + li];
            if (!dry) { krope[(size_t)t * 32 + li] = (bf16_t)f2bf(a0[r] * c - a1[r] * s); krope[(size_t)t * 32 + 16 + li] = (bf16_t)f2bf(a0[r] * s + a1[r] * c); } }
    }
}

DEVI void stage_sg_prep(const Params& p, int bid, int nb) {
    const bf16_t* z = (const bf16_t*)(p.ws + OFF_Z); bf16_t* sg = (bf16_t*)(p.ws + OFF_SG);
    const float* mup = p.in[8] + 1792; const float* mun = p.in[9] + 1792;
    for (int i = bid * NTHREADS + my_tid(); i < T_ * 32; i += nb * NTHREADS) {
        const int t = i >> 5, c = (i & 31) * 8, s = t & (SEQ - 1);
        u32x4 o = {0u, 0u, 0u, 0u};
        if (c < 128) {
            const bf16_t* zp = z + (size_t)t * LDZ + ZR + 1792 + c;
            const u32x4 z4 = {0u, 0u, 0u, 0u};
            const u32x4 w0 = *(const u32x4*)zp, wm = (s > 0) ? *(const u32x4*)(zp - LDZ) : z4, wn = (s < SEQ - 1) ? *(const u32x4*)(zp + LDZ) : z4;
            const float z0[8] = {lo16(w0.x), hi16(w0.x), lo16(w0.y), hi16(w0.y), lo16(w0.z), hi16(w0.z), lo16(w0.w), hi16(w0.w)};
            const float zm[8] = {lo16(wm.x), hi16(wm.x), lo16(wm.y), hi16(wm.y), lo16(wm.z), hi16(wm.z), lo16(wm.w), hi16(wm.w)};
            const float zn[8] = {lo16(wn.x), hi16(wn.x), lo16(wn.y), hi16(wn.y), lo16(wn.z), hi16(wn.z), lo16(wn.w), hi16(wn.w)};
            float r[8];
#pragma unroll
            for (int j = 0; j < 8; ++j) r[j] = sigmoidf_(z0[j] + mup[c + j] * (zm[j] - z0[j]) + mun[c + j] * (zn[j] - z0[j]));
            o.x = pk2(r[0], r[1]); o.y = pk2(r[2], r[3]); o.z = pk2(r[4], r[5]); o.w = pk2(r[6], r[7]);
        }
        *(u32x4*)(sg + (size_t)t * 256 + c) = o;
    }
}

DEVI float max3f_(float a, float b, float c) { return __builtin_fmaxf(__builtin_fmaxf(a, b), c); }
constexpr int KROW = 208, VROW = 192;
constexpr int ATT_KB = 64 * KROW, ATT_VB = 64 * VROW;
DEVI void attn_unit(const Params& p, int u, char* lds) {
    const int tid = my_tid(), lane = tid & 63, wid = tid >> 6, r32 = lane & 31, hi = lane >> 5;
    const int bh = u >> 3, qb = u & 7, b = bh >> 3, h = bh & 7;
    const bf16_t* qraw = (const bf16_t*)((const char*)p.out + DOFF_QRAW);
    const bf16_t* kvraw = (const bf16_t*)((const char*)p.out + DOFF_KVRAW);
    const bf16_t* krope = (const bf16_t*)(p.ws + OFF_KROPE);
    const float* ct = (const float*)(p.ws + OFF_ROPE); const float* st = ct + SEQ * 16;
    bf16_t* omla = (bf16_t*)(p.ws + OFF_OMLA);
    const size_t rowb = (size_t)b * SEQ;
    const int sq = qb * 256 + wid * 32 + r32;
    const float QS = 0.10206207261596577f * 1.4426950408889634f;
    bf16x8 qf[6];
    {
        const bf16_t* qp = qraw + (rowb + sq) * 768 + h * 96;
        u32x4 w[6];
#pragma unroll
        for (int ks = 0; ks < 6; ++ks) w[ks] = *(const u32x4*)(qp + 16 * ks + 8 * hi);
#pragma unroll
        for (int ks = 0; ks < 4; ++ks) {
            u32x4 o; o.x = pk2(lo16(w[ks].x) * QS, hi16(w[ks].x) * QS); o.y = pk2(lo16(w[ks].y) * QS, hi16(w[ks].y) * QS);
            o.z = pk2(lo16(w[ks].z) * QS, hi16(w[ks].z) * QS); o.w = pk2(lo16(w[ks].w) * QS, hi16(w[ks].w) * QS);
            qf[ks] = __builtin_bit_cast(bf16x8, o);
        }
        float x1[8], x2[8], y1[8], y2[8];
        x1[0] = lo16(w[4].x); x1[1] = hi16(w[4].x); x1[2] = lo16(w[4].y); x1[3] = hi16(w[4].y); x1[4] = lo16(w[4].z); x1[5] = hi16(w[4].z); x1[6] = lo16(w[4].w); x1[7] = hi16(w[4].w);
        x2[0] = lo16(w[5].x); x2[1] = hi16(w[5].x); x2[2] = lo16(w[5].y); x2[3] = hi16(w[5].y); x2[4] = lo16(w[5].z); x2[5] = hi16(w[5].z); x2[6] = lo16(w[5].w); x2[7] = hi16(w[5].w);
#pragma unroll
        for (int j = 0; j < 8; ++j) { const float c = ct[sq * 16 + 8 * hi + j], s = st[sq * 16 + 8 * hi + j]; y1[j] = (x1[j] * c - x2[j] * s) * QS; y2[j] = (x1[j] * s + x2[j] * c) * QS; }
        u32x4 o4, o5;
        o4.x = pk2(y1[0], y1[1]); o4.y = pk2(y1[2], y1[3]); o4.z = pk2(y1[4], y1[5]); o4.w = pk2(y1[6], y1[7]);
        o5.x = pk2(y2[0], y2[1]); o5.y = pk2(y2[2], y2[3]); o5.z = pk2(y2[4], y2[5]); o5.w = pk2(y2[6], y2[7]);
        qf[4] = __builtin_bit_cast(bf16x8, o4); qf[5] = __builtin_bit_cast(bf16x8, o5);
    }
    const int kp0r = tid / 12, kp0c = tid % 12;
    const int kp1 = 512 + tid, kp1r = kp1 / 12, kp1c = kp1 % 12;
    const int vr = tid >> 3, vc = tid & 7;
    u32x4 rk0, rk1, rv;
#define A_LOAD(t) do { const size_t base = rowb + (size_t)(t) * 64; \
        rk0 = (kp0c < 8) ? *(const u32x4*)(kvraw + (base + kp0r) * 1024 + h * 128 + 8 * kp0c) : *(const u32x4*)(krope + (base + kp0r) * 32 + 8 * (kp0c - 8)); \
        if (tid < 256) rk1 = (kp1c < 8) ? *(const u32x4*)(kvraw + (base + kp1r) * 1024 + h * 128 + 8 * kp1c) : *(const u32x4*)(krope + (base + kp1r) * 32 + 8 * (kp1c - 8)); \
        rv = *(const u32x4*)(kvraw + (base + vr) * 1024 + h * 128 + 64 + 8 * vc); } while (0)
#define A_STORE(buf) do { char* Kb_ = lds + (buf) * ATT_KB; char* Vb_ = lds + 2 * ATT_KB + (buf) * ATT_VB; \
        *(u32x4*)(Kb_ + kp0r * KROW + kp0c * 16) = rk0; if (tid < 256) *(u32x4*)(Kb_ + kp1r * KROW + kp1c * 16) = rk1; \
        *(u32x4*)(Vb_ + vr * VROW + vc * 16) = rv; } while (0)
    float mhat = 0.f, l = 0.f;
    f32x16 o0, o1, negm;
#pragma unroll
    for (int r = 0; r < 16; ++r) { o0[r] = 0.f; o1[r] = 0.f; negm[r] = 0.f; }
    A_LOAD(0); A_STORE(0); __syncthreads();
    constexpr int NT = SEQ / 64;
    for (int t = 0; t < NT; ++t) {
        const int buf = t & 1;
        if (t + 1 < NT) A_LOAD(t + 1);
        const char* Kb = lds + buf * ATT_KB; const char* Vb = lds + 2 * ATT_KB + buf * ATT_VB;
        f32x16 p0 = negm, p1 = negm;
#pragma unroll
        for (int ks = 0; ks < 6; ++ks) {
            const bf16x8 k0 = *(const bf16x8*)(Kb + r32 * KROW + 32 * ks + 16 * hi);
            const bf16x8 k1 = *(const bf16x8*)(Kb + (32 + r32) * KROW + 32 * ks + 16 * hi);
            p0 = __builtin_amdgcn_mfma_f32_32x32x16_bf16(k0, qf[ks], p0, 0, 0, 0);
            p1 = __builtin_amdgcn_mfma_f32_32x32x16_bf16(k1, qf[ks], p1, 0, 0, 0);
        }
        float mxa = max3f_(p0[0], p0[1], p1[0]), mxb = max3f_(p0[2], p0[3], p1[1]); mxa = max3f_(mxa, p1[2], p1[3]);
#pragma unroll
        for (int r = 4; r < 16; r += 4) { mxa = max3f_(mxa, p0[r], p0[r + 1]); mxb = max3f_(mxb, p0[r + 2], p0[r + 3]); mxa = max3f_(mxa, p1[r], p1[r + 1]); mxb = max3f_(mxb, p1[r + 2], p1[r + 3]); }
        float rm = max3f_(mxa, mxb, mxb); rm = max3f_(rm, __shfl_xor(rm, 32), rm);
        if (t == 0 || __any(rm > 8.f)) {
            const float dl = (t == 0) ? rm : fmaxf(rm, 0.f); mhat += dl;
            const float f = __builtin_amdgcn_exp2f(-dl); l *= f;
#pragma unroll
            for (int r = 0; r < 16; ++r) { p0[r] -= dl; p1[r] -= dl; o0[r] *= f; o1[r] *= f; negm[r] = -mhat; }
        }
        float sum = 0.f;
#pragma unroll
        for (int r = 0; r < 16; ++r) { p0[r] = __builtin_amdgcn_exp2f(p0[r]); p1[r] = __builtin_amdgcn_exp2f(p1[r]); sum += p0[r] + p1[r]; }
        l += sum;
        bf16x8 pb[4];
        {
            u32x4 w;
            w.x = pk2(p0[0], p0[1]); w.y = pk2(p0[2], p0[3]); w.z = pk2(p0[4], p0[5]); w.w = pk2(p0[6], p0[7]); pb[0] = __builtin_bit_cast(bf16x8, w);
            w.x = pk2(p0[8], p0[9]); w.y = pk2(p0[10], p0[11]); w.z = pk2(p0[12], p0[13]); w.w = pk2(p0[14], p0[15]); pb[1] = __builtin_bit_cast(bf16x8, w);
            w.x = pk2(p1[0], p1[1]); w.y = pk2(p1[2], p1[3]); w.z = pk2(p1[4], p1[5]); w.w = pk2(p1[6], p1[7]); pb[2] = __builtin_bit_cast(bf16x8, w);
            w.x = pk2(p1[8], p1[9]); w.y = pk2(p1[10], p1[11]); w.z = pk2(p1[12], p1[13]); w.w = pk2(p1[14], p1[15]); pb[3] = __builtin_bit_cast(bf16x8, w);
        }
#pragma unroll
        for (int s = 0; s < 4; ++s) {
            const char* vtp = Vb + (16 * s + 4 * hi + ((lane & 15) >> 2)) * VROW + (16 * ((lane >> 4) & 1) + 4 * (lane & 3)) * 2;
            const s16x4 a0 = vtr_(vtp), a1 = vtr_(vtp + 8 * VROW);
            const s16x4 c0 = vtr_(vtp + 64), c1 = vtr_(vtp + 8 * VROW + 64);
            const bf16x8 va0 = {a0[0], a0[1], a0[2], a0[3], a1[0], a1[1], a1[2], a1[3]};
            const bf16x8 va1 = {c0[0], c0[1], c0[2], c0[3], c1[0], c1[1], c1[2], c1[3]};
            o0 = __builtin_amdgcn_mfma_f32_32x32x16_bf16(va0, pb[s], o0, 0, 0, 0);
            o1 = __builtin_amdgcn_mfma_f32_32x32x16_bf16(va1, pb[s], o1, 0, 0, 0);
        }
        if (t + 1 < NT) A_STORE(buf ^ 1);
        __syncthreads();
    }
#undef A_LOAD
#undef A_STORE
    l += __shfl_xor(l, 32);
    const float inv = 1.f / l;
    bf16_t* op = omla + (rowb + sq) * 512 + h * 64;
#pragma unroll
    for (int g = 0; g < 4; ++g) {
        const int d0 = 8 * g + 4 * hi;
        u32x2 w; w.x = pk2(o0[4 * g] * inv, o0[4 * g + 1] * inv); w.y = pk2(o0[4 * g + 2] * inv, o0[4 * g + 3] * inv);
        *(u32x2*)(op + d0) = w;
        w.x = pk2(o1[4 * g] * inv, o1[4 * g + 1] * inv); w.y = pk2(o1[4 * g + 2] * inv, o1[4 * g + 3] * inv);
        *(u32x2*)(op + 32 + d0) = w;
    }
}

typedef _Float16 f16x4 __attribute__((ext_vector_type(4)));
typedef _Float16 f16x8 __attribute__((ext_vector_type(8)));
DEVI float dppx1(float x) { return __int_as_float(__builtin_amdgcn_update_dpp(0, __float_as_int(x), 0xB1, 0xF, 0xF, false)); }
DEVI float dppx2(float x) { return __int_as_float(__builtin_amdgcn_update_dpp(0, __float_as_int(x), 0x4E, 0xF, 0xF, false)); }
DEVI float dpphm(float x) { return __int_as_float(__builtin_amdgcn_update_dpp(0, __float_as_int(x), 0x141, 0xF, 0xF, false)); }
DEVI float red8(float x) { x += dppx1(x); x += dppx2(x); x += dpphm(x); return x; }
DEVI float fmix_lo(float a, unsigned h, float c) { float d; asm("v_fma_mix_f32 %0, %1, %2, %3 op_sel_hi:[0,1,0]" : "=v"(d) : "v"(a), "v"(h), "v"(c)); return d; }
DEVI float fmix_hi(float a, unsigned h, float c) { float d; asm("v_fma_mix_f32 %0, %1, %2, %3 op_sel:[0,1,0] op_sel_hi:[0,1,0]" : "=v"(d) : "v"(a), "v"(h), "v"(c)); return d; }
DEVI float mmix_lo(float a, unsigned h) { float d; asm("v_fma_mix_f32 %0, %1, %2, 0 op_sel_hi:[0,1,0]" : "=v"(d) : "v"(a), "v"(h)); return d; }
DEVI float mmix_hi(float a, unsigned h) { float d; asm("v_fma_mix_f32 %0, %1, %2, 0 op_sel:[0,1,0] op_sel_hi:[0,1,0]" : "=v"(d) : "v"(a), "v"(h)); return d; }
DEVI float fmix2_lo(unsigned v, unsigned h, float c) { float d; asm("v_fma_mix_f32 %0, %1, %2, %3 op_sel_hi:[1,1,0]" : "=v"(d) : "v"(v), "v"(h), "v"(c)); return d; }
DEVI float fmix2_hi(unsigned v, unsigned h, float c) { float d; asm("v_fma_mix_f32 %0, %1, %2, %3 op_sel:[0,1,0] op_sel_hi:[1,1,0]" : "=v"(d) : "v"(v), "v"(h), "v"(c)); return d; }
DEVI float fmix_h0(unsigned hv, float b, float c) { float d; asm("v_fma_mix_f32 %0, %1, %2, %3 op_sel_hi:[1,0,0]" : "=v"(d) : "v"(hv), "v"(b), "v"(c)); return d; }
DEVI void unpack8(const u32x4 w, float (&f)[8]) { f[0] = lo16(w.x); f[1] = hi16(w.x); f[2] = lo16(w.y); f[3] = hi16(w.y); f[4] = lo16(w.z); f[5] = hi16(w.z); f[6] = lo16(w.w); f[7] = hi16(w.w); }
DEVI u32x4 pack8(const float (&f)[8]) { u32x4 w; w.x = pk2(f[0], f[1]); w.y = pk2(f[2], f[3]); w.z = pk2(f[4], f[5]); w.w = pk2(f[6], f[7]); return w; }
DEVI u32x4 pack8h(const float (&f)[8]) { f16x8 h;
#pragma unroll
    for (int j = 0; j < 8; ++j) h[j] = (_Float16)f[j];
    return __builtin_bit_cast(u32x4, h); }
constexpr int SLOT = 9216;
constexpr int SL_AT = 0, SL_BT = 1, SL_KT = 2, SL_RT = 3, SL_VT = 4, SL_BH = 5, SL_KH = 6, SL_S0 = 7, SL_MOFF = 8, SL_MOFFT = 9, SL_MAK = 10, SL_LRB = 11, SL_LRK = 12;
constexpr int SL_DD = 1, SL_DDT = 2, SL_N = 10, SL_NT = 12, SL_N2 = 6, SL_W1T = 8, SL_W1 = 9, SL_T = 4, SL_RHST = 1, SL_UT = 2;
constexpr int L_G = 8 * SLOT;
constexpr int L_TW = 10 * SLOT, L_AD = 11 * SLOT;
constexpr int L_ATMP = 12 * SLOT;
constexpr int L_FD = 13 * SLOT;
constexpr int L_C = L_FD + 8 * 272 * 4;
constexpr int L_SEG = L_C + (896 + 320) * 4;
constexpr int L_CHAIN_END = L_SEG + 8 * 64 * 4;
static_assert(L_CHAIN_END <= 147200, "chain LDS");
DEVI f32x16 mm_tile(f32x16 acc, const char* Yt, const char* Xt, int jt, int it, int r32, int hi) {
    const char* yp = Yt + (32 * jt + r32) * 144 + 16 * hi; const char* xp = Xt + (32 * it + r32) * 144 + 16 * hi;
#pragma unroll
    for (int ks = 0; ks < 4; ++ks) acc = __builtin_amdgcn_mfma_f32_32x32x16_bf16(*(const bf16x8*)(xp + 32 * ks), *(const bf16x8*)(yp + 32 * ks), acc, 0, 0, 0);
    return acc;
}
DEVI bf16x8 frag_tr(const char* T, int col0, int ks, int lane, int hi) {
    const char* p = T + (16 * ks + 8 * hi + ((lane & 15) >> 2)) * 144 + (col0 + 16 * ((lane >> 4) & 1) + 4 * (lane & 3)) * 2;
    const s16x4 a = vtr_(p), b = vtr_(p + 4 * 144);
    return (bf16x8){a[0], a[1], a[2], a[3], b[0], b[1], b[2], b[3]};
}
template <bool YT, bool XT>
DEVI f32x16 mm_tile2(f32x16 acc, const char* Yt, const char* Xt, int jt, int it, int lane, int r32, int hi) {
#pragma unroll
    for (int ks = 0; ks < 4; ++ks) {
        const bf16x8 yf = YT ? frag_tr(Yt, 32 * jt, ks, lane, hi) : *(const bf16x8*)(Yt + (32 * jt + r32) * 144 + 16 * hi + 32 * ks);
        const bf16x8 xf = XT ? frag_tr(Xt, 32 * it, ks, lane, hi) : *(const bf16x8*)(Xt + (32 * it + r32) * 144 + 16 * hi + 32 * ks);
        acc = __builtin_amdgcn_mfma_f32_32x32x16_bf16(xf, yf, acc, 0, 0, 0);
    }
    return acc;
}
template <class M> DEVI void st_tile(char* Ot, int jt, int it, int r32, int hi, const f32x16& acc, M mask) {
    const int row = 32 * jt + r32;
#pragma unroll
    for (int g = 0; g < 4; ++g) { const int c0 = 32 * it + 8 * g + 4 * hi;
        u32x2 w; w.x = pk2(mask(row, c0) ? acc[4 * g] : 0.f, mask(row, c0 + 1) ? acc[4 * g + 1] : 0.f); w.y = pk2(mask(row, c0 + 2) ? acc[4 * g + 2] : 0.f, mask(row, c0 + 3) ? acc[4 * g + 3] : 0.f);
        *(u32x2*)(Ot + row * 144 + c0 * 2) = w; }
}
DEVI f32x16 zero16() { f32x16 z;
#pragma unroll
    for (int r = 0; r < 16; ++r) z[r] = 0.f;
    return z; }
DEVI void chain_unit(const Params& p, int unit, char* lds) {
    const int tid0 = my_tid(); const int tid = tid0;
    const int dir = unit & 1, bh = unit >> 1, b = bh >> 3, h = bh & 7;
    const bool fwd = (dir == 0);
    const bf16_t* z = (const bf16_t*)(p.ws + OFF_Z);
    bf16_t* yout = (bf16_t*)(p.ws + (dir ? OFF_YB : OFF_YF));
    bf16_t* vout = (bf16_t*)(p.ws + OFF_VS);
    float* sout = (float*)(p.ws + OFF_SDIR) + (size_t)dir * T_ * 8;
    const size_t rowb = (size_t)b * SEQ;
    float* Cc = (float*)(lds + L_C);
    for (int i = tid; i < 448; i += NTHREADS) {
        int gi;
        if (i < 192) gi = (i >> 6) * 512 + h * 64 + (i & 63); else if (i < 256) gi = 1536 + dir * 64 + (i - 192); else if (i < 320) gi = 1664 + dir * 64 + (i - 256); else gi = 1792 + (i - 320);
        Cc[i] = p.in[8][gi]; Cc[448 + i] = p.in[9][gi];
    }
    if (tid < 64) { const int c = h * 64 + tid; Cc[896 + tid] = p.in[15][c]; Cc[960 + tid] = p.in[16][c]; Cc[1024 + tid] = p.in[17][c]; Cc[1088 + tid] = p.in[10][dir * 512 + c]; Cc[1152 + tid] = p.in[12][dir * 512 + c]; }
    for (int i = tid; i < SLOT / 16; i += NTHREADS) ((u32x4*)(lds + SL_S0 * SLOT))[i] = (u32x4){0u, 0u, 0u, 0u};
    bf16x8 wf[4];
    {
        const int lane = tid & 63, wid = __builtin_amdgcn_readfirstlane(tid >> 6), r32 = lane & 31, hi = lane >> 5, nt = (wid >> 1) & 1;
        const bf16_t* wsrc = (const bf16_t*)(p.ws + (wid < 4 ? OFF_WUP : OFF_AUP)) + ((size_t)dir * 512 + h * 64 + 32 * nt + r32) * 64 + 8 * hi;
#pragma unroll
        for (int ks = 0; ks < 4; ++ks) wf[ks] = *(const bf16x8*)(wsrc + 16 * ks);
    }
    u32x4 zl[5][3];
#define C_LOAD(c) do { const int t0_ = dir ? (SEQ - 64 * ((c) + 1)) : 64 * (c); const int ts_ = t0_ + tt; const bf16_t* zp_ = z + (rowb + ts_) * LDZ + ZR; \
        const bool hp_ = ts_ > 0, hn_ = ts_ < SEQ - 1; const u32x4 z4_ = {0u, 0u, 0u, 0u}; \
        _Pragma("unroll") for (int sg = 0; sg < 5; ++sg) { const int co_ = (sg < 3) ? (sg * 512 + h * 64 + 8 * c8) : (sg == 3 ? 1536 + dir * 64 + 8 * c8 : 1664 + dir * 64 + 8 * c8); \
            zl[sg][1] = *(const u32x4*)(zp_ + co_); zl[sg][0] = hp_ ? *(const u32x4*)(zp_ + co_ - LDZ) : z4_; zl[sg][2] = hn_ ? *(const u32x4*)(zp_ + co_ + LDZ) : z4_; } \
        } while (0)
#define SHIFT8(dst, regs, mi) do { float z0_[8], zm_[8], zn_[8]; unpack8(regs[1], z0_); unpack8(regs[0], zm_); unpack8(regs[2], zn_); \
        const f32x4 mpa_ = *(const f32x4*)(Cc + (mi)), mpb_ = *(const f32x4*)(Cc + (mi) + 4), mna_ = *(const f32x4*)(Cc + 448 + (mi)), mnb_ = *(const f32x4*)(Cc + 448 + (mi) + 4); \
        const float mp_[8] = {mpa_.x, mpa_.y, mpa_.z, mpa_.w, mpb_.x, mpb_.y, mpb_.z, mpb_.w}, mn_[8] = {mna_.x, mna_.y, mna_.z, mna_.w, mnb_.x, mnb_.y, mnb_.z, mnb_.w}; \
        _Pragma("unroll") for (int j = 0; j < 8; ++j) dst[j] = z0_[j] + mp_[j] * (zm_[j] - z0_[j]) + mn_[j] * (zn_[j] - z0_[j]); } while (0)
    f32x16 state = zero16();
    __syncthreads();
    { const int tt = tid >> 3, c8 = tid & 7; C_LOAD(0); }
    for (int c = 0; c < SEQ / 64; ++c) {
        int tid = tid0; asm volatile("" : "+v"(tid));
        const int lane = tid & 63, wid = __builtin_amdgcn_readfirstlane(tid >> 6), r32 = lane & 31, hi = lane >> 5;
        const int nt = (wid >> 1) & 1, tt2 = wid & 1, pj = nt, pi = tt2;
        const int tt = tid >> 3, c8 = tid & 7;
        const int sp = dir ? 63 - tt : tt;
        const int t0 = dir ? (SEQ - 64 * (c + 1)) : 64 * c;
        float r8[8], k8[8], v8[8], kk8[8];
        {
            float wd8[8], ad8[8];
            SHIFT8(r8, zl[0], 8 * c8); SHIFT8(k8, zl[1], 64 + 8 * c8); SHIFT8(v8, zl[2], 128 + 8 * c8); SHIFT8(wd8, zl[3], 192 + 8 * c8); SHIFT8(ad8, zl[4], 256 + 8 * c8);
#pragma unroll
            for (int j = 0; j < 8; ++j) wd8[j] = 1.f - 2.f * __builtin_amdgcn_rcpf(1.f + __expf(2.f * wd8[j]));
            *(u32x4*)(lds + L_TW + tt * 144 + c8 * 16) = pack8(wd8);
            *(u32x4*)(lds + L_AD + tt * 144 + c8 * 16) = pack8(ad8);
            float ss = 0.f;
#pragma unroll
            for (int j = 0; j < 8; ++j) { kk8[j] = k8[j] * Cc[896 + 8 * c8 + j]; ss += kk8[j] * kk8[j]; }
            ss = red8(ss);
            const float inv = 1.f / fmaxf(sqrtf(ss), 1e-12f);
#pragma unroll
            for (int j = 0; j < 8; ++j) kk8[j] *= inv;
        }
        __syncthreads();
        {
            f32x16 acc = zero16();
            const char* xt = lds + (wid < 4 ? L_TW : L_AD) + (32 * tt2 + r32) * 144 + 16 * hi;
#pragma unroll
            for (int ks = 0; ks < 4; ++ks) acc = __builtin_amdgcn_mfma_f32_32x32x16_bf16(wf[ks], *(const bf16x8*)(xt + 32 * ks), acc, 0, 0, 0);
            const int tl = 32 * tt2 + r32;
            if (wid < 4) {
                const int sl = dir ? 63 - tl : tl;
#pragma unroll
                for (int g = 0; g < 4; ++g) { const int n0 = 32 * nt + 8 * g + 4 * hi; f32x4 o;
#pragma unroll
                    for (int q = 0; q < 4; ++q) o[q] = -0.6065306597126334f * sigmoidf_(acc[4 * g + q] + Cc[1088 + n0 + q]);
                    *(f32x4*)(lds + L_G + sl * 256 + n0 * 4) = o; }
            } else {
#pragma unroll
                for (int g = 0; g < 4; ++g) { const int n0 = 32 * nt + 8 * g + 4 * hi; f16x4 o;
#pragma unroll
                    for (int q = 0; q < 4; ++q) o[q] = (_Float16)sigmoidf_(acc[4 * g + q] + Cc[1152 + n0 + q]);
                    *(f16x4*)(lds + L_ATMP + tl * 128 + n0 * 2) = o; }
            }
        }
        __syncthreads();
        float kd8[8], b8[8];
        {
            const f16x8 ah = *(const f16x8*)(lds + L_ATMP + tt * 128 + c8 * 16);
            float sp_ = 0.f;
#pragma unroll
            for (int j = 0; j < 8; ++j) { const float a = (float)ah[j];
                kd8[j] = k8[j] * (1.f + (a - 1.f) * Cc[960 + 8 * c8 + j]); b8[j] = kk8[j] * a; sp_ += r8[j] * kd8[j] * Cc[1024 + 8 * c8 + j]; }
            sp_ = red8(sp_);
            if (c8 == 0) sout[(rowb + t0 + tt) * 8 + h] = sp_;
            if (fwd) *(u32x4*)(vout + (rowb + t0 + tt) * 512 + h * 64 + 8 * c8) = pack8(v8);
            const int n = tid & 63, seg = tid >> 6; float* gp = (float*)(lds + L_G) + (8 * seg) * 64 + n; float run = 0.f;
#pragma unroll
            for (int q = 0; q < 8; ++q) { run += gp[q * 64]; gp[q * 64] = run; }
            ((float*)(lds + L_SEG))[seg * 64 + n] = run;
        }
        __syncthreads();
        {
            const int n = tid & 63, seg = tid >> 6; float off = 0.f;
            for (int q = 0; q < seg; ++q) off += ((const float*)(lds + L_SEG))[q * 64 + n];
            float* gp = (float*)(lds + L_G) + (8 * seg) * 64 + n;
#pragma unroll
            for (int q = 0; q < 8; ++q) gp[q * 64] += off;
        }
        __syncthreads();
        {
            const float* G = (const float*)(lds + L_G);
            const f32x4 ga = *(const f32x4*)(G + sp * 64 + 8 * c8), gb = *(const f32x4*)(G + sp * 64 + 8 * c8 + 4);
            const f32x4 ha = *(const f32x4*)(G + 63 * 64 + 8 * c8), hb = *(const f32x4*)(G + 63 * 64 + 8 * c8 + 4);
            f32x4 pa = {0.f, 0.f, 0.f, 0.f}, pb = pa;
            if (sp > 0) { pa = *(const f32x4*)(G + (sp - 1) * 64 + 8 * c8); pb = *(const f32x4*)(G + (sp - 1) * 64 + 8 * c8 + 4); }
            const float gs[8] = {ga.x, ga.y, ga.z, ga.w, gb.x, gb.y, gb.z, gb.w}, gm[8] = {pa.x, pa.y, pa.z, pa.w, pb.x, pb.y, pb.z, pb.w}, gl[8] = {ha.x, ha.y, ha.z, ha.w, hb.x, hb.y, hb.z, hb.w};
            {
                float at_[8], rt_[8];
#pragma unroll
                for (int j = 0; j < 8; ++j) { at_[j] = -kk8[j] * __expf(gm[j]); rt_[j] = r8[j] * __expf(gs[j]); }
                *(u32x4*)(lds + SL_AT * SLOT + sp * 144 + c8 * 16) = pack8(at_); *(u32x4*)(lds + SL_RT * SLOT + sp * 144 + c8 * 16) = pack8(rt_);
            }
            {
                float bt_[8], kt_[8];
#pragma unroll
                for (int j = 0; j < 8; ++j) { const float en = __expf(-gs[j]); bt_[j] = b8[j] * en; kt_[j] = kd8[j] * en; }
                *(u32x4*)(lds + SL_BT * SLOT + sp * 144 + c8 * 16) = pack8(bt_); *(u32x4*)(lds + SL_KT * SLOT + sp * 144 + c8 * 16) = pack8(kt_);
            }
            {
                float bh_[8], kh_[8];
#pragma unroll
                for (int j = 0; j < 8; ++j) { const float eh = __expf(gl[j] - gs[j]); bh_[j] = b8[j] * eh; kh_[j] = kd8[j] * eh; }
                *(u32x4*)(lds + SL_VT * SLOT + sp * 144 + c8 * 16) = pack8(v8);
                *(u32x4*)(lds + SL_BH * SLOT + sp * 144 + c8 * 16) = pack8(bh_); *(u32x4*)(lds + SL_KH * SLOT + sp * 144 + c8 * 16) = pack8(kh_);
            }
            if (tid < 64) ((float*)(lds + L_SEG))[tid] = __expf(G[63 * 64 + tid]);
        }
        __syncthreads();
        {
            const char* ATt = lds + SL_AT * SLOT; const char* RTt = lds + SL_RT * SLOT;
            f32x16 acc = mm_tile(zero16(), ATt, lds + (wid < 4 ? SL_BT : SL_KT) * SLOT, pj, pi, r32, hi);
            f32x16 acc2 = mm_tile(zero16(), RTt, lds + (wid < 4 ? SL_BT : SL_KT) * SLOT, pj, pi, r32, hi);
            const int row = 32 * pj + r32;
            if (wid < 4) {
                st_tile(lds + SL_MOFF * SLOT, pj, pi, r32, hi, acc, [](int s, int i) { return (s >> 4) > (i >> 4); });
#pragma unroll
                for (int g = 0; g < 4; ++g)
#pragma unroll
                    for (int q = 0; q < 4; ++q) { const int i = 32 * pi + 8 * g + 4 * hi + q; const float vv = acc[4 * g + q];
                        if ((row >> 4) == (i >> 4)) ((float*)(lds + L_FD))[(4 + (row >> 4)) * 272 + (i & 15) * 16 + (row & 15)] = (i < row) ? vv : 0.f; }
                st_tile(lds + SL_LRB * SLOT, pj, pi, r32, hi, acc2, [](int s, int i) { return i <= s; });
            } else {
                st_tile(lds + SL_MAK * SLOT, pj, pi, r32, hi, acc, [](int s, int i) { return i < s; });
                st_tile(lds + SL_LRK * SLOT, pj, pi, r32, hi, acc2, [](int s, int i) { return i <= s; });
            }
        }
        __syncthreads();
        if (c + 1 < SEQ / 64) C_LOAD(c + 1);
        if (wid == 0) {
            const int d = lane >> 4, j = lane & 15; const float* MdT = (const float*)(lds + L_FD) + (4 + d) * 272;
            float x[16];
#pragma unroll
            for (int q = 15; q >= 0; --q) { float acc = (q == j) ? 1.f : 0.f;
                const f32x4 m0 = *(const f32x4*)(MdT + q * 16), m1 = *(const f32x4*)(MdT + q * 16 + 4), m2 = *(const f32x4*)(MdT + q * 16 + 8), m3 = *(const f32x4*)(MdT + q * 16 + 12);
                const float mr[16] = {m0.x, m0.y, m0.z, m0.w, m1.x, m1.y, m1.z, m1.w, m2.x, m2.y, m2.z, m2.w, m3.x, m3.y, m3.z, m3.w};
#pragma unroll
                for (int s = 0; s < 16; ++s) if (s > q) acc = fmaf(x[s], mr[s], acc);
                x[q] = acc; asm volatile("" ::: "memory"); }
            char* rowp = lds + SL_DD * SLOT + (16 * d + j) * 144;
            const u32x4 z4 = {0u, 0u, 0u, 0u};
#pragma unroll
            for (int q = 0; q < 8; ++q) *(u32x4*)(rowp + 16 * q) = z4;
            u32x4 w0, w1; w0.x = pk2(x[0], x[1]); w0.y = pk2(x[2], x[3]); w0.z = pk2(x[4], x[5]); w0.w = pk2(x[6], x[7]); w1.x = pk2(x[8], x[9]); w1.y = pk2(x[10], x[11]); w1.z = pk2(x[12], x[13]); w1.w = pk2(x[14], x[15]);
            asm volatile("s_waitcnt lgkmcnt(0)" ::: "memory");
            *(u32x4*)(rowp + 32 * d) = w0; *(u32x4*)(rowp + 32 * d + 16) = w1;
        }
        f32x16 locA = zero16(), locB = zero16();
        if (wid < 4) { locA = mm_tile2<true, false>(locA, lds + SL_VT * SLOT, lds + SL_MAK * SLOT, pj, pi, lane, r32, hi); locB = mm_tile2<true, true>(locB, lds + SL_VT * SLOT, lds + SL_KH * SLOT, pj, pi, lane, r32, hi); }
        else locA = mm_tile2<false, true>(locA, lds + SL_LRK * SLOT, lds + SL_VT * SLOT, pj, pi, lane, r32, hi);
        __syncthreads();
        if (wid < 4) {
            f32x16 acc = mm_tile2<false, true>(zero16(), lds + SL_DD * SLOT, lds + SL_MOFF * SLOT, pj, pi, lane, r32, hi);
            st_tile(lds + SL_N * SLOT, pj, pi, r32, hi, acc, [](int, int) { return true; });
        }
        __syncthreads();
        {
            f32x16 acc = zero16();
            if (wid >= 4) { const int row = 32 * pj + r32; const char* addt = lds + SL_DD * SLOT;
#pragma unroll
                for (int g = 0; g < 4; ++g) { const u32x2 w = *(const u32x2*)(addt + row * 144 + (32 * pi + 8 * g + 4 * hi) * 2); acc[4 * g] = lo16(w.x); acc[4 * g + 1] = hi16(w.x); acc[4 * g + 2] = lo16(w.y); acc[4 * g + 3] = hi16(w.y); } }
            acc = (wid < 4) ? mm_tile2<false, true>(acc, lds + SL_N * SLOT, lds + SL_N * SLOT, pj, pi, lane, r32, hi) : mm_tile2<false, true>(acc, lds + SL_N * SLOT, lds + SL_DD * SLOT, pj, pi, lane, r32, hi);
            st_tile(lds + (wid < 4 ? SL_N2 : SL_W1) * SLOT, pj, pi, r32, hi, acc, [](int, int) { return true; });
        }
        __syncthreads();
        if (wid < 4) {
            f32x16 acc;
            { const int row = 32 * pj + r32; const char* addt = lds + SL_W1 * SLOT;
#pragma unroll
              for (int g = 0; g < 4; ++g) { const u32x2 w = *(const u32x2*)(addt + row * 144 + (32 * pi + 8 * g + 4 * hi) * 2); acc[4 * g] = lo16(w.x); acc[4 * g + 1] = hi16(w.x); acc[4 * g + 2] = lo16(w.y); acc[4 * g + 3] = hi16(w.y); } }
            acc = mm_tile2<false, true>(acc, lds + SL_N2 * SLOT, lds + SL_W1 * SLOT, pj, pi, lane, r32, hi);
            st_tile(lds + SL_T * SLOT, pj, pi, r32, hi, acc, [](int, int) { return true; });
        } else {
            locA = mm_tile(locA, lds + SL_RT * SLOT, lds + SL_S0 * SLOT, pj, pi, r32, hi);
        }
        if (wid < 4) {
            locA = mm_tile(locA, lds + SL_S0 * SLOT, lds + SL_AT * SLOT, pj, pi, r32, hi);
            st_tile(lds + SL_RHST * SLOT, pj, pi, r32, hi, locA, [](int, int) { return true; });
        }
        __syncthreads();
        if (wid < 4) {
            f32x16 acc = mm_tile(zero16(), lds + SL_RHST * SLOT, lds + SL_T * SLOT, pj, pi, r32, hi);
            st_tile(lds + SL_UT * SLOT, pj, pi, r32, hi, acc, [](int, int) { return true; });
        }
        __syncthreads();
        if (wid < 4) {
            const float* gam = (const float*)(lds + L_SEG);
#pragma unroll
            for (int g = 0; g < 4; ++g) { const f32x4 gq = *(const f32x4*)(gam + 32 * pi + 8 * g + 4 * hi);
                state[4 * g] = state[4 * g] * gq.x + locB[4 * g]; state[4 * g + 1] = state[4 * g + 1] * gq.y + locB[4 * g + 1]; state[4 * g + 2] = state[4 * g + 2] * gq.z + locB[4 * g + 2]; state[4 * g + 3] = state[4 * g + 3] * gq.w + locB[4 * g + 3]; }
            state = mm_tile2<false, true>(state, lds + SL_UT * SLOT, lds + SL_BH * SLOT, pj, pi, lane, r32, hi);
            st_tile(lds + SL_S0 * SLOT, pj, pi, r32, hi, state, [](int, int) { return true; });
        } else {
            locA = mm_tile(locA, lds + SL_LRB * SLOT, lds + SL_UT * SLOT, pj, pi, r32, hi);
            const int s = 32 * pj + r32; const int tn = t0 + (dir ? 63 - s : s);
            bf16_t* yp = yout + (rowb + tn) * 512 + h * 64 + 32 * pi;
#pragma unroll
            for (int g = 0; g < 4; ++g) { u32x2 w; w.x = pk2(locA[4 * g], locA[4 * g + 1]); w.y = pk2(locA[4 * g + 2], locA[4 * g + 3]); *(u32x2*)(yp + 8 * g + 4 * hi) = w; }
        }
        __syncthreads();
    }
#undef C_LOAD
#undef SHIFT8
}

DEVI void stage_rwkv_post(const Params& p, int bid, int nb) {
    const bf16_t* yf = (const bf16_t*)(p.ws + OFF_YF); const bf16_t* yb = (const bf16_t*)(p.ws + OFF_YB);
    const bf16_t* g = (const bf16_t*)(p.ws + OFF_G); const bf16_t* vs = (const bf16_t*)(p.ws + OFF_VS);
    const float* sf = (const float*)(p.ws + OFF_SDIR); const float* sb = sf + (size_t)T_ * 8;
    bf16_t* orw = (bf16_t*)(p.ws + OFF_YF);
    for (int i = bid * NTHREADS + my_tid(); i < T_ * 64; i += nb * NTHREADS) {
        const int c8 = i & 7, th = i >> 3, c = (th & 7) * 64 + 8 * c8;
        const size_t o = (size_t)(th >> 3) * 512 + c;
        float a[8], b[8], y[8], gv[8], vv[8];
        unpack8(*(const u32x4*)(yf + o), a); unpack8(*(const u32x4*)(yb + o), b); unpack8(*(const u32x4*)(g + o), gv); unpack8(*(const u32x4*)(vs + o), vv);
        float s = 0.f;
#pragma unroll
        for (int j = 0; j < 8; ++j) { y[j] = a[j] + b[j]; s += y[j]; }
        const float mu = red8(s) * (1.f / 64.f);
        float q = 0.f;
#pragma unroll
        for (int j = 0; j < 8; ++j) { y[j] -= mu; q += y[j] * y[j]; }
        const float rstd = rsqrtf(red8(q) * (1.f / 64.f) + 64e-5f);
        const float bs = sf[th] + sb[th];
        const f32x4 lga = *(const f32x4*)(p.in[18] + c), lgb = *(const f32x4*)(p.in[18] + c + 4), lba = *(const f32x4*)(p.in[19] + c), lbb = *(const f32x4*)(p.in[19] + c + 4);
        const float lg[8] = {lga.x, lga.y, lga.z, lga.w, lgb.x, lgb.y, lgb.z, lgb.w}, lb[8] = {lba.x, lba.y, lba.z, lba.w, lbb.x, lbb.y, lbb.z, lbb.w};
        float r[8];
#pragma unroll
        for (int j = 0; j < 8; ++j) r[j] = (y[j] * rstd * lg[j] + lb[j] + bs * vv[j]) * gv[j];
        *(u32x4*)(orw + o) = pack8(r);
    }
}

typedef float f32x2v __attribute__((ext_vector_type(2)));
DEVI void stage_route(const Params& p, char* lds, int bid, int nb, bool do_count = true) {
    const int tid = my_tid(), lane = tid & 63, wave = tid >> 6;
    const bf16_t* x1 = (const bf16_t*)(p.ws + OFF_X1); bf16_t* h2 = (bf16_t*)((char*)p.out + DOFF_H2);
    int* toke = (int*)(p.ws + OFF_TOKE); float* tokw = (float*)(p.ws + OFF_TOKW); int* tokr = (int*)(p.ws + OFF_TOKR);
    int* cntwg = (int*)(p.ws + OFF_CNTWG);
    const bf16_t* wrt = (const bf16_t*)(p.ws + OFF_WRT);
    const float* g2 = p.in[23];
    int* hist = (int*)lds;
    float* lgs = (float*)(lds + 256) + wave * (16 * 48);
    if (bid == 0 && do_count) { u32x4* zr = (u32x4*)(h2 + (size_t)T_ * DM); if (tid < 128) zr[tid] = (u32x4){0u, 0u, 0u, 0u}; }
    for (int b = bid; b < T_ / 128; b += nb) {
        if (tid < 32) hist[tid] = 0;
        __syncthreads();
        const int t0 = b * 128 + wave * 16;
        const int li = lane & 15, kq = lane >> 4;
        const bf16_t* xrow = x1 + (size_t)(t0 + li) * DM + 8 * kq;
        u32x4 xr[32];
#pragma unroll
        for (int ks = 0; ks < 32; ++ks) xr[ks] = *(const u32x4*)(xrow + 32 * ks);
        unsigned wvoff = (unsigned)(li * DM + 8 * kq) * 2u; asm volatile("" : "+v"(wvoff));
        const char* wbase = (const char*)wrt;
#define ROUTE_LDW(ob_, hl_, ks_) (*(const bf16x8*)(wbase + (size_t)(((hl_) * 48 + (ob_) * 16) * DM + 32 * (ks_)) * 2 + wvoff))
        f32x4 acc0 = {0.f, 0.f, 0.f, 0.f}, acc1 = acc0, acc2 = acc0;
        float ss = 0.f;
        bf16x8 wb[2][6];
#pragma unroll
        for (int ob = 0; ob < 3; ++ob) { wb[0][2 * ob] = ROUTE_LDW(ob, 0, 0); wb[0][2 * ob + 1] = ROUTE_LDW(ob, 1, 0); }
#pragma unroll
        for (int ks = 0; ks < 32; ++ks) {
            if (ks + 1 < 32) {
#pragma unroll
                for (int ob = 0; ob < 3; ++ob) { wb[(ks + 1) & 1][2 * ob] = ROUTE_LDW(ob, 0, ks + 1); wb[(ks + 1) & 1][2 * ob + 1] = ROUTE_LDW(ob, 1, ks + 1); }
            }
            asm volatile("" ::: "memory");
            float xv[8]; unpack8(xr[ks], xv);
#pragma unroll
            for (int j = 0; j < 8; ++j) ss += xv[j] * xv[j];
            const bf16x8 ax = __builtin_bit_cast(bf16x8, xr[ks]);
            acc0 = __builtin_amdgcn_mfma_f32_16x16x32_bf16(ax, wb[ks & 1][0], acc0, 0, 0, 0);
            acc1 = __builtin_amdgcn_mfma_f32_16x16x32_bf16(ax, wb[ks & 1][2], acc1, 0, 0, 0);
            acc2 = __builtin_amdgcn_mfma_f32_16x16x32_bf16(ax, wb[ks & 1][4], acc2, 0, 0, 0);
            acc0 = __builtin_amdgcn_mfma_f32_16x16x32_bf16(ax, wb[ks & 1][1], acc0, 0, 0, 0);
            acc1 = __builtin_amdgcn_mfma_f32_16x16x32_bf16(ax, wb[ks & 1][3], acc1, 0, 0, 0);
            acc2 = __builtin_amdgcn_mfma_f32_16x16x32_bf16(ax, wb[ks & 1][5], acc2, 0, 0, 0);
        }
        ss += __shfl_xor(ss, 16); ss += __shfl_xor(ss, 32);
        const float my_rstd = rsqrtf(ss * (1.f / DM) + 1e-6f);
        {
            bf16_t* orow = h2 + (size_t)(t0 + li) * DM + 8 * kq;
#pragma unroll
            for (int ks = 0; ks < 32; ++ks) {
                if ((ks & 3) == 0) asm volatile("" ::: "memory");
                u32x4 xw = xr[ks]; asm volatile("" : "+v"(xw));
                float xv[8]; unpack8(xw, xv);
                const f32x4 ga = *(const f32x4*)(g2 + 32 * ks + 8 * kq), gb = *(const f32x4*)(g2 + 32 * ks + 8 * kq + 4);
                const float gq[8] = {ga.x, ga.y, ga.z, ga.w, gb.x, gb.y, gb.z, gb.w};
                float o[8];
#pragma unroll
                for (int j = 0; j < 8; ++j) o[j] = xv[j] * my_rstd * gq[j];
                *(u32x4*)(orow + 32 * ks) = pack8(o);
            }
        }
#pragma unroll
        for (int r = 0; r < 4; ++r) { const float rs = __shfl(my_rstd, 4 * kq + r); acc0[r] *= rs; acc1[r] *= rs; acc2[r] *= rs; }
#pragma unroll
        for (int r = 0; r < 4; ++r) { float* lr = lgs + (4 * kq + r) * 48 + li; lr[0] = acc0[r]; lr[16] = acc1[r]; lr[32] = acc2[r]; }
        asm volatile("s_waitcnt lgkmcnt(0)" ::: "memory");
        if (lane < 16) {
            const float* lg = lgs + lane * 48; const int t = t0 + lane;
            float gl[4];
#pragma unroll
            for (int j = 0; j < 4; ++j) gl[j] = lg[j] + p.in[25][j];
            int gi = 0; float gm = gl[0];
#pragma unroll
            for (int j = 1; j < 4; ++j) if (gl[j] > gm) { gm = gl[j]; gi = j; }
            float gs = 0.f;
#pragma unroll
            for (int j = 0; j < 4; ++j) gs += __expf(gl[j] - gm);
            const float gp = 1.f / gs;
            float el[8];
#pragma unroll
            for (int j = 0; j < 8; ++j) el[j] = lg[4 + gi * 8 + j] + p.in[27][gi * 8 + j];
            int i1 = 0; float m1 = el[0];
#pragma unroll
            for (int j = 1; j < 8; ++j) if (el[j] > m1) { m1 = el[j]; i1 = j; }
            int i2 = -1; float m2 = -INFINITY;
#pragma unroll
            for (int j = 0; j < 8; ++j) if (j != i1 && el[j] > m2) { m2 = el[j]; i2 = j; }
            const float e2 = __expf(m2 - m1), tp1 = 1.f / (1.f + e2), tp2 = e2 / (1.f + e2);
            const int e1i = gi * 8 + i1, e2i = gi * 8 + i2;
            toke[2 * t] = e1i; toke[2 * t + 1] = e2i; tokw[2 * t] = gp * tp1; tokw[2 * t + 1] = gp * tp2;
            if (do_count) { tokr[2 * t] = atomicAdd(hist + e1i, 1); tokr[2 * t + 1] = atomicAdd(hist + e2i, 1); }
        }
        __syncthreads();
        if (do_count && tid < 32) cntwg[b * 32 + tid] = hist[tid];
        __syncthreads();
    }
}
DEVI void stage_scatter(const Params& p, char* lds, int bid, int nb, bool dry = false) {
    const int tid = my_tid(), lane = tid & 63, wave = tid >> 6;
    const int gw = bid * NWAVES + wave, NGW = nb * NWAVES;
    int* ctl = (int*)(p.ws + OFF_CTL); const int* toke = (const int*)(p.ws + OFF_TOKE); const int* tokr = (const int*)(p.ws + OFF_TOKR); int* toks = (int*)(p.ws + OFF_TOKS);
    const int* cntwg = (const int*)(p.ws + OFF_CNTWG);
    int* slottok = (int*)(p.ws + OFF_SLOTTOK);
    int* part = (int*)lds;
    int* tot = part + 512;
    int* cnts = tot + 32;
    int* bases = cnts + 32;
    constexpr int NB = T_ / 128;
    {
        const int e = tid & 31, q = tid >> 5;
        int s = 0;
        for (int w = 16 * q; w < 16 * q + 16; ++w) s += cntwg[w * 32 + e];
        part[q * 32 + e] = s;
    }
    __syncthreads();
    if (tid == 0) {
        int run = 0;
        for (int e = 0; e < NEXP; ++e) {
            int c = 0; for (int q = 0; q < 16; ++q) c += part[q * 32 + e];
            cnts[e] = c; tot[e] = run;
            const int pad = (c + 255) / 256 * 256;
            if (bid == 0) for (int bq = run / 256; bq < (run + pad) / 256; ++bq) ctl[C_BLKE + bq] = e;
            run += pad;
        }
        if (bid == 0) { for (int bq = run / 256; bq < NBLK; ++bq) ctl[C_BLKE + bq] = -1; ctl[C_NBLK] = run / 256; }
    }
    __syncthreads();
    for (int b = bid; b < NB; b += nb) {
        if (tid < 32) { int s = tot[tid]; for (int q = 0; q < (b >> 4); ++q) s += part[q * 32 + tid]; for (int w = b & ~15; w < b; ++w) s += cntwg[w * 32 + tid]; bases[tid] = s; }
        __syncthreads();
        if (tid < 256) { const int a = b * 256 + tid; const int slot = bases[toke[a]] + tokr[a]; if (!dry) { toks[a] = slot; slottok[slot] = a >> 1; } else asm volatile("" :: "v"(slot)); }
        __syncthreads();
    }
    {
        const int e = gw & 31; const int c = cnts[e], pad = (c + 255) / 256 * 256;
        for (int s = tot[e] + c + (gw >> 5) * 64 + lane; s < tot[e] + pad; s += (NGW >> 5) * 64) slottok[s] = T_;
    }
    __syncthreads();
}
DEVI void stage_final(const Params& p, int bid, int nb, bool dry = false) {
    const int lane = my_tid() & 63, wave = my_tid() >> 6;
    const int gw = bid * NWAVES + wave, NGW = nb * NWAVES;
    const bf16_t* ye = (const bf16_t*)(p.ws + OFF_YE); const int* toks = (const int*)(p.ws + OFF_TOKS); const float* tokw = (const float*)(p.ws + OFF_TOKW);
    const bf16_t* x1 = (const bf16_t*)(p.ws + OFF_X1);
    const float* gf = p.in[31];
    f32x4 gv[4];
#pragma unroll
    for (int j = 0; j < 4; ++j) gv[j] = *(const f32x4*)(gf + 4 * lane + 256 * j);
    for (int tb = gw * 2; tb < T_; tb += NGW * 2) {
        u32x2 xa[2][4], ya[2][4], yb[2][4]; float w0[2], w1[2];
#pragma unroll
        for (int q = 0; q < 2; ++q) { const int t = tb + q; const int s0 = toks[2 * t], s1 = toks[2 * t + 1]; w0[q] = tokw[2 * t]; w1[q] = tokw[2 * t + 1];
            const u32x2* xr = (const u32x2*)(x1 + (size_t)t * DM) + lane; const u32x2* y0 = (const u32x2*)(ye + (size_t)s0 * DM) + lane; const u32x2* y1 = (const u32x2*)(ye + (size_t)s1 * DM) + lane;
#pragma unroll
            for (int j = 0; j < 4; ++j) { xa[q][j] = xr[64 * j]; ya[q][j] = y0[64 * j]; yb[q][j] = y1[64 * j]; } }
#pragma unroll
        for (int q = 0; q < 2; ++q) {
            f32x4 v[4]; float s = 0.f;
#pragma unroll
            for (int j = 0; j < 4; ++j) { const u32x2 x = xa[q][j], a = ya[q][j], b = yb[q][j];
                v[j].x = lo16(x.x) + w0[q] * lo16(a.x) + w1[q] * lo16(b.x); v[j].y = hi16(x.x) + w0[q] * hi16(a.x) + w1[q] * hi16(b.x);
                v[j].z = lo16(x.y) + w0[q] * lo16(a.y) + w1[q] * lo16(b.y); v[j].w = hi16(x.y) + w0[q] * hi16(a.y) + w1[q] * hi16(b.y);
                s += (v[j].x * v[j].x + v[j].y * v[j].y) + (v[j].z * v[j].z + v[j].w * v[j].w); }
            const float rstd = rsqrtf(wave_sum(s) * (1.f / DM) + 1e-6f);
            f32x4* orow = (f32x4*)(p.out + (size_t)(tb + q) * DM) + lane;
#pragma unroll
            for (int j = 0; j < 4; ++j) { const f32x4 o = v[j] * rstd * gv[j]; if (!dry) orow[64 * j] = o; else asm volatile("" :: "v"(o)); }
        }
    }
}

#define LAS __attribute__((address_space(3)))
#define XB_TMO      128
#define XB_XCNT(j)  (256  + 64 * (j))
#define XB_XSUB(j)  (1280 + 64 * (j))
#define XB_XGEN(j)  (2304 + 64 * (j))
#define XB_TOP      3328
#define XB_TOPGEN   3392
#define XCD_BAR_WORDS 3456
#define XB_SPIN_CAP (1u << 18)
DEVI unsigned xb_ld(unsigned* p)              { return __hip_atomic_load(p, __ATOMIC_RELAXED, __HIP_MEMORY_SCOPE_AGENT); }
DEVI unsigned xb_add(unsigned* p, unsigned v) { return __hip_atomic_fetch_add(p, v, __ATOMIC_RELAXED, __HIP_MEMORY_SCOPE_AGENT); }
DEVI unsigned xb_xcc_id() { return (unsigned)__builtin_amdgcn_s_getreg((3 << 11) | 20) & 0xFu; }
#define XB_SPIN(cond, bar) do { unsigned _sp = 0; while (cond) { __builtin_amdgcn_s_sleep(1); \
    if ((++_sp & 255u) == 0u) { if (xb_ld(&(bar)[XB_TMO])) break; if (_sp > XB_SPIN_CAP) { atomicAdd(&(bar)[XB_TMO], 1u); break; } } } } while (0)
struct XcdBarrier { unsigned* bar; unsigned x; volatile LAS unsigned* st; };
DEVI XcdBarrier xcd_barrier_post(unsigned* bar, volatile LAS unsigned* st) {
    XcdBarrier b; b.bar = bar; b.x = xb_xcc_id(); b.st = st;
    if (my_tid() == 0) (void)xb_add(&bar[XB_XCNT(b.x)], 1u);
    return b;
}
DEVI void xcd_barrier_complete(unsigned* bar, unsigned x, unsigned& nloc, unsigned& nx) {
    const unsigned G = gridDim.x * gridDim.y * gridDim.z;
    unsigned sum, cnt, mine, sp = 0u;
    for (;;) {
        sum = 0u; cnt = 0u; mine = 0u;
#pragma unroll
        for (unsigned j = 0; j < 16; ++j) { const unsigned c = xb_ld(&bar[XB_XCNT(j)]); sum += c; cnt += (c > 0u) ? 1u : 0u; mine = (j == x) ? c : mine; }
        if (sum == G) break;
        __builtin_amdgcn_s_sleep(1);
        if ((++sp & 255u) == 0u) { if (xb_ld(&bar[XB_TMO])) break; if (sp > XB_SPIN_CAP) { atomicAdd(&bar[XB_TMO], 1u); break; } }
    }
    nloc = mine > 0u ? mine : 1u; nx = cnt > 0u ? cnt : 1u;
}
DEVI void xcd_barrier(const XcdBarrier& b) {
    asm volatile("s_waitcnt vmcnt(0)" ::: "memory");
    __syncthreads();
    if (my_tid() == 0) {
        unsigned* bar = b.bar;
        __builtin_amdgcn_s_waitcnt(0);
        unsigned nloc = b.st[0], nx = b.st[1];
        if (nloc == 0u) { xcd_barrier_complete(bar, b.x, nloc, nx); b.st[0] = nloc; b.st[1] = nx; }
        const unsigned old = xb_add(&bar[XB_XSUB(b.x)], 1u);
        const unsigned gen = old / nloc;
        if (old + 1u == (gen + 1u) * nloc) {
            __builtin_amdgcn_fence(__ATOMIC_RELEASE, "agent");
            asm volatile("s_waitcnt vmcnt(0)" ::: "memory");
            const unsigned og = xb_add(&bar[XB_TOP], 1u);
            const unsigned tg = og / nx;
            if (og + 1u == (tg + 1u) * nx) xb_add(&bar[XB_TOPGEN], 1u);
            else XB_SPIN(xb_ld(&bar[XB_TOPGEN]) == tg, bar);
            __builtin_amdgcn_fence(__ATOMIC_ACQUIRE, "agent");
            xb_add(&bar[XB_XGEN(b.x)], 1u);
            asm volatile("s_waitcnt vmcnt(0)" ::: "memory");
        } else {
            XB_SPIN(xb_ld(&bar[XB_XGEN(b.x)]) == gen, bar);
            __builtin_amdgcn_fence(__ATOMIC_ACQUIRE, "agent");
            asm volatile("s_waitcnt vmcnt(0)" ::: "memory");
        }
    }
    __syncthreads();
}

constexpr int LDS_BYTES = 147456;
constexpr int LDS_MISC = 147200;
constexpr int C_BAR = 4096;
constexpr size_t CTL_ZERO_BYTES = 65536;
constexpr size_t DOFF_H2ND = 0;
constexpr size_t DOFF_ORWKV = 64 * MiB;

template <int PH>
DEVI void run_phase(const Params& p, char* lds, int bid, int nb) {
    unsigned char* ws = p.ws;
    if constexpr (PH == 0) { stage_transposes(p, 0, p.njobs_mid, 0, p.items_mid, lds, bid, nb); stage_rope_table(p, bid, nb);
        { u32x4* wz = (u32x4*)(ws + OFF_WIN + (size_t)NZ * DM * 2); const u32x4 z4 = {0u, 0u, 0u, 0u}; for (int i = bid * NTHREADS + my_tid(); i < (LDZ - NZ) * DM / 8; i += nb * NTHREADS) wz[i] = z4; }
        { bf16_t* gp = (bf16_t*)(ws + OFF_GUP); const u32x4 z4 = {0u, 0u, 0u, 0u}; for (int i = bid * NTHREADS + my_tid(); i < 512 * 16; i += nb * NTHREADS) *(u32x4*)(gp + (size_t)(i >> 4) * 256 + 128 + 8 * (i & 15)) = z4; }
        { bf16_t* wrh = (bf16_t*)(ws + OFF_WRT); bf16_t* wrl = wrh + 48 * DM; for (int i = bid * NTHREADS + my_tid(); i < 48 * DM; i += nb * NTHREADS) { const int o = i >> 10, c = i & 1023; const float w = p.in[23][c] * ((o < 4) ? p.in[24][c * 4 + o] : (o < 36 ? p.in[26][c * 32 + (o - 4)] : 0.f)); const unsigned h = f2bf(w); wrh[i] = (bf16_t)h; wrl[i] = (bf16_t)f2bf(w - bf2f(h)); } }
        __syncthreads(); stage_rms_rows(p.in[0], p.in[1], (bf16_t*)(ws + OFF_H), bid, nb); }
    if constexpr (PH == 1) { F8Bf16 e{(bf16_t*)(ws + OFF_Z), LDZ}; big_gemm(lds, (const bf16_t*)(ws + OFF_H), DM, (const bf16_t*)(ws + OFF_WIN), DM, T_, LDZ, DM, e, bid, nb); }
    if constexpr (PH == 2) { if ((PROBE_MASK >> 25) & 1) { stage_mla_prep(p, bid, nb, true); stage_sg_prep(p, bid, nb); } stage_mla_prep(p, bid, nb); stage_sg_prep(p, bid, nb); }
    if constexpr (PH == 3) {
        const bf16_t* z = (const bf16_t*)(ws + OFF_Z);
        { F8Bf16 e{(bf16_t*)((char*)p.out + DOFF_QRAW), 768}; big_gemm(lds, z, LDZ, (const bf16_t*)(ws + OFF_WUQ), 384, T_, 768, 384, e, bid, nb); }
        { F8Bf16 e{(bf16_t*)((char*)p.out + DOFF_KVRAW), 1024}; big_gemm(lds, z + 384, LDZ, (const bf16_t*)(ws + OFF_WUKV), 256, T_, 1024, 256, e, bid, nb); }
        { F8Bf16 e{(bf16_t*)(ws + OFF_G), 512}; big_gemm(lds, (const bf16_t*)(ws + OFF_SG), 256, (const bf16_t*)(ws + OFF_GUP), 256, T_, 512, 256, e, bid, nb); }
        for (int rep = 0; rep < 1 + ((PROBE_MASK >> 20) & 1); ++rep) for (int u = bid; u < BATCH * NH * 2; u += nb) chain_unit(p, u, lds);
    }
    if constexpr (PH == 4) {
        for (int rep = 0; rep < 1 + ((PROBE_MASK >> 21) & 1); ++rep) for (int u = bid; u < BATCH * NH * 8; u += nb) attn_unit(p, u, lds);
        stage_rwkv_post(p, bid, nb);
    }
    if constexpr (PH == 6) {
        { F8Bf16 e{(bf16_t*)(ws + OFF_BM), 1024}; big_gemm(lds, (const bf16_t*)(ws + OFF_OMLA), 512, (const bf16_t*)(ws + OFF_WBM), 512, T_, 1024, 512, e, bid, nb); }
        { F8Bf16 e{(bf16_t*)(ws + OFF_BR), 1024}; big_gemm(lds, (const bf16_t*)(ws + OFF_YF), 512, (const bf16_t*)(ws + OFF_WBR), 512, T_, 1024, 512, e, bid, nb); }
    }
    if constexpr (PH == 7) { EpiGate e{(const bf16_t*)(ws + OFF_BM), (const bf16_t*)(ws + OFF_BR), (bf16_t*)(ws + OFF_MIXED), p.in[21]};
        big_gemm_epi(lds, (const bf16_t*)(ws + OFF_H), DM, (const bf16_t*)(ws + OFF_WG), DM, T_, 2048, DM, e, bid, nb); }
    if constexpr (PH == 8) { F8Resid e{p.in[0], (bf16_t*)(ws + OFF_X1)};
        big_gemm(lds, (const bf16_t*)(ws + OFF_MIXED), DM, (const bf16_t*)(ws + OFF_WOUT), DM, T_, DM, DM, e, bid, nb); }
    if constexpr (PH == 9) { stage_route(p, lds, bid, nb); if ((PROBE_MASK >> 22) & 1) stage_route(p, lds, bid, nb, false); }
    if constexpr (PH == 10) { if ((PROBE_MASK >> 27) & 1) stage_scatter(p, lds, bid, nb, true); stage_scatter(p, lds, bid, nb); }
    if constexpr (PH == 11) { F8Swiglu e{(bf16_t*)((char*)p.out + DOFF_HID)}; const int* ctl = (const int*)(ws + OFF_CTL);
        big_gemm_<F8Swiglu, true>(lds, (const bf16_t*)((const char*)p.out + DOFF_H2), DM, (const bf16_t*)(ws + OFF_W13), DM, ctl[C_NBLK] * 256, 512, DM, e, bid, nb, ctl + C_BLKE, (size_t)512 * DM, (const int*)(ws + OFF_SLOTTOK));
        {
            const int nwg = ctl[C_NBLK] * 2; int n3 = nwg - 2 * nb; n3 = n3 < 0 ? 0 : (n3 > nb - 32 ? nb - 32 : n3);
            if (bid >= n3) stage_transposes(p, p.njobs_mid, p.njobs_all, p.items_mid, p.items_all, lds, bid - n3, nb - n3);
        } }
    if constexpr (PH == 12) { F8Bf16 e{(bf16_t*)(ws + OFF_YE), DM}; const int* ctl = (const int*)(ws + OFF_CTL);
        big_gemm(lds, (const bf16_t*)((const char*)p.out + DOFF_HID), DEXP, (const bf16_t*)(ws + OFF_W2), DEXP, ctl[C_NBLK] * 256, DM, DEXP, e, bid, nb, ctl + C_BLKE, (size_t)DM * DEXP); }
    if constexpr (PH == 13) { if ((PROBE_MASK >> 26) & 1) stage_final(p, bid, nb, true); stage_final(p, bid, nb); }
}

__global__ void __launch_bounds__(NTHREADS, 2) mega_fwd(Params p) {
    extern __shared__ __attribute__((aligned(16))) char lds[];
    const int bid = blockIdx.x, nb = gridDim.x;
    volatile LAS unsigned* misc = (volatile LAS unsigned*)((LAS char*)lds + LDS_MISC);
    if (my_tid() < 64) misc[my_tid()] = 0u;
    __syncthreads();
    XcdBarrier bar = xcd_barrier_post((unsigned*)(p.ws + OFF_CTL) + C_BAR, misc + 8);
#define PHASE(k) do { run_phase<k>(p, lds, bid, nb); if ((PROBE_MASK >> k) & 1) { __syncthreads(); run_phase<k>(p, lds, bid, nb); } xcd_barrier(bar); if ((PROBE_MASK >> 24) & 1) xcd_barrier(bar); } while (0)
    PHASE(0); PHASE(1); PHASE(2); PHASE(3); PHASE(4); PHASE(6); PHASE(7); PHASE(8); PHASE(9); PHASE(10); PHASE(11); PHASE(12);
    run_phase<13>(p, lds, bid, nb);
#undef PHASE
}

static int add_job(Params& P, int& nj, int& items, int in_idx, int K, int ldsrc, int col0, int ncols, int row_mul, int row_off, int nbatch, long long sbs, long long dbs, size_t dst_off, int dst_ld = 0) {
    TJob& J = P.jobs[nj]; J.in_idx = in_idx; J.K = K; J.ldsrc = ldsrc; J.col0 = col0; J.ncols = ncols; J.row_mul = row_mul; J.row_off = row_off; J.nbatch = nbatch;
    J.sbs = sbs; J.dbs = dbs; J.dst_off = (long long)dst_off; J.item0 = items; J.dst_ld = dst_ld ? dst_ld : K;
    items += nbatch * (K / 64) * (ncols / 32); return ++nj;
}
extern "C" void kernel_launch(void* const* d_in, const int* in_sizes, int n_in, void* d_out, int out_size, void* d_ws, size_t ws_size, hipStream_t stream) {
    static int grid = 0;
    if (grid == 0) {
        if (n_in != 32 || out_size != T_ * DM || ws_size < WS_NEED) { fprintf(stderr, "kernel_launch: unexpected shapes (n_in %d out %d ws %zu)\n", n_in, out_size, ws_size); grid = -1; return; }
        int dev = 0, cus = 0, per_cu = 0;
        if (hipGetDevice(&dev) != hipSuccess || hipDeviceGetAttribute(&cus, hipDeviceAttributeMultiprocessorCount, dev) != hipSuccess) { grid = -1; return; }
        if (hipFuncSetAttribute((const void*)mega_fwd, hipFuncAttributeMaxDynamicSharedMemorySize, LDS_BYTES) != hipSuccess) { fprintf(stderr, "kernel_launch: hipFuncSetAttribute failed\n"); grid = -1; return; }
        if (hipOccupancyMaxActiveBlocksPerMultiprocessor(&per_cu, (const void*)mega_fwd, NTHREADS, LDS_BYTES) != hipSuccess || per_cu < 1)
            fprintf(stderr, "kernel_launch: note: occupancy query reports %d workgroups per CU\n", per_cu);
        (void)hipGetLastError();
        grid = cus;
    }
    if (grid < 0) return;
    Params P{};
    for (int i = 0; i < 32; ++i) P.in[i] = (const float*)d_in[i];
    P.out = (float*)d_out; P.ws = (unsigned char*)d_ws;
    int nj = 0, items = 0;
    add_job(P, nj, items, 2, 1024, 4640, 0, 640, 1, 0, 1, 0, 0, OFF_WIN);
    add_job(P, nj, items, 2, 1024, 4640, 672, 1920, 1, 640, 1, 0, 0, OFF_WIN);
    add_job(P, nj, items, 2, 1024, 4640, 640, 32, 1, 0, 1, 0, 0, OFF_WKR);
    add_job(P, nj, items, 2, 1024, 4640, 2592, 1024, -1, 0, 1, 0, 0, OFF_WG);
    add_job(P, nj, items, 2, 1024, 4640, 3616, 1024, -1, 128, 1, 0, 0, OFF_WG);
    add_job(P, nj, items, 5, 384, 768, 0, 768, 1, 0, 1, 0, 0, OFF_WUQ);
    add_job(P, nj, items, 6, 256, 1024, 0, 1024, 1, 0, 1, 0, 0, OFF_WUKV);
    add_job(P, nj, items, 7, 512, 1024, 0, 1024, 1, 0, 1, 0, 0, OFF_WBM);
    add_job(P, nj, items, 20, 512, 1024, 0, 1024, 1, 0, 1, 0, 0, OFF_WBR);
    add_job(P, nj, items, 22, 1024, 1024, 0, 1024, 1, 0, 1, 0, 0, OFF_WOUT);
    add_job(P, nj, items, 11, 64, 512, 0, 512, 1, 0, 2, 64 * 512, 512 * 64, OFF_WUP);
    add_job(P, nj, items, 13, 64, 512, 0, 512, 1, 0, 2, 64 * 512, 512 * 64, OFF_AUP);
    add_job(P, nj, items, 14, 128, 512, 0, 512, 1, 0, 1, 0, 0, OFF_GUP, 256);
    P.njobs_early = nj; P.items_early = items;
    add_job(P, nj, items, 28, 1024, 256, 0, 256, 2, 0, 32, 1024 * 256, 512 * 1024, OFF_W13);
    add_job(P, nj, items, 29, 1024, 256, 0, 256, 2, 1, 32, 1024 * 256, 512 * 1024, OFF_W13);
    P.njobs_mid = nj; P.items_mid = items;
    add_job(P, nj, items, 30, 256, 1024, 0, 1024, 1, 0, 32, 256 * 1024, 1024 * 256, OFF_W2);
    P.njobs_all = nj; P.items_all = items;
    if (hipMemsetAsync((char*)d_ws + OFF_CTL, 0, CTL_ZERO_BYTES, stream) != hipSuccess) { fprintf(stderr, "kernel_launch: memset failed\n"); return; }
    hipLaunchKernelGGL(mega_fwd, dim3(grid), dim3(NTHREADS), LDS_BYTES, stream, P);
}
```

```cpp
#include <hip/hip_runtime.h>
#include <cstdio>
#include <cstdint>

#define DEVI __device__ __forceinline__
#ifndef PROBE_MASK
#define PROBE_MASK 0
#endif
#ifndef SPAN_PH
#define SPAN_PH -1
#endif
typedef unsigned short bf16_t;
typedef short bf16x8 __attribute__((ext_vector_type(8)));
typedef short s16x4 __attribute__((ext_vector_type(4)));
typedef float f32x4 __attribute__((ext_vector_type(4)));
typedef float f32x16 __attribute__((ext_vector_type(16)));
typedef unsigned u32x4 __attribute__((ext_vector_type(4)));
typedef unsigned u32x2 __attribute__((ext_vector_type(2)));

constexpr int BATCH = 16, SEQ = 2048, DM = 1024, T_ = BATCH * SEQ;
constexpr int NH = 8;
constexpr int LDZ = 2560;
constexpr int NZ = 2560;
constexpr int ZR = 640;
constexpr int NEXP = 32, DEXP = 256;
constexpr int CAP = T_ * 2 + NEXP * 256;
constexpr int NBLK = CAP / 256;
constexpr int NTHREADS = 512, NWAVES = 8;

constexpr size_t MiB = 1u << 20;
constexpr size_t OFF_CTL = 0;
constexpr size_t OFF_WIN = 1 * MiB;
constexpr size_t OFF_WG = 7 * MiB;
constexpr size_t OFF_WUQ = 11 * MiB;
constexpr size_t OFF_WUKV = 12 * MiB;
constexpr size_t OFF_WBM = 13 * MiB;
constexpr size_t OFF_WBR = 14 * MiB;
constexpr size_t OFF_WOUT = 15 * MiB;
constexpr size_t OFF_WUP = 17 * MiB;
constexpr size_t OFF_AUP = 17 * MiB + 131072;
constexpr size_t OFF_GUP = 17 * MiB + 262144;
constexpr size_t OFF_WKR = 17 * MiB + 524288;
constexpr size_t OFF_ROPE = 18 * MiB;
constexpr size_t OFF_TOKE = 18 * MiB + 262144;
constexpr size_t OFF_TOKW = 18 * MiB + 524288;
constexpr size_t OFF_TOKS = 18 * MiB + 786432;
constexpr size_t OFF_TOKR = 19 * MiB;
constexpr size_t OFF_WRT = 19 * MiB + 524288;
constexpr size_t OFF_CNTWG = 19 * MiB + 786432;
constexpr size_t OFF_KROPE = 20 * MiB;
constexpr size_t OFF_YB = 22 * MiB;
constexpr size_t OFF_W13 = 366 * MiB;
constexpr size_t OFF_W2 = 54 * MiB;
constexpr size_t OFF_TW = 70 * MiB;
constexpr size_t OFF_AD = 78 * MiB;
constexpr size_t OFF_SG = 54 * MiB;
constexpr size_t OFF_Z = 94 * MiB;
constexpr size_t OFF_H = 302 * MiB;
constexpr size_t OFF_WL = 270 * MiB;
constexpr size_t OFF_G = 398 * MiB;
constexpr size_t OFF_OMLA = 430 * MiB;
constexpr size_t OFF_YF = 462 * MiB;
constexpr size_t OFF_H2ND = 94 * MiB;
constexpr size_t OFF_BR = 158 * MiB;
constexpr size_t OFF_BM = 94 * MiB;
constexpr size_t OFF_X1 = 94 * MiB;
constexpr size_t DOFF_H2 = 0;
constexpr size_t OFF_YE = 158 * MiB;
constexpr size_t DOFF_HID = 65 * MiB;
constexpr size_t OFF_VS = 270 * MiB;
constexpr size_t OFF_SDIR = 70 * MiB;
constexpr size_t OFF_MIXED = 222 * MiB;
constexpr size_t OFF_SLOTTOK = 338 * MiB;
constexpr size_t WS_NEED = 494 * MiB;
constexpr size_t DOFF_QRAW = 0, DOFF_KVRAW = 48 * MiB;

constexpr int C_CNT = 0, C_CUR = 64, C_PST = 128, C_NBLK = 192, C_BLKE = 256;

DEVI int my_tid() { int t = threadIdx.x; asm volatile("" : "+v"(t)); return t; }
DEVI float bf2f(unsigned h) { return __uint_as_float(h << 16); }
DEVI unsigned f2bf(float f) { unsigned u = __float_as_uint(f); return (u + 0x7fffu + ((u >> 16) & 1u)) >> 16; }
typedef float f32x2p __attribute__((ext_vector_type(2))); typedef __bf16 bf16x2p __attribute__((ext_vector_type(2)));
DEVI unsigned pk2(float lo, float hi) { const f32x2p v = {lo, hi}; return __builtin_bit_cast(unsigned, __builtin_convertvector(v, bf16x2p)); }
DEVI float lo16(unsigned w) { return __uint_as_float(w << 16); }
DEVI float hi16(unsigned w) { return __uint_as_float(w & 0xffff0000u); }
DEVI float wave_sum(float v) {
    v += __int_as_float(__builtin_amdgcn_update_dpp(0, __float_as_int(v), 0xB1, 0xF, 0xF, false));
    v += __int_as_float(__builtin_amdgcn_update_dpp(0, __float_as_int(v), 0x4E, 0xF, 0xF, false));
    v += __int_as_float(__builtin_amdgcn_update_dpp(0, __float_as_int(v), 0x141, 0xF, 0xF, false));
    v += __int_as_float(__builtin_amdgcn_update_dpp(0, __float_as_int(v), 0x140, 0xF, 0xF, false));
    v += __shfl_xor(v, 16); v += __shfl_xor(v, 32);
    return v;
}
DEVI float sigmoidf_(float x) { return __builtin_amdgcn_rcpf(1.f + __expf(-x)); }
DEVI void unpack8(const u32x4 w, float (&f)[8]) { f[0] = lo16(w.x); f[1] = hi16(w.x); f[2] = lo16(w.y); f[3] = hi16(w.y); f[4] = lo16(w.z); f[5] = hi16(w.z); f[6] = lo16(w.w); f[7] = hi16(w.w); }
DEVI u32x4 pack8(const float (&f)[8]) { u32x4 w; w.x = pk2(f[0], f[1]); w.y = pk2(f[2], f[3]); w.z = pk2(f[4], f[5]); w.w = pk2(f[6], f[7]); return w; }

struct TJob { int in_idx, K, ldsrc, col0, ncols, row_mul, row_off, nbatch; long long sbs, dbs, dst_off; int item0, dst_ld; };
constexpr int MAXJOBS = 16;
struct Params {
    const float* in[32];
    float* out;
    unsigned char* ws;
    TJob jobs[MAXJOBS];
    int njobs_early, njobs_all, items_early, items_all;
    int njobs_mid, items_mid;
};

DEVI void transpose_item(const float* W, int K, int ld, bf16_t* WT, int dst_ld, int row_off, int row_mul, float* scr, int kb, int nb, int lane) {
    const int k0 = 64 * kb, n0 = 32 * nb;
    float tv[32];
#pragma unroll
    for (int i = 0; i < 32; ++i) tv[i] = W[(size_t)(k0 + 2 * i + (lane >> 5)) * ld + n0 + (lane & 31)];
#pragma unroll
    for (int i = 0; i < 32; ++i) scr[(2 * i + (lane >> 5)) * 33 + (lane & 31)] = tv[i];
    asm volatile("s_waitcnt lgkmcnt(0)" ::: "memory");
    const int c = lane & 7;
#pragma unroll
    for (int j = 0; j < 4; ++j) {
        const int n = (lane >> 3) + 8 * j; const float* s = scr + (8 * c) * 33 + n;
        u32x4 o; o.x = pk2(s[0], s[33]); o.y = pk2(s[66], s[99]); o.z = pk2(s[132], s[165]); o.w = pk2(s[198], s[231]);
        const int nn = n0 + n;
        const int drow = row_mul > 0 ? row_off + nn * row_mul : row_off + ((nn >> 7) << 8) + (nn & 127);
        *(u32x4*)(WT + (size_t)drow * dst_ld + k0 + 8 * c) = o;
    }
    asm volatile("s_waitcnt lgkmcnt(0)" ::: "memory");
}
DEVI void stage_transposes(const Params& p, int j0, int j1, int item_base, int item_end, char* lds, int bid, int nb) {
    const int lane = my_tid() & 63, wave = my_tid() >> 6;
    float* scr = (float*)(lds + wave * 8704);
    const int gw = bid * NWAVES + wave, NGW = nb * NWAVES;
    for (int it = item_base + gw; it < item_end; it += NGW) {
        int j = j0;
        while (j + 1 < j1 && it >= p.jobs[j + 1].item0) ++j;
        const TJob& J = p.jobs[j];
        int r = it - J.item0;
        const int nblk = J.ncols / 32, per = (J.K / 64) * nblk;
        const int e = r / per; r -= e * per;
        const int kb = r / nblk, nbk = r % nblk;
        transpose_item(p.in[J.in_idx] + (size_t)e * J.sbs + J.col0, J.K, J.ldsrc, (bf16_t*)(p.ws + J.dst_off) + (size_t)e * J.dbs, J.dst_ld, J.row_off, J.row_mul, scr, kb, nbk, lane);
    }
}
DEVI void stage_rope_table(const Params& p, int bid, int nb) {
    float* ct = (float*)(p.ws + OFF_ROPE); float* st = ct + SEQ * 16;
    for (int i = bid * NTHREADS + my_tid(); i < SEQ * 16; i += nb * NTHREADS) {
        const int pos = i >> 4, f = i & 15;
        const double inv = pow(10000.0, -(double)(2 * f) / 32.0);
        const double ang = (double)pos * inv;
        ct[i] = (float)cos(ang); st[i] = (float)sin(ang);
    }
}

DEVI void stage_rms_rows(const float* x, const float* g, bf16_t* out, int bid, int nb) {
    const int lane = my_tid() & 63, wave = my_tid() >> 6;
    const int gw = bid * NWAVES + wave, NGW = nb * NWAVES;
    f32x4 gv[4];
#pragma unroll
    for (int j = 0; j < 4; ++j) gv[j] = *(const f32x4*)(g + 4 * lane + 256 * j);
    for (int mb = gw * 4; mb < T_; mb += NGW * 4) {
        f32x4 v[4][4];
#pragma unroll
        for (int q = 0; q < 4; ++q) { const f32x4* xr = (const f32x4*)(x + (size_t)(mb + q) * DM) + lane;
#pragma unroll
            for (int j = 0; j < 4; ++j) v[q][j] = xr[64 * j]; }
#pragma unroll
        for (int q = 0; q < 4; ++q) { float s = 0.f;
#pragma unroll
            for (int j = 0; j < 4; ++j) s += (v[q][j].x * v[q][j].x + v[q][j].y * v[q][j].y) + (v[q][j].z * v[q][j].z + v[q][j].w * v[q][j].w);
            const float rstd = rsqrtf(wave_sum(s) * (1.f / DM) + 1e-6f);
            u32x2* o8 = (u32x2*)(out + (size_t)(mb + q) * DM) + lane;
#pragma unroll
            for (int j = 0; j < 4; ++j) { u32x2 w; w.x = pk2(v[q][j].x * rstd * gv[j].x, v[q][j].y * rstd * gv[j].y); w.y = pk2(v[q][j].z * rstd * gv[j].z, v[q][j].w * rstd * gv[j].w); o8[64 * j] = w; } }
    }
}

typedef short v4i16_t_ __attribute__((ext_vector_type(4)));
DEVI s16x4 vtr_(const char* p) { return __builtin_bit_cast(s16x4, __builtin_amdgcn_ds_read_tr16_b64_v4i16((__attribute__((address_space(3))) v4i16_t_*)p)); }
struct EpiBf16 { bf16_t* out; int ld;
    DEVI void operator()(int row, int col, f32x4 v) const { u32x2 w; w.x = pk2(v.x, v.y); w.y = pk2(v.z, v.w); *(u32x2*)(out + (size_t)row * ld + col) = w; } };
struct EpiBiasAct { bf16_t* out; int ld; const float* bias; int act;
    DEVI void operator()(int row, int col, f32x4 v) const {
        const f32x4 b = *(const f32x4*)(bias + col); v = v + b;
        if (act) { v.x = sigmoidf_(v.x); v.y = sigmoidf_(v.y); v.z = sigmoidf_(v.z); v.w = sigmoidf_(v.w); }
        u32x2 w; w.x = pk2(v.x, v.y); w.y = pk2(v.z, v.w); *(u32x2*)(out + (size_t)row * ld + col) = w; } };
struct EpiMix { const bf16_t* gl; bf16_t* bm; const float* gb;
    DEVI void operator()(int row, int col, f32x4 v) const {
        const u32x2 g1 = *(const u32x2*)(gl + (size_t)row * 2048 + col), g2 = *(const u32x2*)(gl + (size_t)row * 2048 + 1024 + col);
        const u32x2 m = *(const u32x2*)(bm + (size_t)row * 1024 + col);
        const f32x4 b0 = *(const f32x4*)(gb + col), b1 = *(const f32x4*)(gb + 1024 + col);
        f32x4 r;
        r.x = sigmoidf_(lo16(g1.x) + b0.x) * lo16(m.x) + sigmoidf_(lo16(g2.x) + b1.x) * v.x;
        r.y = sigmoidf_(hi16(g1.x) + b0.y) * hi16(m.x) + sigmoidf_(hi16(g2.x) + b1.y) * v.y;
        r.z = sigmoidf_(lo16(g1.y) + b0.z) * lo16(m.y) + sigmoidf_(lo16(g2.y) + b1.z) * v.z;
        r.w = sigmoidf_(hi16(g1.y) + b0.w) * hi16(m.y) + sigmoidf_(hi16(g2.y) + b1.w) * v.w;
        u32x2 w; w.x = pk2(r.x, r.y); w.y = pk2(r.z, r.w); *(u32x2*)(bm + (size_t)row * 1024 + col) = w; } };
struct EpiResid { const float* x; float* out;
    DEVI void operator()(int row, int col, f32x4 v) const { const f32x4 b = *(const f32x4*)(x + (size_t)row * DM + col); *(f32x4*)(out + (size_t)row * DM + col) = b + v; } };
struct EpiSwiglu { bf16_t* hid;
    DEVI void operator()(int row, int col, f32x4 v) const {
        const float a = v.x * sigmoidf_(v.x) * v.y, b = v.z * sigmoidf_(v.z) * v.w;
        *(unsigned*)(hid + (size_t)row * DEXP + (col >> 1)) = pk2(a, b); } };

template <class Epi>
DEVI void gemm_stage(const bf16_t* A, int lda, const bf16_t* Bt, int ldb, int M, int N, int K, const Epi& epi, char* lds, int bid, int nb,
                     const int* rowidx, const int* blk_e, size_t estride) {
    const int tid = my_tid(), lane = tid & 63, wid = tid >> 6, wr = wid >> 1, wc = wid & 1;
    const int nM = M / 256, nN = (N + 127) / 128, nt = K / 64;
    for (int u = bid; u < nM * nN; u += nb) {
        const int pm = u / nN, pn = u % nN, m0 = pm * 256, n0 = pn * 128;
        const bf16_t* Bu = Bt;
        if (blk_e) { const int e = blk_e[pm]; if (e < 0) continue; Bu = Bt + (size_t)e * estride; }
        const bf16_t* ga[4]; const bf16_t* gb[2]; int offA[4], offB[2];
#pragma unroll
        for (int i = 0; i < 4; ++i) { const int pc = tid + 512 * i, row = pc >> 3, ch = pc & 7;
            int r = m0 + row; if (rowidx) r = rowidx[m0 + row];
            ga[i] = (r >= 0) ? A + (size_t)r * lda + ch * 8 : nullptr; offA[i] = row * 128 + ((ch ^ (row & 7)) << 4); }
#pragma unroll
        for (int i = 0; i < 2; ++i) { const int pc = tid + 512 * i, row = pc >> 3, ch = pc & 7; const int n = n0 + row;
            gb[i] = (n < N) ? Bu + (size_t)n * ldb + ch * 8 : nullptr; offB[i] = row * 128 + ((ch ^ (row & 7)) << 4); }
        u32x4 ra[4], rb[2];
        const u32x4 zero4 = {0u, 0u, 0u, 0u};
#define G_LOAD(kt) do { _Pragma("unroll") for (int i = 0; i < 4; ++i) ra[i] = ga[i] ? *(const u32x4*)(ga[i] + (kt) * 64) : zero4; \
                        _Pragma("unroll") for (int i = 0; i < 2; ++i) rb[i] = gb[i] ? *(const u32x4*)(gb[i] + (kt) * 64) : zero4; } while (0)
#define G_STORE(buf) do { _Pragma("unroll") for (int i = 0; i < 4; ++i) *(u32x4*)(lds + (buf) * 32768 + offA[i]) = ra[i]; \
                          _Pragma("unroll") for (int i = 0; i < 2; ++i) *(u32x4*)(lds + 65536 + (buf) * 16384 + offB[i]) = rb[i]; } while (0)
        f32x4 acc[4][4];
#pragma unroll
        for (int a = 0; a < 4; ++a)
#pragma unroll
            for (int b = 0; b < 4; ++b) acc[a][b] = (f32x4){0.f, 0.f, 0.f, 0.f};
        G_LOAD(0); G_STORE(0); __syncthreads();
        for (int kt = 0; kt < nt; ++kt) {
            const int buf = kt & 1;
            if (kt + 1 < nt) G_LOAD(kt + 1);
            const char* As = lds + buf * 32768; const char* Bs = lds + 65536 + buf * 16384;
#pragma unroll
            for (int kk = 0; kk < 2; ++kk) {
                bf16x8 af[4], bfr[4];
#pragma unroll
                for (int mi = 0; mi < 4; ++mi) { const int row = 64 * wr + 16 * mi + (lane & 15), ch = 4 * kk + (lane >> 4); af[mi] = *(const bf16x8*)(As + row * 128 + ((ch ^ (row & 7)) << 4)); }
#pragma unroll
                for (int ni = 0; ni < 4; ++ni) { const int row = 64 * wc + 16 * ni + (lane & 15), ch = 4 * kk + (lane >> 4); bfr[ni] = *(const bf16x8*)(Bs + row * 128 + ((ch ^ (row & 7)) << 4)); }
#pragma unroll
                for (int mi = 0; mi < 4; ++mi)
#pragma unroll
                    for (int ni = 0; ni < 4; ++ni) acc[mi][ni] = __builtin_amdgcn_mfma_f32_16x16x32_bf16(bfr[ni], af[mi], acc[mi][ni], 0, 0, 0);
            }
            if (kt + 1 < nt) G_STORE(buf ^ 1);
            __syncthreads();
        }
#undef G_LOAD
#undef G_STORE
#pragma unroll
        for (int mi = 0; mi < 4; ++mi)
#pragma unroll
            for (int ni = 0; ni < 4; ++ni) {
                const int row = m0 + 64 * wr + 16 * mi + (lane & 15), col = n0 + 64 * wc + 16 * ni + 4 * (lane >> 4);
                if (col < N) epi(row, col, acc[mi][ni]);
            }
    }
}


namespace pg8 {
#define PG8_LAS __attribute__((address_space(3)))
constexpr int BM = 256, BK = 64, HALF = 128, HTB = HALF * BK * 2, STAGE_BYTES = 8 * HTB, NXCD = 8, WGM = 8;
__host__ __device__ __forceinline__ int lds_byte(int r, int c) { const int st = (r >> 4) * 2 + (c >> 5), rr = r & 15, cc = c & 31, ob = rr * 64 + cc * 2; return st * 1024 + (ob ^ (((ob >> 9) & 1) << 5)); }
__host__ __device__ __forceinline__ void stage_rc(int b, int& R, int& C) { const int st = b / 1024, sb = b % 1024, swz = sb ^ (((sb >> 9) & 1) << 5); R = (st >> 1) * 16 + swz / 64; C = (st & 1) * 32 + (swz % 64) / 2; }
__host__ __device__ __forceinline__ int perm32(int rho) { const int n = rho >> 4, i = rho & 15; return 8 * (i >> 2) + 4 * n + (i & 3); }
struct Unit { int pm, pn, e; };
struct Gemm { const bf16_t* A; const bf16_t* Bt; int M, N, K, lda, ldb; size_t estride; const int* rowidx; };
struct StaticOrder {
    int nM, nN, nwg, G, c; const int* blk_e;
    __device__ void init(int M, int N, int G_, int c_, const int* be = nullptr) { nM = M / BM; nN = N / BM; nwg = nM * nN; G = G_; c = c_; blk_e = be; }
    __device__ bool next(int i, Unit& u) const {
        const long L = (long)i * G + c; if (L >= nwg) return false;
        int wgid = (int)L; { const int q = nwg / NXCD, r = nwg % NXCD, xcd = wgid % NXCD, off = wgid / NXCD; wgid = (xcd < r ? xcd * (q + 1) : r * (q + 1) + (xcd - r) * q) + off; }
        const int nig = WGM * nN, gid = wgid / nig, fm = gid * WGM, gsz = (nM - fm) < WGM ? (nM - fm) : WGM;
        u.pm = fm + ((wgid % nig) % gsz); u.pn = (wgid % nig) / gsz; u.e = blk_e ? blk_e[u.pm] : 0; return true;
    }
    __device__ __forceinline__ void a_ready(const Unit&) const {}
    __device__ __forceinline__ void done(const Unit&) const {}
};
template <class F> struct Epi8 {
    static constexpr bool PERM = true, AFTER_DRAIN = false; F f;
    __device__ __forceinline__ void operator()(const f32x4 (&acc)[2][2][4][2], const Unit& u, int wr, int wc, int fr, int fq) const {
#pragma unroll
        for (int ai = 0; ai < 2; ++ai)
#pragma unroll
            for (int m = 0; m < 4; ++m) { const int row = u.pm * BM + ai * HALF + wr * 64 + m * 16 + fr;
#pragma unroll
                for (int bj = 0; bj < 2; ++bj) f(row, u.pn * BM + bj * HALF + wc * 32 + 8 * fq, acc[ai][bj][m][0], acc[ai][bj][m][1]); }
    }
};
template <class Epi, class Sched, bool ALIGN_EPI = false, bool SP2 = false, bool GATHER = false>
__device__ __forceinline__ void gemm_phase(PG8_LAS unsigned char* lds, const Gemm g, const Sched& S, const Epi& E) {
    const int tid = my_tid(), wid = __builtin_amdgcn_readfirstlane(tid >> 6), lane = tid & 63, wr = wid >> 2, wc = wid & 3, fr = lane & 15, fq = lane >> 4;
    const int K = g.K, nt = K / BK;
    unsigned voffA[2], voffB[2]; int rA[2], cA2[2];
#pragma unroll
    for (int i = 0; i < 2; ++i) { int R, C; stage_rc(tid * 16 + i * 8192, R, C); const int Rb = Epi::PERM ? ((R & ~31) + perm32(R & 31)) : R; rA[i] = R; cA2[i] = C * 2;
        voffA[i] = (unsigned)(R * g.lda + C) * 2u; voffB[i] = (unsigned)(Rb * g.ldb + C) * 2u; }
    unsigned vAc[2][2], vAn[2][2];
#define PG8_VA(dst, pmv) do { _Pragma("unroll") for (int h_ = 0; h_ < 2; ++h_) _Pragma("unroll") for (int i_ = 0; i_ < 2; ++i_) { \
        if constexpr (GATHER) dst[h_][i_] = (unsigned)g.rowidx[(pmv) * BM + h_ * HALF + rA[i_]] * (unsigned)(g.lda * 2) + (unsigned)cA2[i_]; \
        else dst[h_][i_] = voffA[i_] + (unsigned)(h_ * HALF * g.lda * 2); } } while (0)
    const size_t kstep = (size_t)(BK * 2);
    const size_t hstepA = (size_t)HALF * g.lda * 2, hstepB = (size_t)HALF * g.ldb * 2;
    const size_t tstepA = 2 * hstepA, tstepB = 2 * hstepB, estep = g.estride * 2;
    const unsigned ldsw = (unsigned)wid * 1024u;
    const int aoff = lds_byte(wr * 64 + fr, fq * 8), boff = lds_byte(wc * 32 + fr, fq * 8);
#define PG8_SA(b, h) (((b) * 2 + (h)) * HTB)
#define PG8_SB(b, h) ((4 + (b) * 2 + (h)) * HTB)
#define PG8_STAGE(bufoff, gbase, voff) do { _Pragma("unroll") for (int _i = 0; _i < 2; ++_i) \
        __builtin_amdgcn_global_load_lds((const unsigned*)((const char*)(gbase) + (voff)[_i]), (PG8_LAS unsigned*)(lds + (bufoff) + ldsw + _i * 8192), 16, 0, 0); } while (0)
#define PG8_LDA(dst, b, h) do { _Pragma("unroll") for (int m = 0; m < 4; ++m) _Pragma("unroll") for (int k = 0; k < 2; ++k) dst[m][k] = *(const PG8_LAS bf16x8*)(lds + PG8_SA(b, h) + aoff + m * 2048 + k * 1024); } while (0)
#define PG8_LDB(dst, b, h) do { _Pragma("unroll") for (int n = 0; n < 2; ++n) _Pragma("unroll") for (int k = 0; k < 2; ++k) dst[n][k] = *(const PG8_LAS bf16x8*)(lds + PG8_SB(b, h) + boff + n * 2048 + k * 1024); } while (0)
#define PG8_MMA(ai, bj, At, Bt) do { __builtin_amdgcn_s_setprio(1); _Pragma("unroll") for (int m = 0; m < 4; ++m) _Pragma("unroll") for (int n = 0; n < 2; ++n) _Pragma("unroll") for (int k = 0; k < 2; ++k) \
        acc[ai][bj][m][n] = __builtin_amdgcn_mfma_f32_16x16x32_bf16(Bt[n][k], At[m][k], acc[ai][bj][m][n], 0, 0, 0); __builtin_amdgcn_s_setprio(0); } while (0)
#define PG8_WAIT_V(n) asm volatile("s_waitcnt vmcnt(" #n ")" ::: "memory")
#define PG8_WAIT_L(n) asm volatile("s_waitcnt lgkmcnt(" #n ")" ::: "memory")
#define PG8_BAR __builtin_amdgcn_s_barrier()
#define PG8_SCHED __builtin_amdgcn_sched_barrier(0)
    Unit cur, nxt; int ui = 0;
    if (!S.next(0, cur)) return;
    f32x4 acc[2][2][4][2];
#pragma unroll
    for (int a = 0; a < 2; ++a)
#pragma unroll
        for (int b = 0; b < 2; ++b)
#pragma unroll
            for (int m = 0; m < 4; ++m)
#pragma unroll
                for (int n = 0; n < 2; ++n) acc[a][b][m][n] = (f32x4){0.f, 0.f, 0.f, 0.f};
    bf16x8 At[4][2], B0[2][2], B1[2][2];
    const char* cA = (const char*)g.A + (GATHER ? (size_t)0 : (size_t)cur.pm * tstepA); const char* cB = (const char*)g.Bt + (size_t)cur.e * estep + (size_t)cur.pn * tstepB;
    PG8_VA(vAc, cur.pm);
    S.a_ready(cur);
    if constexpr (SP2) {
        PG8_STAGE(PG8_SB(0, 0), cB, voffB); PG8_STAGE(PG8_SB(0, 1), cB + hstepB, voffB); PG8_STAGE(PG8_SA(0, 0), cA, vAc[0]); PG8_STAGE(PG8_SA(0, 1), cA, vAc[1]);
        if (wr == 1) PG8_BAR;
        PG8_WAIT_V(2); PG8_BAR;
        PG8_STAGE(PG8_SB(1, 0), cB + kstep, voffB); PG8_STAGE(PG8_SA(1, 0), cA + kstep, vAc[0]); PG8_STAGE(PG8_SB(1, 1), cB + hstepB + kstep, voffB);
        PG8_WAIT_V(6); PG8_BAR;
    } else {
        PG8_STAGE(PG8_SB(0, 0), cB, voffB); PG8_STAGE(PG8_SA(0, 0), cA, voffA); PG8_STAGE(PG8_SB(0, 1), cB + hstepB, voffB); PG8_STAGE(PG8_SA(0, 1), cA + hstepA, voffA);
        if (wr == 1) PG8_BAR;
        PG8_WAIT_V(4); PG8_BAR;
        PG8_STAGE(PG8_SB(1, 0), cB + kstep, voffB); PG8_STAGE(PG8_SA(1, 0), cA + kstep, voffA); PG8_STAGE(PG8_SB(1, 1), cB + hstepB + kstep, voffB);
        PG8_WAIT_V(6); PG8_BAR;
    }
    for (;;) {
        const bool has_next = S.next(ui + 1, nxt);
        const char* nA = (has_next && !GATHER) ? (const char*)g.A + (size_t)nxt.pm * tstepA : cA; PG8_VA(vAn, (has_next ? nxt.pm : cur.pm)); const char* nB = has_next ? (const char*)g.Bt + (size_t)nxt.e * estep + (size_t)nxt.pn * tstepB : cB;
        for (int t = 0; t < nt; t += 2) {
            const bool last = (t == nt - 2);
            const char* a1 = cA + (size_t)(t + 1) * kstep;
            const char* a2 = last ? nA : cA + (size_t)(t + 2) * kstep; const char* b2 = last ? nB : cB + (size_t)(t + 2) * kstep;
            const char* a3 = a2 + kstep; const char* b3 = b2 + kstep;
            unsigned v2[2][2];
#pragma unroll
            for (int h_ = 0; h_ < 2; ++h_)
#pragma unroll
                for (int i_ = 0; i_ < 2; ++i_) v2[h_][i_] = last ? vAn[h_][i_] : vAc[h_][i_];
            if (last && has_next) S.a_ready(nxt);
            if constexpr (SP2) {
            PG8_LDB(B0, 0, 0); PG8_LDB(B1, 0, 1); PG8_SCHED; PG8_LDA(At, 0, 0); PG8_STAGE(PG8_SA(1, 1), a1, vAc[1]);
            PG8_WAIT_V(8); PG8_WAIT_L(0); PG8_BAR; PG8_MMA(0, 0, At, B0); PG8_MMA(0, 1, At, B1); PG8_BAR; PG8_SCHED;
            PG8_LDA(At, 0, 1); PG8_STAGE(PG8_SB(0, 0), b2, voffB); PG8_STAGE(PG8_SB(0, 1), b2 + hstepB, voffB); PG8_STAGE(PG8_SA(0, 0), a2, v2[0]);
            PG8_WAIT_V(8); PG8_WAIT_L(0); PG8_BAR; PG8_MMA(1, 0, At, B0); PG8_MMA(1, 1, At, B1); PG8_BAR; PG8_SCHED;
            PG8_LDB(B0, 1, 0); PG8_LDB(B1, 1, 1); PG8_SCHED; PG8_LDA(At, 1, 0); PG8_STAGE(PG8_SA(0, 1), a2, v2[1]);
            PG8_WAIT_V(8); PG8_WAIT_L(0); PG8_BAR; PG8_MMA(0, 0, At, B0); PG8_MMA(0, 1, At, B1); PG8_BAR; PG8_SCHED;
            PG8_LDA(At, 1, 1); PG8_STAGE(PG8_SB(1, 0), b3, voffB); PG8_STAGE(PG8_SB(1, 1), b3 + hstepB, voffB); PG8_STAGE(PG8_SA(1, 0), a3, v2[0]);
            PG8_WAIT_V(8); PG8_WAIT_L(0); PG8_BAR; PG8_MMA(1, 0, At, B0); PG8_MMA(1, 1, At, B1); PG8_BAR; PG8_SCHED;
            } else {
            PG8_LDB(B0, 0, 0); PG8_SCHED; PG8_LDA(At, 0, 0); PG8_STAGE(PG8_SA(1, 1), a1 + hstepA, voffA);
            PG8_WAIT_L(8); PG8_BAR; PG8_WAIT_L(0); PG8_MMA(0, 0, At, B0); PG8_BAR; PG8_SCHED;
            PG8_LDB(B1, 0, 1); PG8_STAGE(PG8_SB(0, 0), b2, voffB);
            PG8_BAR; PG8_WAIT_L(0); PG8_MMA(0, 1, At, B1); PG8_BAR;
            PG8_LDA(At, 0, 1); PG8_STAGE(PG8_SA(0, 0), a2, voffA);
            PG8_BAR; PG8_WAIT_L(0); PG8_MMA(1, 0, At, B0); PG8_BAR; PG8_SCHED;
            PG8_STAGE(PG8_SB(0, 1), b2 + hstepB, voffB);
            PG8_WAIT_V(6); PG8_BAR; PG8_MMA(1, 1, At, B1); PG8_BAR;
            PG8_LDB(B0, 1, 0); PG8_SCHED; PG8_LDA(At, 1, 0); PG8_STAGE(PG8_SA(0, 1), a2 + hstepA, voffA);
            PG8_WAIT_L(8); PG8_BAR; PG8_WAIT_L(0); PG8_MMA(0, 0, At, B0); PG8_BAR; PG8_SCHED;
            PG8_LDB(B1, 1, 1); PG8_STAGE(PG8_SB(1, 0), b3, voffB);
            PG8_BAR; PG8_WAIT_L(0); PG8_MMA(0, 1, At, B1); PG8_BAR;
            PG8_LDA(At, 1, 1); PG8_STAGE(PG8_SA(1, 0), a3, voffA);
            PG8_BAR; PG8_WAIT_L(0); PG8_MMA(1, 0, At, B0); PG8_BAR; PG8_SCHED;
            PG8_STAGE(PG8_SB(1, 1), b3 + hstepB, voffB);
            PG8_WAIT_V(6); PG8_BAR; PG8_MMA(1, 1, At, B1); PG8_BAR;
            }
        }
        if constexpr (ALIGN_EPI) { if (wr == 0) PG8_BAR; }
        if constexpr (!Epi::AFTER_DRAIN) { E(acc, cur, wr, wc, fr, fq); S.done(cur); }
        if (!has_next) break;
#pragma unroll
        for (int a = 0; a < 2; ++a)
#pragma unroll
            for (int b = 0; b < 2; ++b)
#pragma unroll
                for (int m = 0; m < 4; ++m)
#pragma unroll
                    for (int n = 0; n < 2; ++n) acc[a][b][m][n] = (f32x4){0.f, 0.f, 0.f, 0.f};
        cur = nxt; cA = nA; cB = nB; ++ui;
#pragma unroll
        for (int h_ = 0; h_ < 2; ++h_)
#pragma unroll
            for (int i_ = 0; i_ < 2; ++i_) vAc[h_][i_] = vAn[h_][i_];
        if constexpr (ALIGN_EPI) { if (wr == 1) PG8_BAR; }
    }
    PG8_WAIT_V(0);
    if constexpr (!ALIGN_EPI) { if (wr == 0) PG8_BAR; }
    PG8_BAR;
    if constexpr (Epi::AFTER_DRAIN) { E.fused(acc, cur, wr, wc, fr, fq, lds, wid, lane); S.done(cur); }
#undef PG8_VA
#undef PG8_SA
#undef PG8_SB
#undef PG8_STAGE
#undef PG8_LDA
#undef PG8_LDB
#undef PG8_MMA
#undef PG8_WAIT_V
#undef PG8_WAIT_L
#undef PG8_BAR
#undef PG8_SCHED
}
}

struct F8Bf16 { bf16_t* out; int ld;
    DEVI void operator()(int row, int col, f32x4 a, f32x4 b) const { u32x4 w; w.x = pk2(a.x, a.y); w.y = pk2(a.z, a.w); w.z = pk2(b.x, b.y); w.w = pk2(b.z, b.w); *(u32x4*)(out + (size_t)row * ld + col) = w; } };
struct F8Resid { const float* x; bf16_t* out;
    DEVI void operator()(int row, int col, f32x4 a, f32x4 b) const { const float* xp = x + (size_t)row * DM + col;
        a = a + *(const f32x4*)xp; b = b + *(const f32x4*)(xp + 4);
        u32x4 w; w.x = pk2(a.x, a.y); w.y = pk2(a.z, a.w); w.z = pk2(b.x, b.y); w.w = pk2(b.z, b.w); *(u32x4*)(out + (size_t)row * DM + col) = w; } };
struct F8Swiglu { bf16_t* hid;
    DEVI void operator()(int row, int col, f32x4 a, f32x4 b) const {
        u32x2 w; w.x = pk2(a.x * sigmoidf_(a.x) * a.y, a.z * sigmoidf_(a.z) * a.w); w.y = pk2(b.x * sigmoidf_(b.x) * b.y, b.z * sigmoidf_(b.z) * b.w);
        *(u32x2*)(hid + (size_t)row * DEXP + (col >> 1)) = w; } };
struct F8Mix { const bf16_t* gl; const bf16_t* bm; bf16_t* mixed; const float* gb;
    DEVI void operator()(int row, int col, f32x4 a, f32x4 b) const {
        const u32x4 g1 = *(const u32x4*)(gl + (size_t)row * 2048 + col), g2 = *(const u32x4*)(gl + (size_t)row * 2048 + 1024 + col);
        const u32x4 m = *(const u32x4*)(bm + (size_t)row * 1024 + col);
        const f32x4 b0a = *(const f32x4*)(gb + col), b0b = *(const f32x4*)(gb + col + 4), b1a = *(const f32x4*)(gb + 1024 + col), b1b = *(const f32x4*)(gb + 1024 + col + 4);
        float r[8];
        r[0] = sigmoidf_(lo16(g1.x) + b0a.x) * lo16(m.x) + sigmoidf_(lo16(g2.x) + b1a.x) * a.x;
        r[1] = sigmoidf_(hi16(g1.x) + b0a.y) * hi16(m.x) + sigmoidf_(hi16(g2.x) + b1a.y) * a.y;
        r[2] = sigmoidf_(lo16(g1.y) + b0a.z) * lo16(m.y) + sigmoidf_(lo16(g2.y) + b1a.z) * a.z;
        r[3] = sigmoidf_(hi16(g1.y) + b0a.w) * hi16(m.y) + sigmoidf_(hi16(g2.y) + b1a.w) * a.w;
        r[4] = sigmoidf_(lo16(g1.z) + b0b.x) * lo16(m.z) + sigmoidf_(lo16(g2.z) + b1b.x) * b.x;
        r[5] = sigmoidf_(hi16(g1.z) + b0b.y) * hi16(m.z) + sigmoidf_(hi16(g2.z) + b1b.y) * b.y;
        r[6] = sigmoidf_(lo16(g1.w) + b0b.z) * lo16(m.w) + sigmoidf_(lo16(g2.w) + b1b.z) * b.z;
        r[7] = sigmoidf_(hi16(g1.w) + b0b.w) * hi16(m.w) + sigmoidf_(hi16(g2.w) + b1b.w) * b.w;
        u32x4 w; w.x = pk2(r[0], r[1]); w.y = pk2(r[2], r[3]); w.z = pk2(r[4], r[5]); w.w = pk2(r[6], r[7]);
        *(u32x4*)(mixed + (size_t)row * 1024 + col) = w; } };
template <class F, bool GATHER = false>
DEVI void big_gemm_(char* lds, const bf16_t* A, int lda, const bf16_t* Bt, int ldb, int M, int N, int K, const F& f, int bid, int nb, const int* blk_e, size_t estride, const int* rowidx) {
    int Kr = K; asm volatile("" : "+s"(Kr));
    pg8::Gemm g{A, Bt, M, N, Kr, lda, ldb, estride, rowidx}; pg8::StaticOrder S; S.init(M, N, nb, bid, blk_e);
    pg8::Epi8<F> E{f};
    pg8::gemm_phase<pg8::Epi8<F>, pg8::StaticOrder, true, true, GATHER>((PG8_LAS unsigned char*)lds, g, S, E);
}
template <class F>
DEVI void big_gemm(char* lds, const bf16_t* A, int lda, const bf16_t* Bt, int ldb, int M, int N, int K, const F& f, int bid, int nb, const int* blk_e = nullptr, size_t estride = 0) {
    big_gemm_<F, false>(lds, A, lda, Bt, ldb, M, N, K, f, bid, nb, blk_e, estride, nullptr);
}

struct EpiGate { static constexpr bool PERM = true, AFTER_DRAIN = false; const bf16_t* bm; const bf16_t* br; bf16_t* mixed; const float* gb;
    __device__ __forceinline__ void operator()(const f32x4 (&acc)[2][2][4][2], const pg8::Unit& u, int wr, int wc, int fr, int fq) const {
        const int oc = u.pn * 128 + wc * 32 + 8 * fq;
        const f32x4 b0a = *(const f32x4*)(gb + oc), b0b = *(const f32x4*)(gb + oc + 4), b1a = *(const f32x4*)(gb + 1024 + oc), b1b = *(const f32x4*)(gb + 1024 + oc + 4);
#pragma unroll
        for (int ai = 0; ai < 2; ++ai)
#pragma unroll
            for (int m = 0; m < 4; ++m) { const int row = u.pm * pg8::BM + ai * pg8::HALF + wr * 64 + m * 16 + fr;
                const u32x4 mm = *(const u32x4*)(bm + (size_t)row * 1024 + oc), rr = *(const u32x4*)(br + (size_t)row * 1024 + oc);
                const f32x4 g1a = acc[ai][0][m][0], g1b = acc[ai][0][m][1], g2a = acc[ai][1][m][0], g2b = acc[ai][1][m][1];
                float r[8];
                r[0] = sigmoidf_(g1a.x + b0a.x) * lo16(mm.x) + sigmoidf_(g2a.x + b1a.x) * lo16(rr.x);
                r[1] = sigmoidf_(g1a.y + b0a.y) * hi16(mm.x) + sigmoidf_(g2a.y + b1a.y) * hi16(rr.x);
                r[2] = sigmoidf_(g1a.z + b0a.z) * lo16(mm.y) + sigmoidf_(g2a.z + b1a.z) * lo16(rr.y);
                r[3] = sigmoidf_(g1a.w + b0a.w) * hi16(mm.y) + sigmoidf_(g2a.w + b1a.w) * hi16(rr.y);
                r[4] = sigmoidf_(g1b.x + b0b.x) * lo16(mm.z) + sigmoidf_(g2b.x + b1b.x) * lo16(rr.z);
                r[5] = sigmoidf_(g1b.y + b0b.y) * hi16(mm.z) + sigmoidf_(g2b.y + b1b.y) * hi16(rr.z);
                r[6] = sigmoidf_(g1b.z + b0b.z) * lo16(mm.w) + sigmoidf_(g2b.z + b1b.z) * lo16(rr.w);
                r[7] = sigmoidf_(g1b.w + b0b.w) * hi16(mm.w) + sigmoidf_(g2b.w + b1b.w) * hi16(rr.w);
                u32x4 w; w.x = pk2(r[0], r[1]); w.y = pk2(r[2], r[3]); w.z = pk2(r[4], r[5]); w.w = pk2(r[6], r[7]);
                *(u32x4*)(mixed + (size_t)row * 1024 + oc) = w; }
    }
};
template <class E>
DEVI void big_gemm_epi(char* lds, const bf16_t* A, int lda, const bf16_t* Bt, int ldb, int M, int N, int K, const E& e, int bid, int nb) {
    int Kr = K; asm volatile("" : "+s"(Kr));
    pg8::Gemm g{A, Bt, M, N, Kr, lda, ldb, 0, nullptr}; pg8::StaticOrder S; S.init(M, N, nb, bid, nullptr);
    pg8::gemm_phase<E, pg8::StaticOrder, true, true, false>((PG8_LAS unsigned char*)lds, g, S, e);
}

DEVI void stage_mla_prep(const Params& p, char* lds, int bid, int nb, bool dry = false) {
    const int tid = my_tid(), lane = tid & 63, wave = tid >> 6;
    const int gw = bid * NWAVES + wave, NGW = nb * NWAVES;
    bf16_t* z = (bf16_t*)(p.ws + OFF_Z); bf16_t* krope = (bf16_t*)(p.ws + OFF_KROPE);
    const float* ct = (const float*)(p.ws + OFF_ROPE); const float* st = ct + SEQ * 16;
    const float* gq = p.in[3]; const float* gkv = p.in[4];
    {
        const bf16_t* wkr = (const bf16_t*)(p.ws + OFF_WKR);
        u32x4 w8[8];
#pragma unroll
        for (int i = 0; i < 8; ++i) { const int q = tid + 512 * i; w8[i] = *(const u32x4*)(wkr + (size_t)(q >> 7) * DM + (q & 127) * 8); }
#pragma unroll
        for (int i = 0; i < 8; ++i) { const int q = tid + 512 * i; *(u32x4*)(lds + (q >> 7) * 2064 + (q & 127) * 16) = w8[i]; }
    }
    {
        const bool isq = lane < 48;
        const float* g0p = isq ? gq + 8 * lane : gkv + 8 * (lane - 48); const float* g1p = gkv + 8 * ((lane & 15) + 16);
        const f32x4 g0a = *(const f32x4*)g0p, g0b = *(const f32x4*)(g0p + 4), g1a = *(const f32x4*)g1p, g1b = *(const f32x4*)(g1p + 4);
        const float g0[8] = {g0a.x, g0a.y, g0a.z, g0a.w, g0b.x, g0b.y, g0b.z, g0b.w}, g1[8] = {g1a.x, g1a.y, g1a.z, g1a.w, g1b.x, g1b.y, g1b.z, g1b.w};
        for (int tq = gw * 4; tq < T_; tq += NGW * 4) {
            u32x4 A[4], B[4];
#pragma unroll
            for (int q = 0; q < 4; ++q) { bf16_t* zr = z + (size_t)(tq + q) * LDZ; A[q] = *(const u32x4*)(zr + 8 * lane); B[q] = (u32x4){0u, 0u, 0u, 0u}; if (lane < 16) B[q] = *(const u32x4*)(zr + 512 + 8 * lane); }
#pragma unroll
            for (int q = 0; q < 4; ++q) {
                bf16_t* zr = z + (size_t)(tq + q) * LDZ;
                float a[8], b[8]; unpack8(A[q], a); unpack8(B[q], b);
                float sa = 0.f, sb = 0.f;
#pragma unroll
                for (int j = 0; j < 8; ++j) { sa += a[j] * a[j]; sb += b[j] * b[j]; }
                const float ssq = wave_sum(isq ? sa : 0.f), sskv = wave_sum((isq ? 0.f : sa) + sb);
                const float rq = rsqrtf(ssq * (1.f / 384.f) + 1e-6f), rkv = rsqrtf(sskv * (1.f / 256.f) + 1e-6f);
                const float r = isq ? rq : rkv;
                float oa[8], ob[8];
#pragma unroll
                for (int j = 0; j < 8; ++j) { oa[j] = a[j] * r * g0[j]; ob[j] = b[j] * rkv * g1[j]; }
                const u32x4 o = pack8(oa), o2 = pack8(ob);
                if (!dry) { *(u32x4*)(zr + 8 * lane) = o; if (lane < 16) *(u32x4*)(zr + 512 + 8 * lane) = o2; } else { asm volatile("" :: "v"(o)); asm volatile("" :: "v"(o2)); }
            }
        }
    }
    __syncthreads();
    const bf16_t* hb = (const bf16_t*)(p.ws + OFF_H);
    for (int tb = gw * 16; tb < T_; tb += NGW * 16) {
        const int li = lane & 15, kq = lane >> 4;
        const bf16_t* ap = hb + (size_t)(tb + li) * DM + 8 * kq;
        bf16x8 av[32];
#pragma unroll
        for (int ks = 0; ks < 32; ++ks) av[ks] = *(const bf16x8*)(ap + 32 * ks);
        const char* bl = lds + li * 2064 + kq * 16;
        f32x4 a0 = {0.f, 0.f, 0.f, 0.f}, a1 = a0;
#pragma unroll
        for (int ks = 0; ks < 32; ++ks) {
            if ((ks & 3) == 0) asm volatile("" ::: "memory");
            a0 = __builtin_amdgcn_mfma_f32_16x16x32_bf16(av[ks], *(const bf16x8*)(bl + 64 * ks), a0, 0, 0, 0);
            a1 = __builtin_amdgcn_mfma_f32_16x16x32_bf16(av[ks], *(const bf16x8*)(bl + 16 * 2064 + 64 * ks), a1, 0, 0, 0);
        }
#pragma unroll
        for (int r = 0; r < 4; ++r) { const int t = tb + 4 * kq + r, pos = t & (SEQ - 1);
            const float c = ct[pos * 16 + li], s = st[pos * 16 + li];
            if (!dry) { krope[(size_t)t * 32 + li] = (bf16_t)f2bf(a0[r] * c - a1[r] * s); krope[(size_t)t * 32 + 16 + li] = (bf16_t)f2bf(a0[r] * s + a1[r] * c); } }
    }
    __syncthreads();
}

DEVI void stage_sg_prep(const Params& p, int bid, int nb) {
    const bf16_t* z = (const bf16_t*)(p.ws + OFF_Z); bf16_t* sg = (bf16_t*)(p.ws + OFF_SG);
    const float* mup = p.in[8] + 1792; const float* mun = p.in[9] + 1792;
    for (int i = bid * NTHREADS + my_tid(); i < T_ * 32; i += nb * NTHREADS) {
        const int t = i >> 5, c = (i & 31) * 8, s = t & (SEQ - 1);
        u32x4 o = {0u, 0u, 0u, 0u};
        if (c < 128) {
            const bf16_t* zp = z + (size_t)t * LDZ + ZR + 1792 + c;
            const u32x4 z4 = {0u, 0u, 0u, 0u};
            const u32x4 w0 = *(const u32x4*)zp, wm = (s > 0) ? *(const u32x4*)(zp - LDZ) : z4, wn = (s < SEQ - 1) ? *(const u32x4*)(zp + LDZ) : z4;
            const float z0[8] = {lo16(w0.x), hi16(w0.x), lo16(w0.y), hi16(w0.y), lo16(w0.z), hi16(w0.z), lo16(w0.w), hi16(w0.w)};
            const float zm[8] = {lo16(wm.x), hi16(wm.x), lo16(wm.y), hi16(wm.y), lo16(wm.z), hi16(wm.z), lo16(wm.w), hi16(wm.w)};
            const float zn[8] = {lo16(wn.x), hi16(wn.x), lo16(wn.y), hi16(wn.y), lo16(wn.z), hi16(wn.z), lo16(wn.w), hi16(wn.w)};
            float r[8];
#pragma unroll
            for (int j = 0; j < 8; ++j) r[j] = sigmoidf_(z0[j] + mup[c + j] * (zm[j] - z0[j]) + mun[c + j] * (zn[j] - z0[j]));
            o.x = pk2(r[0], r[1]); o.y = pk2(r[2], r[3]); o.z = pk2(r[4], r[5]); o.w = pk2(r[6], r[7]);
        }
        *(u32x4*)(sg + (size_t)t * 256 + c) = o;
    }
}

DEVI float max3f_(float a, float b, float c) { return __builtin_fmaxf(__builtin_fmaxf(a, b), c); }
constexpr int KROW = 208, VROW = 192;
constexpr int ATT_KB = 64 * KROW, ATT_VB = 64 * VROW;
struct TagF { static constexpr bool value = false; }; struct TagT { static constexpr bool value = true; };
DEVI void attn_units(const Params& p, char* lds, int bid, int nb) {
    const int tid = my_tid(), lane = tid & 63, wid = tid >> 6, r32 = lane & 31, hi = lane >> 5;
    const bf16_t* qraw = (const bf16_t*)((const char*)p.out + DOFF_QRAW);
    const bf16_t* kvraw = (const bf16_t*)((const char*)p.out + DOFF_KVRAW);
    const bf16_t* krope = (const bf16_t*)(p.ws + OFF_KROPE);
    const float* ct = (const float*)(p.ws + OFF_ROPE); const float* st = ct + SEQ * 16;
    bf16_t* omla = (bf16_t*)(p.ws + OFF_OMLA);
    const float QS = 0.10206207261596577f * 1.4426950408889634f;
    const int kp0r = tid / 12, kp0c = tid % 12;
    const int kp1 = 512 + tid, kp1r = kp1 / 12, kp1c = kp1 % 12;
    const int vr = tid >> 3, vc = tid & 7;
    u32x4 rk0, rk1, rv;
    u32x4 qw[6]; f32x4 rc[2], rs[2];
#define A_LOADG(rowb_, h_, t) do { const size_t base = (rowb_) + (size_t)(t) * 64; \
        rk0 = (kp0c < 8) ? *(const u32x4*)(kvraw + (base + kp0r) * 1024 + (h_) * 128 + 8 * kp0c) : *(const u32x4*)(krope + (base + kp0r) * 32 + 8 * (kp0c - 8)); \
        if (tid < 256) rk1 = (kp1c < 8) ? *(const u32x4*)(kvraw + (base + kp1r) * 1024 + (h_) * 128 + 8 * kp1c) : *(const u32x4*)(krope + (base + kp1r) * 32 + 8 * (kp1c - 8)); \
        rv = *(const u32x4*)(kvraw + (base + vr) * 1024 + (h_) * 128 + 64 + 8 * vc); } while (0)
#define A_STORE(buf) do { char* Kb_ = lds + (buf) * ATT_KB; char* Vb_ = lds + 2 * ATT_KB + (buf) * ATT_VB; \
        *(u32x4*)(Kb_ + kp0r * KROW + kp0c * 16) = rk0; if (tid < 256) *(u32x4*)(Kb_ + kp1r * KROW + kp1c * 16) = rk1; \
        *(u32x4*)(Vb_ + vr * VROW + vc * 16) = rv; } while (0)
#define U_PREFETCH(u_) do { const int bh_ = (u_) >> 3, qb_ = (u_) & 7, b_ = bh_ >> 3, h2_ = bh_ & 7; const size_t rb_ = (size_t)b_ * SEQ; const int sq_ = qb_ * 256 + wid * 32 + r32; \
        const bf16_t* qp_ = qraw + (rb_ + sq_) * 768 + h2_ * 96; \
        _Pragma("unroll") for (int ks = 0; ks < 6; ++ks) qw[ks] = *(const u32x4*)(qp_ + 16 * ks + 8 * hi); \
        rc[0] = *(const f32x4*)(ct + sq_ * 16 + 8 * hi); rc[1] = *(const f32x4*)(ct + sq_ * 16 + 8 * hi + 4); rs[0] = *(const f32x4*)(st + sq_ * 16 + 8 * hi); rs[1] = *(const f32x4*)(st + sq_ * 16 + 8 * hi + 4); \
        A_LOADG(rb_, h2_, 0); } while (0)
    if (bid < BATCH * NH * 8) U_PREFETCH(bid);
    for (int u = bid; u < BATCH * NH * 8; u += nb) {
        const int bh = u >> 3, qb = u & 7, b = bh >> 3, h = bh & 7;
        const size_t rowb = (size_t)b * SEQ;
        const int sq = qb * 256 + wid * 32 + r32;
        const int unext = u + nb;
        bf16x8 qf[6];
        {
#pragma unroll
            for (int ks = 0; ks < 4; ++ks) {
                u32x4 o; o.x = pk2(lo16(qw[ks].x) * QS, hi16(qw[ks].x) * QS); o.y = pk2(lo16(qw[ks].y) * QS, hi16(qw[ks].y) * QS);
                o.z = pk2(lo16(qw[ks].z) * QS, hi16(qw[ks].z) * QS); o.w = pk2(lo16(qw[ks].w) * QS, hi16(qw[ks].w) * QS);
                qf[ks] = __builtin_bit_cast(bf16x8, o);
            }
            float x1[8], x2[8], y1[8], y2[8];
            unpack8(qw[4], x1); unpack8(qw[5], x2);
            const float cv[8] = {rc[0].x, rc[0].y, rc[0].z, rc[0].w, rc[1].x, rc[1].y, rc[1].z, rc[1].w}, sv[8] = {rs[0].x, rs[0].y, rs[0].z, rs[0].w, rs[1].x, rs[1].y, rs[1].z, rs[1].w};
#pragma unroll
            for (int j = 0; j < 8; ++j) { y1[j] = (x1[j] * cv[j] - x2[j] * sv[j]) * QS; y2[j] = (x1[j] * sv[j] + x2[j] * cv[j]) * QS; }
            qf[4] = __builtin_bit_cast(bf16x8, pack8(y1)); qf[5] = __builtin_bit_cast(bf16x8, pack8(y2));
        }
        float mhat = 0.f, l = 0.f;
        f32x16 o0, o1, negm;
#pragma unroll
        for (int r = 0; r < 16; ++r) { o0[r] = 0.f; o1[r] = 0.f; negm[r] = 0.f; }
        A_STORE(0); __syncthreads();
        constexpr int NT = SEQ / 64;
        auto tile = [&](const int t, auto last_tag) {
            constexpr bool LAST = decltype(last_tag)::value;
            const int buf = t & 1;
            if constexpr (!LAST) A_LOADG(rowb, h, t + 1); else { if (unext < BATCH * NH * 8) U_PREFETCH(unext); }
            const char* Kb = lds + buf * ATT_KB; const char* Vb = lds + 2 * ATT_KB + buf * ATT_VB;
            f32x16 p0 = negm, p1 = negm;
#pragma unroll
            for (int ks = 0; ks < 6; ++ks) {
                const bf16x8 k0 = *(const bf16x8*)(Kb + r32 * KROW + 32 * ks + 16 * hi);
                const bf16x8 k1 = *(const bf16x8*)(Kb + (32 + r32) * KROW + 32 * ks + 16 * hi);
                p0 = __builtin_amdgcn_mfma_f32_32x32x16_bf16(k0, qf[ks], p0, 0, 0, 0);
                p1 = __builtin_amdgcn_mfma_f32_32x32x16_bf16(k1, qf[ks], p1, 0, 0, 0);
            }
            float mxa = max3f_(p0[0], p0[1], p1[0]), mxb = max3f_(p0[2], p0[3], p1[1]); mxa = max3f_(mxa, p1[2], p1[3]);
#pragma unroll
            for (int r = 4; r < 16; r += 4) { mxa = max3f_(mxa, p0[r], p0[r + 1]); mxb = max3f_(mxb, p0[r + 2], p0[r + 3]); mxa = max3f_(mxa, p1[r], p1[r + 1]); mxb = max3f_(mxb, p1[r + 2], p1[r + 3]); }
            float rm = max3f_(mxa, mxb, mxb); rm = max3f_(rm, __shfl_xor(rm, 32), rm);
            if (t == 0 || __any(rm > 8.f)) {
                const float dl = (t == 0) ? rm : fmaxf(rm, 0.f); mhat += dl;
                const float f = __builtin_amdgcn_exp2f(-dl); l *= f;
#pragma unroll
                for (int r = 0; r < 16; ++r) { p0[r] -= dl; p1[r] -= dl; o0[r] *= f; o1[r] *= f; negm[r] = -mhat; }
            }
            float sum = 0.f;
#pragma unroll
            for (int r = 0; r < 16; ++r) { p0[r] = __builtin_amdgcn_exp2f(p0[r]); p1[r] = __builtin_amdgcn_exp2f(p1[r]); sum += p0[r] + p1[r]; }
            l += sum;
            bf16x8 pb[4];
            {
                u32x4 w;
                w.x = pk2(p0[0], p0[1]); w.y = pk2(p0[2], p0[3]); w.z = pk2(p0[4], p0[5]); w.w = pk2(p0[6], p0[7]); pb[0] = __builtin_bit_cast(bf16x8, w);
                w.x = pk2(p0[8], p0[9]); w.y = pk2(p0[10], p0[11]); w.z = pk2(p0[12], p0[13]); w.w = pk2(p0[14], p0[15]); pb[1] = __builtin_bit_cast(bf16x8, w);
                w.x = pk2(p1[0], p1[1]); w.y = pk2(p1[2], p1[3]); w.z = pk2(p1[4], p1[5]); w.w = pk2(p1[6], p1[7]); pb[2] = __builtin_bit_cast(bf16x8, w);
                w.x = pk2(p1[8], p1[9]); w.y = pk2(p1[10], p1[11]); w.z = pk2(p1[12], p1[13]); w.w = pk2(p1[14], p1[15]); pb[3] = __builtin_bit_cast(bf16x8, w);
            }
#pragma unroll
            for (int s = 0; s < 4; ++s) {
                const char* vtp = Vb + (16 * s + 4 * hi + ((lane & 15) >> 2)) * VROW + (16 * ((lane >> 4) & 1) + 4 * (lane & 3)) * 2;
                const s16x4 a0 = vtr_(vtp), a1 = vtr_(vtp + 8 * VROW);
                const s16x4 c0 = vtr_(vtp + 64), c1 = vtr_(vtp + 8 * VROW + 64);
                const bf16x8 va0 = {a0[0], a0[1], a0[2], a0[3], a1[0], a1[1], a1[2], a1[3]};
                const bf16x8 va1 = {c0[0], c0[1], c0[2], c0[3], c1[0], c1[1], c1[2], c1[3]};
                o0 = __builtin_amdgcn_mfma_f32_32x32x16_bf16(va0, pb[s], o0, 0, 0, 0);
                o1 = __builtin_amdgcn_mfma_f32_32x32x16_bf16(va1, pb[s], o1, 0, 0, 0);
            }
            if constexpr (!LAST) { A_STORE(buf ^ 1); __syncthreads(); }
        };
        for (int t = 0; t < NT - 1; ++t) tile(t, TagF{});
        tile(NT - 1, TagT{});
        l += __shfl_xor(l, 32);
        const float inv = 1.f / l;
        bf16_t* op = omla + (rowb + sq) * 512 + h * 64;
#pragma unroll
        for (int g = 0; g < 4; ++g) {
            const int d0 = 8 * g + 4 * hi;
            u32x2 w; w.x = pk2(o0[4 * g] * inv, o0[4 * g + 1] * inv); w.y = pk2(o0[4 * g + 2] * inv, o0[4 * g + 3] * inv);
            *(u32x2*)(op + d0) = w;
            w.x = pk2(o1[4 * g] * inv, o1[4 * g + 1] * inv); w.y = pk2(o1[4 * g + 2] * inv, o1[4 * g + 3] * inv);
            *(u32x2*)(op + 32 + d0) = w;
        }
    }
#undef A_LOADG
#undef A_STORE
#undef U_PREFETCH
}

typedef _Float16 f16x4 __attribute__((ext_vector_type(4)));
typedef _Float16 f16x8 __attribute__((ext_vector_type(8)));
DEVI float dppx1(float x) { return __int_as_float(__builtin_amdgcn_update_dpp(0, __float_as_int(x), 0xB1, 0xF, 0xF, false)); }
DEVI float dppx2(float x) { return __int_as_float(__builtin_amdgcn_update_dpp(0, __float_as_int(x), 0x4E, 0xF, 0xF, false)); }
DEVI float dpphm(float x) { return __int_as_float(__builtin_amdgcn_update_dpp(0, __float_as_int(x), 0x141, 0xF, 0xF, false)); }
DEVI float red8(float x) { x += dppx1(x); x += dppx2(x); x += dpphm(x); return x; }
DEVI float fmix_lo(float a, unsigned h, float c) { float d; asm("v_fma_mix_f32 %0, %1, %2, %3 op_sel_hi:[0,1,0]" : "=v"(d) : "v"(a), "v"(h), "v"(c)); return d; }
DEVI float fmix_hi(float a, unsigned h, float c) { float d; asm("v_fma_mix_f32 %0, %1, %2, %3 op_sel:[0,1,0] op_sel_hi:[0,1,0]" : "=v"(d) : "v"(a), "v"(h), "v"(c)); return d; }
DEVI float mmix_lo(float a, unsigned h) { float d; asm("v_fma_mix_f32 %0, %1, %2, 0 op_sel_hi:[0,1,0]" : "=v"(d) : "v"(a), "v"(h)); return d; }
DEVI float mmix_hi(float a, unsigned h) { float d; asm("v_fma_mix_f32 %0, %1, %2, 0 op_sel:[0,1,0] op_sel_hi:[0,1,0]" : "=v"(d) : "v"(a), "v"(h)); return d; }
DEVI float fmix2_lo(unsigned v, unsigned h, float c) { float d; asm("v_fma_mix_f32 %0, %1, %2, %3 op_sel_hi:[1,1,0]" : "=v"(d) : "v"(v), "v"(h), "v"(c)); return d; }
DEVI float fmix2_hi(unsigned v, unsigned h, float c) { float d; asm("v_fma_mix_f32 %0, %1, %2, %3 op_sel:[0,1,0] op_sel_hi:[1,1,0]" : "=v"(d) : "v"(v), "v"(h), "v"(c)); return d; }
DEVI float fmix_h0(unsigned hv, float b, float c) { float d; asm("v_fma_mix_f32 %0, %1, %2, %3 op_sel_hi:[1,0,0]" : "=v"(d) : "v"(hv), "v"(b), "v"(c)); return d; }
DEVI u32x4 pack8h(const float (&f)[8]) { f16x8 h;
#pragma unroll
    for (int j = 0; j < 8; ++j) h[j] = (_Float16)f[j];
    return __builtin_bit_cast(u32x4, h); }
constexpr int SLOT = 9216;
constexpr int SL_AT = 0, SL_BT = 1, SL_KT = 2, SL_RT = 3, SL_VT = 4, SL_BH = 5, SL_KH = 6, SL_S0 = 7, SL_MOFF = 8, SL_MOFFT = 9, SL_MAK = 10, SL_LRB = 11, SL_LRK = 12;
constexpr int SL_DD = 1, SL_DDT = 2, SL_N = 10, SL_NT = 12, SL_N2 = 6, SL_W1T = 8, SL_W1 = 9, SL_T = 4, SL_RHST = 1, SL_UT = 2;
constexpr int L_G = 8 * SLOT;
constexpr int L_TW = 10 * SLOT, L_AD = 11 * SLOT;
constexpr int L_ATMP = 12 * SLOT;
constexpr int L_FD = 13 * SLOT;
constexpr int L_C = L_FD + 8 * 272 * 4;
constexpr int L_SEG = L_C + (896 + 320) * 4;
constexpr int L_CHAIN_END = L_SEG + 8 * 64 * 4;
static_assert(L_CHAIN_END <= 147200, "chain LDS");
DEVI f32x16 mm_tile(f32x16 acc, const char* Yt, const char* Xt, int jt, int it, int r32, int hi) {
    const char* yp = Yt + (32 * jt + r32) * 144 + 16 * hi; const char* xp = Xt + (32 * it + r32) * 144 + 16 * hi;
#pragma unroll
    for (int ks = 0; ks < 4; ++ks) acc = __builtin_amdgcn_mfma_f32_32x32x16_bf16(*(const bf16x8*)(xp + 32 * ks), *(const bf16x8*)(yp + 32 * ks), acc, 0, 0, 0);
    return acc;
}
DEVI bf16x8 frag_tr(const char* T, int col0, int ks, int lane, int hi) {
    const char* p = T + (16 * ks + 8 * hi + ((lane & 15) >> 2)) * 144 + (col0 + 16 * ((lane >> 4) & 1) + 4 * (lane & 3)) * 2;
    const s16x4 a = vtr_(p), b = vtr_(p + 4 * 144);
    return (bf16x8){a[0], a[1], a[2], a[3], b[0], b[1], b[2], b[3]};
}
template <bool YT, bool XT>
DEVI f32x16 mm_tile2(f32x16 acc, const char* Yt, const char* Xt, int jt, int it, int lane, int r32, int hi) {
#pragma unroll
    for (int ks = 0; ks < 4; ++ks) {
        const bf16x8 yf = YT ? frag_tr(Yt, 32 * jt, ks, lane, hi) : *(const bf16x8*)(Yt + (32 * jt + r32) * 144 + 16 * hi + 32 * ks);
        const bf16x8 xf = XT ? frag_tr(Xt, 32 * it, ks, lane, hi) : *(const bf16x8*)(Xt + (32 * it + r32) * 144 + 16 * hi + 32 * ks);
        acc = __builtin_amdgcn_mfma_f32_32x32x16_bf16(xf, yf, acc, 0, 0, 0);
    }
    return acc;
}
template <class M> DEVI void st_tile(char* Ot, int jt, int it, int r32, int hi, const f32x16& acc, M mask) {
    const int row = 32 * jt + r32;
#pragma unroll
    for (int g = 0; g < 4; ++g) { const int c0 = 32 * it + 8 * g + 4 * hi;
        u32x2 w; w.x = pk2(mask(row, c0) ? acc[4 * g] : 0.f, mask(row, c0 + 1) ? acc[4 * g + 1] : 0.f); w.y = pk2(mask(row, c0 + 2) ? acc[4 * g + 2] : 0.f, mask(row, c0 + 3) ? acc[4 * g + 3] : 0.f);
        *(u32x2*)(Ot + row * 144 + c0 * 2) = w; }
}
DEVI f32x16 zero16() { f32x16 z;
#pragma unroll
    for (int r = 0; r < 16; ++r) z[r] = 0.f;
    return z; }
DEVI void chain_unit(const Params& p, int unit, char* lds) {
    const int tid0 = my_tid(); const int tid = tid0;
    const int dir = unit & 1, bh = unit >> 1, b = bh >> 3, h = bh & 7;
    const bool fwd = (dir == 0);
    const bf16_t* z = (const bf16_t*)(p.ws + OFF_Z);
    bf16_t* yout = (bf16_t*)(p.ws + (dir ? OFF_YB : OFF_YF));
    bf16_t* vout = (bf16_t*)(p.ws + OFF_VS);
    float* sout = (float*)(p.ws + OFF_SDIR) + (size_t)dir * T_ * 8;
    const size_t rowb = (size_t)b * SEQ;
    float* Cc = (float*)(lds + L_C);
    for (int i = tid; i < 448; i += NTHREADS) {
        int gi;
        if (i < 192) gi = (i >> 6) * 512 + h * 64 + (i & 63); else if (i < 256) gi = 1536 + dir * 64 + (i - 192); else if (i < 320) gi = 1664 + dir * 64 + (i - 256); else gi = 1792 + (i - 320);
        Cc[i] = p.in[8][gi]; Cc[448 + i] = p.in[9][gi];
    }
    if (tid < 64) { const int c = h * 64 + tid; Cc[896 + tid] = p.in[15][c]; Cc[960 + tid] = p.in[16][c]; Cc[1024 + tid] = p.in[17][c]; Cc[1088 + tid] = p.in[10][dir * 512 + c]; Cc[1152 + tid] = p.in[12][dir * 512 + c]; }
    for (int i = tid; i < SLOT / 16; i += NTHREADS) ((u32x4*)(lds + SL_S0 * SLOT))[i] = (u32x4){0u, 0u, 0u, 0u};
    bf16x8 wf[4];
    {
        const int lane = tid & 63, wid = __builtin_amdgcn_readfirstlane(tid >> 6), r32 = lane & 31, hi = lane >> 5, nt = (wid >> 1) & 1;
        const bf16_t* wsrc = (const bf16_t*)(p.ws + (wid < 4 ? OFF_WUP : OFF_AUP)) + ((size_t)dir * 512 + h * 64 + 32 * nt + r32) * 64 + 8 * hi;
#pragma unroll
        for (int ks = 0; ks < 4; ++ks) wf[ks] = *(const bf16x8*)(wsrc + 16 * ks);
    }
    u32x4 zl[5][3];
#define C_LOAD(c) do { const int t0_ = dir ? (SEQ - 64 * ((c) + 1)) : 64 * (c); const int ts_ = t0_ + tt; const bf16_t* zp_ = z + (rowb + ts_) * LDZ + ZR; \
        const bool hp_ = ts_ > 0, hn_ = ts_ < SEQ - 1; const u32x4 z4_ = {0u, 0u, 0u, 0u}; \
        _Pragma("unroll") for (int sg = 0; sg < 5; ++sg) { const int co_ = (sg < 3) ? (sg * 512 + h * 64 + 8 * c8) : (sg == 3 ? 1536 + dir * 64 + 8 * c8 : 1664 + dir * 64 + 8 * c8); \
            zl[sg][1] = *(const u32x4*)(zp_ + co_); zl[sg][0] = hp_ ? *(const u32x4*)(zp_ + co_ - LDZ) : z4_; zl[sg][2] = hn_ ? *(const u32x4*)(zp_ + co_ + LDZ) : z4_; } \
        } while (0)
#define SHIFT8(dst, regs, mi) do { float z0_[8], zm_[8], zn_[8]; unpack8(regs[1], z0_); unpack8(regs[0], zm_); unpack8(regs[2], zn_); \
        const f32x4 mpa_ = *(const f32x4*)(Cc + (mi)), mpb_ = *(const f32x4*)(Cc + (mi) + 4), mna_ = *(const f32x4*)(Cc + 448 + (mi)), mnb_ = *(const f32x4*)(Cc + 448 + (mi) + 4); \
        const float mp_[8] = {mpa_.x, mpa_.y, mpa_.z, mpa_.w, mpb_.x, mpb_.y, mpb_.z, mpb_.w}, mn_[8] = {mna_.x, mna_.y, mna_.z, mna_.w, mnb_.x, mnb_.y, mnb_.z, mnb_.w}; \
        _Pragma("unroll") for (int j = 0; j < 8; ++j) dst[j] = z0_[j] + mp_[j] * (zm_[j] - z0_[j]) + mn_[j] * (zn_[j] - z0_[j]); } while (0)
    f32x16 state = zero16();
    __syncthreads();
    { const int tt = tid >> 3, c8 = tid & 7; C_LOAD(0); }
    for (int c = 0; c < SEQ / 64; ++c) {
        int tid = tid0; asm volatile("" : "+v"(tid));
        const int lane = tid & 63, wid = __builtin_amdgcn_readfirstlane(tid >> 6), r32 = lane & 31, hi = lane >> 5;
        const int nt = (wid >> 1) & 1, tt2 = wid & 1, pj = nt, pi = tt2;
        const int tt = tid >> 3, c8 = tid & 7;
        const int sp = dir ? 63 - tt : tt;
        const int t0 = dir ? (SEQ - 64 * (c + 1)) : 64 * c;
        float r8[8], k8[8], v8[8], kk8[8];
        {
            float wd8[8], ad8[8];
            SHIFT8(r8, zl[0], 8 * c8); SHIFT8(k8, zl[1], 64 + 8 * c8); SHIFT8(v8, zl[2], 128 + 8 * c8); SHIFT8(wd8, zl[3], 192 + 8 * c8); SHIFT8(ad8, zl[4], 256 + 8 * c8);
#pragma unroll
            for (int j = 0; j < 8; ++j) wd8[j] = 1.f - 2.f * __builtin_amdgcn_rcpf(1.f + __expf(2.f * wd8[j]));
            *(u32x4*)(lds + L_TW + tt * 144 + c8 * 16) = pack8(wd8);
            *(u32x4*)(lds + L_AD + tt * 144 + c8 * 16) = pack8(ad8);
            float ss = 0.f;
#pragma unroll
            for (int j = 0; j < 8; ++j) { kk8[j] = k8[j] * Cc[896 + 8 * c8 + j]; ss += kk8[j] * kk8[j]; }
            ss = red8(ss);
            const float inv = 1.f / fmaxf(sqrtf(ss), 1e-12f);
#pragma unroll
            for (int j = 0; j < 8; ++j) kk8[j] *= inv;
        }
        __syncthreads();
        {
            f32x16 acc = zero16();
            const char* xt = lds + (wid < 4 ? L_TW : L_AD) + (32 * tt2 + r32) * 144 + 16 * hi;
#pragma unroll
            for (int ks = 0; ks < 4; ++ks) acc = __builtin_amdgcn_mfma_f32_32x32x16_bf16(wf[ks], *(const bf16x8*)(xt + 32 * ks), acc, 0, 0, 0);
            const int tl = 32 * tt2 + r32;
            if (wid < 4) {
                const int sl = dir ? 63 - tl : tl;
#pragma unroll
                for (int g = 0; g < 4; ++g) { const int n0 = 32 * nt + 8 * g + 4 * hi; f32x4 o;
#pragma unroll
                    for (int q = 0; q < 4; ++q) o[q] = -0.6065306597126334f * sigmoidf_(acc[4 * g + q] + Cc[1088 + n0 + q]);
                    *(f32x4*)(lds + L_G + sl * 256 + n0 * 4) = o; }
            } else {
#pragma unroll
                for (int g = 0; g < 4; ++g) { const int n0 = 32 * nt + 8 * g + 4 * hi; f16x4 o;
#pragma unroll
                    for (int q = 0; q < 4; ++q) o[q] = (_Float16)sigmoidf_(acc[4 * g + q] + Cc[1152 + n0 + q]);
                    *(f16x4*)(lds + L_ATMP + tl * 128 + n0 * 2) = o; }
            }
        }
        __syncthreads();
        float kd8[8], b8[8];
        {
            const f16x8 ah = *(const f16x8*)(lds + L_ATMP + tt * 128 + c8 * 16);
            float sp_ = 0.f;
#pragma unroll
            for (int j = 0; j < 8; ++j) { const float a = (float)ah[j];
                kd8[j] = k8[j] * (1.f + (a - 1.f) * Cc[960 + 8 * c8 + j]); b8[j] = kk8[j] * a; sp_ += r8[j] * kd8[j] * Cc[1024 + 8 * c8 + j]; }
            sp_ = red8(sp_);
            if (c8 == 0) sout[(rowb + t0 + tt) * 8 + h] = sp_;
            if (fwd) *(u32x4*)(vout + (rowb + t0 + tt) * 512 + h * 64 + 8 * c8) = pack8(v8);
            const int n = tid & 63, seg = tid >> 6; float* gp = (float*)(lds + L_G) + (8 * seg) * 64 + n; float run = 0.f;
#pragma unroll
            for (int q = 0; q < 8; ++q) { run += gp[q * 64]; gp[q * 64] = run; }
            ((float*)(lds + L_SEG))[seg * 64 + n] = run;
        }
        __syncthreads();
        {
            const int n = tid & 63, seg = tid >> 6; float off = 0.f;
            for (int q = 0; q < seg; ++q) off += ((const float*)(lds + L_SEG))[q * 64 + n];
            float* gp = (float*)(lds + L_G) + (8 * seg) * 64 + n;
#pragma unroll
            for (int q = 0; q < 8; ++q) gp[q * 64] += off;
        }
        __syncthreads();
        {
            const float* G = (const float*)(lds + L_G);
            const f32x4 ga = *(const f32x4*)(G + sp * 64 + 8 * c8), gb = *(const f32x4*)(G + sp * 64 + 8 * c8 + 4);
            const f32x4 ha = *(const f32x4*)(G + 63 * 64 + 8 * c8), hb = *(const f32x4*)(G + 63 * 64 + 8 * c8 + 4);
            f32x4 pa = {0.f, 0.f, 0.f, 0.f}, pb = pa;
            if (sp > 0) { pa = *(const f32x4*)(G + (sp - 1) * 64 + 8 * c8); pb = *(const f32x4*)(G + (sp - 1) * 64 + 8 * c8 + 4); }
            const float gs[8] = {ga.x, ga.y, ga.z, ga.w, gb.x, gb.y, gb.z, gb.w}, gm[8] = {pa.x, pa.y, pa.z, pa.w, pb.x, pb.y, pb.z, pb.w}, gl[8] = {ha.x, ha.y, ha.z, ha.w, hb.x, hb.y, hb.z, hb.w};
            {
                float at_[8], rt_[8];
#pragma unroll
                for (int j = 0; j < 8; ++j) { at_[j] = -kk8[j] * __expf(gm[j]); rt_[j] = r8[j] * __expf(gs[j]); }
                *(u32x4*)(lds + SL_AT * SLOT + sp * 144 + c8 * 16) = pack8(at_); *(u32x4*)(lds + SL_RT * SLOT + sp * 144 + c8 * 16) = pack8(rt_);
            }
            {
                float bt_[8], kt_[8];
#pragma unroll
                for (int j = 0; j < 8; ++j) { const float en = __expf(-gs[j]); bt_[j] = b8[j] * en; kt_[j] = kd8[j] * en; }
                *(u32x4*)(lds + SL_BT * SLOT + sp * 144 + c8 * 16) = pack8(bt_); *(u32x4*)(lds + SL_KT * SLOT + sp * 144 + c8 * 16) = pack8(kt_);
            }
            {
                float bh_[8], kh_[8];
#pragma unroll
                for (int j = 0; j < 8; ++j) { const float eh = __expf(gl[j] - gs[j]); bh_[j] = b8[j] * eh; kh_[j] = kd8[j] * eh; }
                *(u32x4*)(lds + SL_VT * SLOT + sp * 144 + c8 * 16) = pack8(v8);
                *(u32x4*)(lds + SL_BH * SLOT + sp * 144 + c8 * 16) = pack8(bh_); *(u32x4*)(lds + SL_KH * SLOT + sp * 144 + c8 * 16) = pack8(kh_);
            }
            if (tid < 64) ((float*)(lds + L_SEG))[tid] = __expf(G[63 * 64 + tid]);
        }
        __syncthreads();
        {
            const char* ATt = lds + SL_AT * SLOT; const char* RTt = lds + SL_RT * SLOT;
            f32x16 acc = mm_tile(zero16(), ATt, lds + (wid < 4 ? SL_BT : SL_KT) * SLOT, pj, pi, r32, hi);
            f32x16 acc2 = mm_tile(zero16(), RTt, lds + (wid < 4 ? SL_BT : SL_KT) * SLOT, pj, pi, r32, hi);
            const int row = 32 * pj + r32;
            if (wid < 4) {
                st_tile(lds + SL_MOFF * SLOT, pj, pi, r32, hi, acc, [](int s, int i) { return (s >> 4) > (i >> 4); });
#pragma unroll
                for (int g = 0; g < 4; ++g)
#pragma unroll
                    for (int q = 0; q < 4; ++q) { const int i = 32 * pi + 8 * g + 4 * hi + q; const float vv = acc[4 * g + q];
                        if ((row >> 4) == (i >> 4)) ((float*)(lds + L_FD))[(4 + (row >> 4)) * 272 + (i & 15) * 16 + (row & 15)] = (i < row) ? vv : 0.f; }
                st_tile(lds + SL_LRB * SLOT, pj, pi, r32, hi, acc2, [](int s, int i) { return i <= s; });
            } else {
                st_tile(lds + SL_MAK * SLOT, pj, pi, r32, hi, acc, [](int s, int i) { return i < s; });
                st_tile(lds + SL_LRK * SLOT, pj, pi, r32, hi, acc2, [](int s, int i) { return i <= s; });
            }
        }
        __syncthreads();
        if (c + 1 < SEQ / 64) C_LOAD(c + 1);
        if (wid == 0) {
            const int d = lane >> 4, j = lane & 15; const float* MdT = (const float*)(lds + L_FD) + (4 + d) * 272;
            float x[16];
#pragma unroll
            for (int q = 15; q >= 0; --q) { float acc = (q == j) ? 1.f : 0.f;
                const f32x4 m0 = *(const f32x4*)(MdT + q * 16), m1 = *(const f32x4*)(MdT + q * 16 + 4), m2 = *(const f32x4*)(MdT + q * 16 + 8), m3 = *(const f32x4*)(MdT + q * 16 + 12);
                const float mr[16] = {m0.x, m0.y, m0.z, m0.w, m1.x, m1.y, m1.z, m1.w, m2.x, m2.y, m2.z, m2.w, m3.x, m3.y, m3.z, m3.w};
#pragma unroll
                for (int s = 0; s < 16; ++s) if (s > q) acc = fmaf(x[s], mr[s], acc);
                x[q] = acc; asm volatile("" ::: "memory"); }
            char* rowp = lds + SL_DD * SLOT + (16 * d + j) * 144;
            const u32x4 z4 = {0u, 0u, 0u, 0u};
#pragma unroll
            for (int q = 0; q < 8; ++q) *(u32x4*)(rowp + 16 * q) = z4;
            u32x4 w0, w1; w0.x = pk2(x[0], x[1]); w0.y = pk2(x[2], x[3]); w0.z = pk2(x[4], x[5]); w0.w = pk2(x[6], x[7]); w1.x = pk2(x[8], x[9]); w1.y = pk2(x[10], x[11]); w1.z = pk2(x[12], x[13]); w1.w = pk2(x[14], x[15]);
            asm volatile("s_waitcnt lgkmcnt(0)" ::: "memory");
            *(u32x4*)(rowp + 32 * d) = w0; *(u32x4*)(rowp + 32 * d + 16) = w1;
        }
        f32x16 locA = zero16(), locB = zero16();
        if (wid < 4) { locA = mm_tile2<true, false>(locA, lds + SL_VT * SLOT, lds + SL_MAK * SLOT, pj, pi, lane, r32, hi); locB = mm_tile2<true, true>(locB, lds + SL_VT * SLOT, lds + SL_KH * SLOT, pj, pi, lane, r32, hi); }
        else locA = mm_tile2<false, true>(locA, lds + SL_LRK * SLOT, lds + SL_VT * SLOT, pj, pi, lane, r32, hi);
        __syncthreads();
        if (wid < 4) {
            f32x16 acc = mm_tile2<false, true>(zero16(), lds + SL_DD * SLOT, lds + SL_MOFF * SLOT, pj, pi, lane, r32, hi);
            st_tile(lds + SL_N * SLOT, pj, pi, r32, hi, acc, [](int, int) { return true; });
        }
        __syncthreads();
        {
            f32x16 acc = zero16();
            if (wid >= 4) { const int row = 32 * pj + r32; const char* addt = lds + SL_DD * SLOT;
#pragma unroll
                for (int g = 0; g < 4; ++g) { const u32x2 w = *(const u32x2*)(addt + row * 144 + (32 * pi + 8 * g + 4 * hi) * 2); acc[4 * g] = lo16(w.x); acc[4 * g + 1] = hi16(w.x); acc[4 * g + 2] = lo16(w.y); acc[4 * g + 3] = hi16(w.y); } }
            acc = (wid < 4) ? mm_tile2<false, true>(acc, lds + SL_N * SLOT, lds + SL_N * SLOT, pj, pi, lane, r32, hi) : mm_tile2<false, true>(acc, lds + SL_N * SLOT, lds + SL_DD * SLOT, pj, pi, lane, r32, hi);
            st_tile(lds + (wid < 4 ? SL_N2 : SL_W1) * SLOT, pj, pi, r32, hi, acc, [](int, int) { return true; });
        }
        __syncthreads();
        if (wid < 4) {
            f32x16 acc;
            { const int row = 32 * pj + r32; const char* addt = lds + SL_W1 * SLOT;
#pragma unroll
              for (int g = 0; g < 4; ++g) { const u32x2 w = *(const u32x2*)(addt + row * 144 + (32 * pi + 8 * g + 4 * hi) * 2); acc[4 * g] = lo16(w.x); acc[4 * g + 1] = hi16(w.x); acc[4 * g + 2] = lo16(w.y); acc[4 * g + 3] = hi16(w.y); } }
            acc = mm_tile2<false, true>(acc, lds + SL_N2 * SLOT, lds + SL_W1 * SLOT, pj, pi, lane, r32, hi);
            st_tile(lds + SL_T * SLOT, pj, pi, r32, hi, acc, [](int, int) { return true; });
        } else {
            locA = mm_tile(locA, lds + SL_RT * SLOT, lds + SL_S0 * SLOT, pj, pi, r32, hi);
        }
        if (wid < 4) {
            locA = mm_tile(locA, lds + SL_S0 * SLOT, lds + SL_AT * SLOT, pj, pi, r32, hi);
            st_tile(lds + SL_RHST * SLOT, pj, pi, r32, hi, locA, [](int, int) { return true; });
        }
        __syncthreads();
        if (wid < 4) {
            f32x16 acc = mm_tile(zero16(), lds + SL_RHST * SLOT, lds + SL_T * SLOT, pj, pi, r32, hi);
            st_tile(lds + SL_UT * SLOT, pj, pi, r32, hi, acc, [](int, int) { return true; });
        }
        __syncthreads();
        if (wid < 4) {
            const float* gam = (const float*)(lds + L_SEG);
#pragma unroll
            for (int g = 0; g < 4; ++g) { const f32x4 gq = *(const f32x4*)(gam + 32 * pi + 8 * g + 4 * hi);
                state[4 * g] = state[4 * g] * gq.x + locB[4 * g]; state[4 * g + 1] = state[4 * g + 1] * gq.y + locB[4 * g + 1]; state[4 * g + 2] = state[4 * g + 2] * gq.z + locB[4 * g + 2]; state[4 * g + 3] = state[4 * g + 3] * gq.w + locB[4 * g + 3]; }
            state = mm_tile2<false, true>(state, lds + SL_UT * SLOT, lds + SL_BH * SLOT, pj, pi, lane, r32, hi);
            st_tile(lds + SL_S0 * SLOT, pj, pi, r32, hi, state, [](int, int) { return true; });
        } else {
            locA = mm_tile(locA, lds + SL_LRB * SLOT, lds + SL_UT * SLOT, pj, pi, r32, hi);
            const int s = 32 * pj + r32; const int tn = t0 + (dir ? 63 - s : s);
            bf16_t* yp = yout + (rowb + tn) * 512 + h * 64 + 32 * pi;
#pragma unroll
            for (int g = 0; g < 4; ++g) { u32x2 w; w.x = pk2(locA[4 * g], locA[4 * g + 1]); w.y = pk2(locA[4 * g + 2], locA[4 * g + 3]); *(u32x2*)(yp + 8 * g + 4 * hi) = w; }
        }
        __syncthreads();
    }
#undef C_LOAD
#undef SHIFT8
}

DEVI void stage_rwkv_post(const Params& p, int bid, int nb) {
    const bf16_t* yf = (const bf16_t*)(p.ws + OFF_YF); const bf16_t* yb = (const bf16_t*)(p.ws + OFF_YB);
    const bf16_t* g = (const bf16_t*)(p.ws + OFF_G); const bf16_t* vs = (const bf16_t*)(p.ws + OFF_VS);
    const float* sf = (const float*)(p.ws + OFF_SDIR); const float* sb = sf + (size_t)T_ * 8;
    bf16_t* orw = (bf16_t*)(p.ws + OFF_YF);
    for (int i = bid * NTHREADS + my_tid(); i < T_ * 64; i += nb * NTHREADS) {
        const int c8 = i & 7, th = i >> 3, c = (th & 7) * 64 + 8 * c8;
        const size_t o = (size_t)(th >> 3) * 512 + c;
        float a[8], b[8], y[8], gv[8], vv[8];
        unpack8(*(const u32x4*)(yf + o), a); unpack8(*(const u32x4*)(yb + o), b); unpack8(*(const u32x4*)(g + o), gv); unpack8(*(const u32x4*)(vs + o), vv);
        float s = 0.f;
#pragma unroll
        for (int j = 0; j < 8; ++j) { y[j] = a[j] + b[j]; s += y[j]; }
        const float mu = red8(s) * (1.f / 64.f);
        float q = 0.f;
#pragma unroll
        for (int j = 0; j < 8; ++j) { y[j] -= mu; q += y[j] * y[j]; }
        const float rstd = rsqrtf(red8(q) * (1.f / 64.f) + 64e-5f);
        const float bs = sf[th] + sb[th];
        const f32x4 lga = *(const f32x4*)(p.in[18] + c), lgb = *(const f32x4*)(p.in[18] + c + 4), lba = *(const f32x4*)(p.in[19] + c), lbb = *(const f32x4*)(p.in[19] + c + 4);
        const float lg[8] = {lga.x, lga.y, lga.z, lga.w, lgb.x, lgb.y, lgb.z, lgb.w}, lb[8] = {lba.x, lba.y, lba.z, lba.w, lbb.x, lbb.y, lbb.z, lbb.w};
        float r[8];
#pragma unroll
        for (int j = 0; j < 8; ++j) r[j] = (y[j] * rstd * lg[j] + lb[j] + bs * vv[j]) * gv[j];
        *(u32x4*)(orw + o) = pack8(r);
    }
}

typedef float f32x2v __attribute__((ext_vector_type(2)));
DEVI void stage_route(const Params& p, char* lds, int bid, int nb, bool do_count = true) {
    const int tid = my_tid(), lane = tid & 63, wave = tid >> 6;
    const bf16_t* x1 = (const bf16_t*)(p.ws + OFF_X1); bf16_t* h2 = (bf16_t*)((char*)p.out + DOFF_H2);
    int* toke = (int*)(p.ws + OFF_TOKE); float* tokw = (float*)(p.ws + OFF_TOKW); int* tokr = (int*)(p.ws + OFF_TOKR);
    int* cntwg = (int*)(p.ws + OFF_CNTWG);
    const bf16_t* wrt = (const bf16_t*)(p.ws + OFF_WRT);
    const float* g2 = p.in[23];
    int* hist = (int*)lds;
    float* bs = (float*)(lds + 128);
    float* lgs = (float*)(lds + 512) + wave * (16 * 48);
    float* g2s = (float*)(lds + 25088);
    constexpr int WB0 = 29184, WBSZ = 96 * 528;
    if (bid == 0 && do_count) { u32x4* zr = (u32x4*)(h2 + (size_t)T_ * DM); if (tid < 128) zr[tid] = (u32x4){0u, 0u, 0u, 0u}; }
    g2s[tid] = g2[tid]; g2s[tid + 512] = g2[tid + 512];
    if (tid < 4) bs[tid] = p.in[25][tid]; else if (tid < 36) bs[tid] = p.in[27][tid - 4];
    for (int b = bid; b < T_ / 128; b += nb) {
        if (tid < 32) hist[tid] = 0;
        const int t0 = b * 128 + wave * 16;
        const int li = lane & 15, kq = lane >> 4;
        const bf16_t* xrow = x1 + (size_t)(t0 + li) * DM + 8 * kq;
        u32x4 xr[32];
#pragma unroll
        for (int ks = 0; ks < 32; ++ks) xr[ks] = *(const u32x4*)(xrow + 32 * ks);
        unsigned gvoff = (unsigned)((tid >> 5) * 2048 + (tid & 31) * 16); asm volatile("" : "+v"(gvoff));
        unsigned svoff = (unsigned)((tid >> 5) * 528 + (tid & 31) * 16); asm volatile("" : "+v"(svoff));
        unsigned fvoff = (unsigned)(li * 528 + kq * 16); asm volatile("" : "+v"(fvoff));
        const char* wbase = (const char*)wrt;
        u32x4 st[6];
#pragma unroll
        for (int i = 0; i < 6; ++i) st[i] = *(const u32x4*)(wbase + (size_t)(i * 16 * 2048) + gvoff);
#pragma unroll
        for (int i = 0; i < 6; ++i) *(u32x4*)(lds + WB0 + i * 16 * 528 + svoff) = st[i];
        __syncthreads();
        f32x4 acc0 = {0.f, 0.f, 0.f, 0.f}, acc1 = acc0, acc2 = acc0;
        float ss = 0.f;
#pragma unroll
        for (int c = 0; c < 4; ++c) {
            if (c < 3) {
#pragma unroll
                for (int i = 0; i < 6; ++i) st[i] = *(const u32x4*)(wbase + (size_t)(i * 16 * 2048 + (c + 1) * 512) + gvoff);
            }
            const char* wl = lds + WB0 + (c & 1) * WBSZ + fvoff;
#pragma unroll
            for (int ksl = 0; ksl < 8; ++ksl) {
                const int ks = 8 * c + ksl;
                bf16x8 wf[6];
#pragma unroll
                for (int ob = 0; ob < 3; ++ob) { wf[2 * ob] = *(const bf16x8*)(wl + (ob * 16) * 528 + ksl * 64); wf[2 * ob + 1] = *(const bf16x8*)(wl + (48 + ob * 16) * 528 + ksl * 64); }
                float xv[8]; unpack8(xr[ks], xv);
#pragma unroll
                for (int j = 0; j < 8; ++j) ss += xv[j] * xv[j];
                const bf16x8 ax = __builtin_bit_cast(bf16x8, xr[ks]);
                acc0 = __builtin_amdgcn_mfma_f32_16x16x32_bf16(ax, wf[0], acc0, 0, 0, 0);
                acc1 = __builtin_amdgcn_mfma_f32_16x16x32_bf16(ax, wf[2], acc1, 0, 0, 0);
                acc2 = __builtin_amdgcn_mfma_f32_16x16x32_bf16(ax, wf[4], acc2, 0, 0, 0);
                acc0 = __builtin_amdgcn_mfma_f32_16x16x32_bf16(ax, wf[1], acc0, 0, 0, 0);
                acc1 = __builtin_amdgcn_mfma_f32_16x16x32_bf16(ax, wf[3], acc1, 0, 0, 0);
                acc2 = __builtin_amdgcn_mfma_f32_16x16x32_bf16(ax, wf[5], acc2, 0, 0, 0);
            }
            if (c < 3) {
#pragma unroll
                for (int i = 0; i < 6; ++i) *(u32x4*)(lds + WB0 + ((c + 1) & 1) * WBSZ + i * 16 * 528 + svoff) = st[i];
                __syncthreads();
            }
        }
        ss += __shfl_xor(ss, 16); ss += __shfl_xor(ss, 32);
        const float my_rstd = rsqrtf(ss * (1.f / DM) + 1e-6f);
        {
            bf16_t* orow = h2 + (size_t)(t0 + li) * DM + 8 * kq;
#pragma unroll
            for (int ks = 0; ks < 32; ++ks) {
                if ((ks & 3) == 0) asm volatile("" ::: "memory");
                u32x4 xw = xr[ks]; asm volatile("" : "+v"(xw));
                float xv[8]; unpack8(xw, xv);
                const f32x4 ga = *(const f32x4*)(g2s + 32 * ks + 8 * kq), gb = *(const f32x4*)(g2s + 32 * ks + 8 * kq + 4);
                const float gq[8] = {ga.x, ga.y, ga.z, ga.w, gb.x, gb.y, gb.z, gb.w};
                float o[8];
#pragma unroll
                for (int j = 0; j < 8; ++j) o[j] = xv[j] * my_rstd * gq[j];
                *(u32x4*)(orow + 32 * ks) = pack8(o);
            }
        }
#pragma unroll
        for (int r = 0; r < 4; ++r) { const float rs = __shfl(my_rstd, 4 * kq + r); acc0[r] *= rs; acc1[r] *= rs; acc2[r] *= rs; }
#pragma unroll
        for (int r = 0; r < 4; ++r) { float* lr = lgs + (4 * kq + r) * 48 + li; lr[0] = acc0[r]; lr[16] = acc1[r]; lr[32] = acc2[r]; }
        asm volatile("s_waitcnt lgkmcnt(0)" ::: "memory");
        if (lane < 16) {
            const float* lg = lgs + lane * 48; const int t = t0 + lane;
            float gl[4];
#pragma unroll
            for (int j = 0; j < 4; ++j) gl[j] = lg[j] + bs[j];
            int gi = 0; float gm = gl[0];
#pragma unroll
            for (int j = 1; j < 4; ++j) if (gl[j] > gm) { gm = gl[j]; gi = j; }
            float gs = 0.f;
#pragma unroll
            for (int j = 0; j < 4; ++j) gs += __expf(gl[j] - gm);
            const float gp = 1.f / gs;
            float el[8];
#pragma unroll
            for (int j = 0; j < 8; ++j) el[j] = lg[4 + gi * 8 + j] + bs[4 + gi * 8 + j];
            int i1 = 0; float m1 = el[0];
#pragma unroll
            for (int j = 1; j < 8; ++j) if (el[j] > m1) { m1 = el[j]; i1 = j; }
            int i2 = -1; float m2 = -INFINITY;
#pragma unroll
            for (int j = 0; j < 8; ++j) if (j != i1 && el[j] > m2) { m2 = el[j]; i2 = j; }
            const float e2 = __expf(m2 - m1), tp1 = 1.f / (1.f + e2), tp2 = e2 / (1.f + e2);
            const int e1i = gi * 8 + i1, e2i = gi * 8 + i2;
            toke[2 * t] = e1i; toke[2 * t + 1] = e2i; tokw[2 * t] = gp * tp1; tokw[2 * t + 1] = gp * tp2;
            if (do_count) { tokr[2 * t] = atomicAdd(hist + e1i, 1); tokr[2 * t + 1] = atomicAdd(hist + e2i, 1); }
        }
        __syncthreads();
        if (do_count && tid < 32) cntwg[b * 32 + tid] = hist[tid];
        __syncthreads();
    }
}
DEVI void stage_scatter(const Params& p, char* lds, int bid, int nb, bool dry = false) {
    const int tid = my_tid(), lane = tid & 63, wave = tid >> 6;
    const int gw = bid * NWAVES + wave, NGW = nb * NWAVES;
    int* ctl = (int*)(p.ws + OFF_CTL); const int* toke = (const int*)(p.ws + OFF_TOKE); const int* tokr = (const int*)(p.ws + OFF_TOKR); int* toks = (int*)(p.ws + OFF_TOKS);
    const int* cntwg = (const int*)(p.ws + OFF_CNTWG);
    int* slottok = (int*)(p.ws + OFF_SLOTTOK);
    int* part = (int*)lds;
    int* tot = part + 512;
    int* cnts = tot + 32;
    int* bases = cnts + 32;
    constexpr int NB = T_ / 128;
    {
        const int e = tid & 31, q = tid >> 5;
        int s = 0;
        for (int w = 16 * q; w < 16 * q + 16; ++w) s += cntwg[w * 32 + e];
        part[q * 32 + e] = s;
    }
    __syncthreads();
    if (tid == 0) {
        int run = 0;
        for (int e = 0; e < NEXP; ++e) {
            int c = 0; for (int q = 0; q < 16; ++q) c += part[q * 32 + e];
            cnts[e] = c; tot[e] = run;
            const int pad = (c + 255) / 256 * 256;
            if (bid == 0) for (int bq = run / 256; bq < (run + pad) / 256; ++bq) ctl[C_BLKE + bq] = e;
            run += pad;
        }
        if (bid == 0) { for (int bq = run / 256; bq < NBLK; ++bq) ctl[C_BLKE + bq] = -1; ctl[C_NBLK] = run / 256; }
    }
    __syncthreads();
    for (int b = bid; b < NB; b += nb) {
        if (tid < 32) { int s = tot[tid]; for (int q = 0; q < (b >> 4); ++q) s += part[q * 32 + tid]; for (int w = b & ~15; w < b; ++w) s += cntwg[w * 32 + tid]; bases[tid] = s; }
        __syncthreads();
        if (tid < 256) { const int a = b * 256 + tid; const int slot = bases[toke[a]] + tokr[a]; if (!dry) { toks[a] = slot; slottok[slot] = a >> 1; } else asm volatile("" :: "v"(slot)); }
        __syncthreads();
    }
    {
        const int e = gw & 31; const int c = cnts[e], pad = (c + 255) / 256 * 256;
        for (int s = tot[e] + c + (gw >> 5) * 64 + lane; s < tot[e] + pad; s += (NGW >> 5) * 64) slottok[s] = T_;
    }
    __syncthreads();
}
DEVI void stage_final(const Params& p, int bid, int nb, bool dry = false) {
    const int lane = my_tid() & 63, wave = my_tid() >> 6;
    const int gw = bid * NWAVES + wave, NGW = nb * NWAVES;
    const bf16_t* ye = (const bf16_t*)(p.ws + OFF_YE); const int* toks = (const int*)(p.ws + OFF_TOKS); const float* tokw = (const float*)(p.ws + OFF_TOKW);
    const bf16_t* x1 = (const bf16_t*)(p.ws + OFF_X1);
    const float* gf = p.in[31];
    f32x4 gv[4];
#pragma unroll
    for (int j = 0; j < 4; ++j) gv[j] = *(const f32x4*)(gf + 4 * lane + 256 * j);
    for (int tb = gw * 2; tb < T_; tb += NGW * 2) {
        u32x2 xa[2][4], ya[2][4], yb[2][4]; float w0[2], w1[2];
#pragma unroll
        for (int q = 0; q < 2; ++q) { const int t = tb + q; const int s0 = toks[2 * t], s1 = toks[2 * t + 1]; w0[q] = tokw[2 * t]; w1[q] = tokw[2 * t + 1];
            const u32x2* xr = (const u32x2*)(x1 + (size_t)t * DM) + lane; const u32x2* y0 = (const u32x2*)(ye + (size_t)s0 * DM) + lane; const u32x2* y1 = (const u32x2*)(ye + (size_t)s1 * DM) + lane;
#pragma unroll
            for (int j = 0; j < 4; ++j) { xa[q][j] = xr[64 * j]; ya[q][j] = y0[64 * j]; yb[q][j] = y1[64 * j]; } }
#pragma unroll
        for (int q = 0; q < 2; ++q) {
            f32x4 v[4]; float s = 0.f;
#pragma unroll
            for (int j = 0; j < 4; ++j) { const u32x2 x = xa[q][j], a = ya[q][j], b = yb[q][j];
                v[j].x = lo16(x.x) + w0[q] * lo16(a.x) + w1[q] * lo16(b.x); v[j].y = hi16(x.x) + w0[q] * hi16(a.x) + w1[q] * hi16(b.x);
                v[j].z = lo16(x.y) + w0[q] * lo16(a.y) + w1[q] * lo16(b.y); v[j].w = hi16(x.y) + w0[q] * hi16(a.y) + w1[q] * hi16(b.y);
                s += (v[j].x * v[j].x + v[j].y * v[j].y) + (v[j].z * v[j].z + v[j].w * v[j].w); }
            const float rstd = rsqrtf(wave_sum(s) * (1.f / DM) + 1e-6f);
            f32x4* orow = (f32x4*)(p.out + (size_t)(tb + q) * DM) + lane;
#pragma unroll
            for (int j = 0; j < 4; ++j) { const f32x4 o = v[j] * rstd * gv[j]; if (!dry) orow[64 * j] = o; else asm volatile("" :: "v"(o)); }
        }
    }
}

#define LAS __attribute__((address_space(3)))
#define XB_TMO      128
#define XB_XCNT(j)  (256  + 64 * (j))
#define XB_XSUB(j)  (1280 + 64 * (j))
#define XB_XGEN(j)  (2304 + 64 * (j))
#define XB_TOP      3328
#define XB_TOPGEN   3392
#define XCD_BAR_WORDS 3456
#define XB_SPIN_CAP (1u << 18)
DEVI unsigned xb_ld(unsigned* p)              { return __hip_atomic_load(p, __ATOMIC_RELAXED, __HIP_MEMORY_SCOPE_AGENT); }
DEVI unsigned xb_add(unsigned* p, unsigned v) { return __hip_atomic_fetch_add(p, v, __ATOMIC_RELAXED, __HIP_MEMORY_SCOPE_AGENT); }
DEVI unsigned xb_xcc_id() { return (unsigned)__builtin_amdgcn_s_getreg((3 << 11) | 20) & 0xFu; }
#define XB_SPIN(cond, bar) do { unsigned _sp = 0; while (cond) { __builtin_amdgcn_s_sleep(1); \
    if ((++_sp & 255u) == 0u) { if (xb_ld(&(bar)[XB_TMO])) break; if (_sp > XB_SPIN_CAP) { atomicAdd(&(bar)[XB_TMO], 1u); break; } } } } while (0)
struct XcdBarrier { unsigned* bar; unsigned x; volatile LAS unsigned* st; };
DEVI XcdBarrier xcd_barrier_post(unsigned* bar, volatile LAS unsigned* st) {
    XcdBarrier b; b.bar = bar; b.x = xb_xcc_id(); b.st = st;
    if (my_tid() == 0) (void)xb_add(&bar[XB_XCNT(b.x)], 1u);
    return b;
}
DEVI void xcd_barrier_complete(unsigned* bar, unsigned x, unsigned& nloc, unsigned& nx) {
    const unsigned G = gridDim.x * gridDim.y * gridDim.z;
    unsigned sum, cnt, mine, sp = 0u;
    for (;;) {
        sum = 0u; cnt = 0u; mine = 0u;
#pragma unroll
        for (unsigned j = 0; j < 16; ++j) { const unsigned c = xb_ld(&bar[XB_XCNT(j)]); sum += c; cnt += (c > 0u) ? 1u : 0u; mine = (j == x) ? c : mine; }
        if (sum == G) break;
        __builtin_amdgcn_s_sleep(1);
        if ((++sp & 255u) == 0u) { if (xb_ld(&bar[XB_TMO])) break; if (sp > XB_SPIN_CAP) { atomicAdd(&bar[XB_TMO], 1u); break; } }
    }
    nloc = mine > 0u ? mine : 1u; nx = cnt > 0u ? cnt : 1u;
}
DEVI void xcd_barrier(const XcdBarrier& b) {
    asm volatile("s_waitcnt vmcnt(0)" ::: "memory");
    __syncthreads();
    if (my_tid() == 0) {
        unsigned* bar = b.bar;
        __builtin_amdgcn_s_waitcnt(0);
        unsigned nloc = b.st[0], nx = b.st[1];
        if (nloc == 0u) { xcd_barrier_complete(bar, b.x, nloc, nx); b.st[0] = nloc; b.st[1] = nx; }
        const unsigned old = xb_add(&bar[XB_XSUB(b.x)], 1u);
        const unsigned gen = old / nloc;
        if (old + 1u == (gen + 1u) * nloc) {
            __builtin_amdgcn_fence(__ATOMIC_RELEASE, "agent");
            asm volatile("s_waitcnt vmcnt(0)" ::: "memory");
            const unsigned og = xb_add(&bar[XB_TOP], 1u);
            const unsigned tg = og / nx;
            if (og + 1u == (tg + 1u) * nx) xb_add(&bar[XB_TOPGEN], 1u);
            else XB_SPIN(xb_ld(&bar[XB_TOPGEN]) == tg, bar);
            __builtin_amdgcn_fence(__ATOMIC_ACQUIRE, "agent");
            xb_add(&bar[XB_XGEN(b.x)], 1u);
            asm volatile("s_waitcnt vmcnt(0)" ::: "memory");
        } else {
            XB_SPIN(xb_ld(&bar[XB_XGEN(b.x)]) == gen, bar);
            __builtin_amdgcn_fence(__ATOMIC_ACQUIRE, "agent");
            asm volatile("s_waitcnt vmcnt(0)" ::: "memory");
        }
    }
    __syncthreads();
}

constexpr int LDS_BYTES = 147456;
constexpr int LDS_MISC = 147200;
constexpr int C_BAR = 4096;
constexpr size_t CTL_ZERO_BYTES = 65536;
constexpr size_t DOFF_H2ND = 0;
constexpr size_t DOFF_ORWKV = 64 * MiB;

template <int PH>
DEVI void run_phase(const Params& p, char* lds, int bid, int nb) {
    unsigned char* ws = p.ws;
    if constexpr (PH == 0) { stage_transposes(p, 0, p.njobs_mid, 0, p.items_mid, lds, bid, nb); stage_rope_table(p, bid, nb);
        { u32x4* wz = (u32x4*)(ws + OFF_WIN + (size_t)NZ * DM * 2); const u32x4 z4 = {0u, 0u, 0u, 0u}; for (int i = bid * NTHREADS + my_tid(); i < (LDZ - NZ) * DM / 8; i += nb * NTHREADS) wz[i] = z4; }
        { bf16_t* gp = (bf16_t*)(ws + OFF_GUP); const u32x4 z4 = {0u, 0u, 0u, 0u}; for (int i = bid * NTHREADS + my_tid(); i < 512 * 16; i += nb * NTHREADS) *(u32x4*)(gp + (size_t)(i >> 4) * 256 + 128 + 8 * (i & 15)) = z4; }
        { bf16_t* wrh = (bf16_t*)(ws + OFF_WRT); bf16_t* wrl = wrh + 48 * DM; for (int i = bid * NTHREADS + my_tid(); i < 48 * DM; i += nb * NTHREADS) { const int o = i >> 10, c = i & 1023; const float w = p.in[23][c] * ((o < 4) ? p.in[24][c * 4 + o] : (o < 36 ? p.in[26][c * 32 + (o - 4)] : 0.f)); const unsigned h = f2bf(w); wrh[i] = (bf16_t)h; wrl[i] = (bf16_t)f2bf(w - bf2f(h)); } }
        __syncthreads(); stage_rms_rows(p.in[0], p.in[1], (bf16_t*)(ws + OFF_H), bid, nb); }
    if constexpr (PH == 1) { F8Bf16 e{(bf16_t*)(ws + OFF_Z), LDZ}; big_gemm(lds, (const bf16_t*)(ws + OFF_H), DM, (const bf16_t*)(ws + OFF_WIN), DM, T_, LDZ, DM, e, bid, nb); }
    if constexpr (PH == 2) { if ((PROBE_MASK >> 25) & 1) { stage_mla_prep(p, lds, bid, nb, true); stage_sg_prep(p, bid, nb); } stage_mla_prep(p, lds, bid, nb); stage_sg_prep(p, bid, nb); }
    if constexpr (PH == 3) {
        const bf16_t* z = (const bf16_t*)(ws + OFF_Z);
        { F8Bf16 e{(bf16_t*)((char*)p.out + DOFF_QRAW), 768}; big_gemm(lds, z, LDZ, (const bf16_t*)(ws + OFF_WUQ), 384, T_, 768, 384, e, bid, nb); }
        { F8Bf16 e{(bf16_t*)((char*)p.out + DOFF_KVRAW), 1024}; big_gemm(lds, z + 384, LDZ, (const bf16_t*)(ws + OFF_WUKV), 256, T_, 1024, 256, e, bid, nb); }
        { F8Bf16 e{(bf16_t*)(ws + OFF_G), 512}; big_gemm(lds, (const bf16_t*)(ws + OFF_SG), 256, (const bf16_t*)(ws + OFF_GUP), 256, T_, 512, 256, e, bid, nb); }
        for (int rep = 0; rep < 1 + ((PROBE_MASK >> 20) & 1); ++rep) for (int u = bid; u < BATCH * NH * 2; u += nb) chain_unit(p, u, lds);
    }
    if constexpr (PH == 4) {
        for (int rep = 0; rep < 1 + ((PROBE_MASK >> 21) & 1); ++rep) attn_units(p, lds, bid, nb);
        stage_rwkv_post(p, bid, nb);
    }
    if constexpr (PH == 6) {
        { F8Bf16 e{(bf16_t*)(ws + OFF_BM), 1024}; big_gemm(lds, (const bf16_t*)(ws + OFF_OMLA), 512, (const bf16_t*)(ws + OFF_WBM), 512, T_, 1024, 512, e, bid, nb); }
        { F8Bf16 e{(bf16_t*)(ws + OFF_BR), 1024}; big_gemm(lds, (const bf16_t*)(ws + OFF_YF), 512, (const bf16_t*)(ws + OFF_WBR), 512, T_, 1024, 512, e, bid, nb); }
    }
    if constexpr (PH == 7) { EpiGate e{(const bf16_t*)(ws + OFF_BM), (const bf16_t*)(ws + OFF_BR), (bf16_t*)(ws + OFF_MIXED), p.in[21]};
        big_gemm_epi(lds, (const bf16_t*)(ws + OFF_H), DM, (const bf16_t*)(ws + OFF_WG), DM, T_, 2048, DM, e, bid, nb); }
    if constexpr (PH == 8) { F8Resid e{p.in[0], (bf16_t*)(ws + OFF_X1)};
        big_gemm(lds, (const bf16_t*)(ws + OFF_MIXED), DM, (const bf16_t*)(ws + OFF_WOUT), DM, T_, DM, DM, e, bid, nb); }
    if constexpr (PH == 9) { stage_route(p, lds, bid, nb); if ((PROBE_MASK >> 22) & 1) stage_route(p, lds, bid, nb, false); }
    if constexpr (PH == 10) { if ((PROBE_MASK >> 27) & 1) stage_scatter(p, lds, bid, nb, true); stage_scatter(p, lds, bid, nb); }
    if constexpr (PH == 11) { F8Swiglu e{(bf16_t*)((char*)p.out + DOFF_HID)}; const int* ctl = (const int*)(ws + OFF_CTL);
        big_gemm_<F8Swiglu, true>(lds, (const bf16_t*)((const char*)p.out + DOFF_H2), DM, (const bf16_t*)(ws + OFF_W13), DM, ctl[C_NBLK] * 256, 512, DM, e, bid, nb, ctl + C_BLKE, (size_t)512 * DM, (const int*)(ws + OFF_SLOTTOK));
        {
            const int nwg = ctl[C_NBLK] * 2; int n3 = nwg - 2 * nb; n3 = n3 < 0 ? 0 : (n3 > nb - 32 ? nb - 32 : n3);
            if (bid >= n3) stage_transposes(p, p.njobs_mid, p.njobs_all, p.items_mid, p.items_all, lds, bid - n3, nb - n3);
        } }
    if constexpr (PH == 12) { F8Bf16 e{(bf16_t*)(ws + OFF_YE), DM}; const int* ctl = (const int*)(ws + OFF_CTL);
        big_gemm(lds, (const bf16_t*)((const char*)p.out + DOFF_HID), DEXP, (const bf16_t*)(ws + OFF_W2), DEXP, ctl[C_NBLK] * 256, DM, DEXP, e, bid, nb, ctl + C_BLKE, (size_t)DM * DEXP); }
    if constexpr (PH == 13) { if ((PROBE_MASK >> 26) & 1) stage_final(p, bid, nb, true); stage_final(p, bid, nb); }
}

__global__ void __launch_bounds__(NTHREADS, 2) mega_fwd(Params p) {
    extern __shared__ __attribute__((aligned(16))) char lds[];
    const int bid = blockIdx.x, nb = gridDim.x;
    volatile LAS unsigned* misc = (volatile LAS unsigned*)((LAS char*)lds + LDS_MISC);
    if (my_tid() < 64) misc[my_tid()] = 0u;
    __syncthreads();
    XcdBarrier bar = xcd_barrier_post((unsigned*)(p.ws + OFF_CTL) + C_BAR, misc + 8);
    unsigned long long tsp0 = 0, tsp1 = 0;
#define PHASE(k) do { if (SPAN_PH == k) tsp0 = __builtin_amdgcn_s_memrealtime(); run_phase<k>(p, lds, bid, nb); if ((PROBE_MASK >> k) & 1) { __syncthreads(); run_phase<k>(p, lds, bid, nb); } xcd_barrier(bar); if ((PROBE_MASK >> 24) & 1) xcd_barrier(bar); if (SPAN_PH == k) tsp1 = __builtin_amdgcn_s_memrealtime(); } while (0)
    PHASE(0); PHASE(1); PHASE(2); PHASE(3); PHASE(4); PHASE(6); PHASE(7); PHASE(8); PHASE(9); PHASE(10); PHASE(11); PHASE(12);
    if (SPAN_PH == 13) tsp0 = __builtin_amdgcn_s_memrealtime();
    run_phase<13>(p, lds, bid, nb);
    if (SPAN_PH == 13) { __syncthreads(); tsp1 = __builtin_amdgcn_s_memrealtime(); }
    if (SPAN_PH >= 0 && bid == 0) { const unsigned long long t2 = __builtin_amdgcn_s_memrealtime(); while (__builtin_amdgcn_s_memrealtime() - t2 < tsp1 - tsp0) __builtin_amdgcn_s_sleep(8); }
#undef PHASE
}

static int add_job(Params& P, int& nj, int& items, int in_idx, int K, int ldsrc, int col0, int ncols, int row_mul, int row_off, int nbatch, long long sbs, long long dbs, size_t dst_off, int dst_ld = 0) {
    TJob& J = P.jobs[nj]; J.in_idx = in_idx; J.K = K; J.ldsrc = ldsrc; J.col0 = col0; J.ncols = ncols; J.row_mul = row_mul; J.row_off = row_off; J.nbatch = nbatch;
    J.sbs = sbs; J.dbs = dbs; J.dst_off = (long long)dst_off; J.item0 = items; J.dst_ld = dst_ld ? dst_ld : K;
    items += nbatch * (K / 64) * (ncols / 32); return ++nj;
}
extern "C" void kernel_launch(void* const* d_in, const int* in_sizes, int n_in, void* d_out, int out_size, void* d_ws, size_t ws_size, hipStream_t stream) {
    static int grid = 0;
    if (grid == 0) {
        if (n_in != 32 || out_size != T_ * DM || ws_size < WS_NEED) { fprintf(stderr, "kernel_launch: unexpected shapes (n_in %d out %d ws %zu)\n", n_in, out_size, ws_size); grid = -1; return; }
        int dev = 0, cus = 0, per_cu = 0;
        if (hipGetDevice(&dev) != hipSuccess || hipDeviceGetAttribute(&cus, hipDeviceAttributeMultiprocessorCount, dev) != hipSuccess) { grid = -1; return; }
        if (hipFuncSetAttribute((const void*)mega_fwd, hipFuncAttributeMaxDynamicSharedMemorySize, LDS_BYTES) != hipSuccess) { fprintf(stderr, "kernel_launch: hipFuncSetAttribute failed\n"); grid = -1; return; }
        if (hipOccupancyMaxActiveBlocksPerMultiprocessor(&per_cu, (const void*)mega_fwd, NTHREADS, LDS_BYTES) != hipSuccess || per_cu < 1)
            fprintf(stderr, "kernel_launch: note: occupancy query reports %d workgroups per CU\n", per_cu);
        (void)hipGetLastError();
        grid = cus;
    }
    if (grid < 0) return;
    Params P{};
    for (int i = 0; i < 32; ++i) P.in[i] = (const float*)d_in[i];
    P.out = (float*)d_out; P.ws = (unsigned char*)d_ws;
    int nj = 0, items = 0;
    add_job(P, nj, items, 2, 1024, 4640, 0, 640, 1, 0, 1, 0, 0, OFF_WIN);
    add_job(P, nj, items, 2, 1024, 4640, 672, 1920, 1, 640, 1, 0, 0, OFF_WIN);
    add_job(P, nj, items, 2, 1024, 4640, 640, 32, 1, 0, 1, 0, 0, OFF_WKR);
    add_job(P, nj, items, 2, 1024, 4640, 2592, 1024, -1, 0, 1, 0, 0, OFF_WG);
    add_job(P, nj, items, 2, 1024, 4640, 3616, 1024, -1, 128, 1, 0, 0, OFF_WG);
    add_job(P, nj, items, 5, 384, 768, 0, 768, 1, 0, 1, 0, 0, OFF_WUQ);
    add_job(P, nj, items, 6, 256, 1024, 0, 1024, 1, 0, 1, 0, 0, OFF_WUKV);
    add_job(P, nj, items, 7, 512, 1024, 0, 1024, 1, 0, 1, 0, 0, OFF_WBM);
    add_job(P, nj, items, 20, 512, 1024, 0, 1024, 1, 0, 1, 0, 0, OFF_WBR);
    add_job(P, nj, items, 22, 1024, 1024, 0, 1024, 1, 0, 1, 0, 0, OFF_WOUT);
    add_job(P, nj, items, 11, 64, 512, 0, 512, 1, 0, 2, 64 * 512, 512 * 64, OFF_WUP);
    add_job(P, nj, items, 13, 64, 512, 0, 512, 1, 0, 2, 64 * 512, 512 * 64, OFF_AUP);
    add_job(P, nj, items, 14, 128, 512, 0, 512, 1, 0, 1, 0, 0, OFF_GUP, 256);
    P.njobs_early = nj; P.items_early = items;
    add_job(P, nj, items, 28, 1024, 256, 0, 256, 2, 0, 32, 1024 * 256, 512 * 1024, OFF_W13);
    add_job(P, nj, items, 29, 1024, 256, 0, 256, 2, 1, 32, 1024 * 256, 512 * 1024, OFF_W13);
    P.njobs_mid = nj; P.items_mid = items;
    add_job(P, nj, items, 30, 256, 1024, 0, 1024, 1, 0, 32, 256 * 1024, 1024 * 256, OFF_W2);
    P.njobs_all = nj; P.items_all = items;
    if (hipMemsetAsync((char*)d_ws + OFF_CTL, 0, CTL_ZERO_BYTES, stream) != hipSuccess) { fprintf(stderr, "kernel_launch: memset failed\n"); return; }
    hipLaunchKernelGGL(mega_fwd, dim3(grid), dim3(NTHREADS), LDS_BYTES, stream, P);
}
```

```cpp
#include <hip/hip_runtime.h>
#include <cstdio>
#include <cstdint>

#define DEVI __device__ __forceinline__
#ifndef PROBE_MASK
#define PROBE_MASK 0
#endif
#ifndef SPAN_PH
#define SPAN_PH -1
#endif
typedef unsigned short bf16_t;
typedef short bf16x8 __attribute__((ext_vector_type(8)));
typedef short s16x4 __attribute__((ext_vector_type(4)));
typedef float f32x4 __attribute__((ext_vector_type(4)));
typedef float f32x16 __attribute__((ext_vector_type(16)));
typedef unsigned u32x4 __attribute__((ext_vector_type(4)));
typedef unsigned u32x2 __attribute__((ext_vector_type(2)));

constexpr int BATCH = 16, SEQ = 2048, DM = 1024, T_ = BATCH * SEQ;
constexpr int NH = 8;
constexpr int LDZ = 2560;
constexpr int NZ = 2560;
constexpr int ZR = 640;
constexpr int NEXP = 32, DEXP = 256;
constexpr int CAP = T_ * 2 + NEXP * 256;
constexpr int NBLK = CAP / 256;
constexpr int NTHREADS = 512, NWAVES = 8;

constexpr size_t MiB = 1u << 20;
constexpr size_t OFF_CTL = 0;
constexpr size_t OFF_WIN = 1 * MiB;
constexpr size_t OFF_WG = 7 * MiB;
constexpr size_t OFF_WUQ = 11 * MiB;
constexpr size_t OFF_WUKV = 12 * MiB;
constexpr size_t OFF_WBM = 13 * MiB;
constexpr size_t OFF_WBR = 14 * MiB;
constexpr size_t OFF_WOUT = 15 * MiB;
constexpr size_t OFF_WUP = 17 * MiB;
constexpr size_t OFF_AUP = 17 * MiB + 131072;
constexpr size_t OFF_GUP = 17 * MiB + 262144;
constexpr size_t OFF_WKR = 17 * MiB + 524288;
constexpr size_t OFF_ROPE = 18 * MiB;
constexpr size_t OFF_TOKE = 18 * MiB + 262144;
constexpr size_t OFF_TOKW = 18 * MiB + 524288;
constexpr size_t OFF_TOKS = 18 * MiB + 786432;
constexpr size_t OFF_TOKR = 19 * MiB;
constexpr size_t OFF_WRT = 19 * MiB + 524288;
constexpr size_t OFF_CNTWG = 19 * MiB + 786432;
constexpr size_t OFF_KROPE = 20 * MiB;
constexpr size_t OFF_YB = 22 * MiB;
constexpr size_t OFF_W13 = 366 * MiB;
constexpr size_t OFF_W2 = 54 * MiB;
constexpr size_t OFF_TW = 70 * MiB;
constexpr size_t OFF_AD = 78 * MiB;
constexpr size_t DOFF_SG = 112 * MiB;
constexpr size_t OFF_H8 = 62 * MiB;
constexpr size_t OFF_Z = 94 * MiB;
constexpr size_t OFF_H = 302 * MiB;
constexpr size_t OFF_WL = 270 * MiB;
constexpr size_t OFF_G = 398 * MiB;
constexpr size_t OFF_OMLA = 430 * MiB;
constexpr size_t OFF_YF = 462 * MiB;
constexpr size_t OFF_H2ND = 94 * MiB;
constexpr size_t OFF_BR = 158 * MiB;
constexpr size_t OFF_BM = 94 * MiB;
constexpr size_t OFF_X1 = 94 * MiB;
constexpr size_t DOFF_H2 = 0;
constexpr size_t OFF_YE = 158 * MiB;
constexpr size_t DOFF_HID = 65 * MiB;
constexpr size_t OFF_VS = 270 * MiB;
constexpr size_t OFF_SDIR = 494 * MiB;
constexpr size_t OFF_MIXED = 222 * MiB;
constexpr size_t OFF_SLOTTOK = 338 * MiB;
constexpr size_t OFF_TWAD = 430 * MiB;
constexpr size_t OFF_CKV8 = 496 * MiB;
constexpr size_t WS_NEED = 504 * MiB;
constexpr size_t DOFF_QRAW = 0, DOFF_KVRAW = 48 * MiB;

constexpr int C_CNT = 0, C_CUR = 64, C_PST = 128, C_NBLK = 192, C_BLKE = 256;

DEVI int my_tid() { int t = threadIdx.x; asm volatile("" : "+v"(t)); return t; }
DEVI float bf2f(unsigned h) { return __uint_as_float(h << 16); }
DEVI unsigned f2bf(float f) { unsigned u = __float_as_uint(f); return (u + 0x7fffu + ((u >> 16) & 1u)) >> 16; }
typedef float f32x2p __attribute__((ext_vector_type(2))); typedef __bf16 bf16x2p __attribute__((ext_vector_type(2)));
DEVI unsigned pk2(float lo, float hi) { const f32x2p v = {lo, hi}; return __builtin_bit_cast(unsigned, __builtin_convertvector(v, bf16x2p)); }
DEVI float lo16(unsigned w) { return __uint_as_float(w << 16); }
DEVI float hi16(unsigned w) { return __uint_as_float(w & 0xffff0000u); }
DEVI float wave_sum(float v) {
    v += __int_as_float(__builtin_amdgcn_update_dpp(0, __float_as_int(v), 0xB1, 0xF, 0xF, false));
    v += __int_as_float(__builtin_amdgcn_update_dpp(0, __float_as_int(v), 0x4E, 0xF, 0xF, false));
    v += __int_as_float(__builtin_amdgcn_update_dpp(0, __float_as_int(v), 0x141, 0xF, 0xF, false));
    v += __int_as_float(__builtin_amdgcn_update_dpp(0, __float_as_int(v), 0x140, 0xF, 0xF, false));
    v += __shfl_xor(v, 16); v += __shfl_xor(v, 32);
    return v;
}
DEVI float sigmoidf_(float x) { return __builtin_amdgcn_rcpf(1.f + __expf(-x)); }
DEVI unsigned pk4_fp8(float a, float b, float c, float d) { int w = 0; w = __builtin_amdgcn_cvt_pk_fp8_f32(a, b, w, false); w = __builtin_amdgcn_cvt_pk_fp8_f32(c, d, w, true); return (unsigned)w; }
constexpr float F8_ASCALE = 16.f, F8_WSCALE = 16.f;
constexpr int F8_ASC_E8 = 123, F8_WSC_E8 = 123;
DEVI void unpack8(const u32x4 w, float (&f)[8]) { f[0] = lo16(w.x); f[1] = hi16(w.x); f[2] = lo16(w.y); f[3] = hi16(w.y); f[4] = lo16(w.z); f[5] = hi16(w.z); f[6] = lo16(w.w); f[7] = hi16(w.w); }
DEVI u32x4 pack8(const float (&f)[8]) { u32x4 w; w.x = pk2(f[0], f[1]); w.y = pk2(f[2], f[3]); w.z = pk2(f[4], f[5]); w.w = pk2(f[6], f[7]); return w; }

struct TJob { int in_idx, K, ldsrc, col0, ncols, row_mul, row_off, nbatch; long long sbs, dbs, dst_off; int item0, dst_ld, fp8; };
constexpr int MAXJOBS = 16;
struct Params {
    const float* in[32];
    float* out;
    unsigned char* ws;
    TJob jobs[MAXJOBS];
    int njobs_early, njobs_all, items_early, items_all;
    int njobs_mid, items_mid;
};

DEVI void transpose_item(const float* W, int K, int ld, bf16_t* WT, int dst_ld, int row_off, int row_mul, float* scr, int kb, int nb, int lane, int fp8 = 0) {
    const int k0 = 64 * kb, n0 = 32 * nb;
    float tv[32];
#pragma unroll
    for (int i = 0; i < 32; ++i) tv[i] = W[(size_t)(k0 + 2 * i + (lane >> 5)) * ld + n0 + (lane & 31)];
#pragma unroll
    for (int i = 0; i < 32; ++i) scr[(2 * i + (lane >> 5)) * 33 + (lane & 31)] = tv[i];
    asm volatile("s_waitcnt lgkmcnt(0)" ::: "memory");
    const int c = lane & 7;
#pragma unroll
    for (int j = 0; j < 4; ++j) {
        const int n = (lane >> 3) + 8 * j; const float* s = scr + (8 * c) * 33 + n;
        u32x4 o; o.x = pk2(s[0], s[33]); o.y = pk2(s[66], s[99]); o.z = pk2(s[132], s[165]); o.w = pk2(s[198], s[231]);
        const int nn = n0 + n;
        const int drow = row_mul > 0 ? row_off + nn * row_mul : row_off + ((nn >> 7) << 8) + (nn & 127);
        if (fp8) { u32x2 o8; o8.x = pk4_fp8(s[0] * F8_WSCALE, s[33] * F8_WSCALE, s[66] * F8_WSCALE, s[99] * F8_WSCALE); o8.y = pk4_fp8(s[132] * F8_WSCALE, s[165] * F8_WSCALE, s[198] * F8_WSCALE, s[231] * F8_WSCALE);
            *(u32x2*)((char*)WT + (size_t)drow * dst_ld + k0 + 8 * c) = o8; }
        else *(u32x4*)(WT + (size_t)drow * dst_ld + k0 + 8 * c) = o;
    }
    asm volatile("s_waitcnt lgkmcnt(0)" ::: "memory");
}
DEVI void stage_transposes(const Params& p, int j0, int j1, int item_base, int item_end, char* lds, int bid, int nb) {
    const int lane = my_tid() & 63, wave = my_tid() >> 6;
    float* scr = (float*)(lds + wave * 8704);
    const int gw = bid * NWAVES + wave, NGW = nb * NWAVES;
    for (int it = item_base + gw; it < item_end; it += NGW) {
        int j = j0;
        while (j + 1 < j1 && it >= p.jobs[j + 1].item0) ++j;
        const TJob& J = p.jobs[j];
        int r = it - J.item0;
        const int nblk = J.ncols / 32, per = (J.K / 64) * nblk;
        const int e = r / per; r -= e * per;
        const int kb = r / nblk, nbk = r % nblk;
        transpose_item(p.in[J.in_idx] + (size_t)e * J.sbs + J.col0, J.K, J.ldsrc, (bf16_t*)(p.ws + J.dst_off + (size_t)e * J.dbs * (J.fp8 ? 1 : 2)), J.dst_ld, J.row_off, J.row_mul, scr, kb, nbk, lane, J.fp8);
    }
}
DEVI void stage_rope_table(const Params& p, int bid, int nb) {
    float* ct = (float*)(p.ws + OFF_ROPE); float* st = ct + SEQ * 16;
    for (int i = bid * 128 + my_tid(); i < SEQ * 16 && my_tid() < 128; i += nb * 128) {
        const int pos = i >> 4, f = i & 15, fh = f >> 2, fl = f & 3;
        const double a = fh == 0 ? 1.0 : (fh == 1 ? 0.1 : (fh == 2 ? 0.01 : 0.001));
        const double bq = fl == 0 ? 1.0 : (fl == 1 ? 0.56234132519034908 : (fl == 2 ? 0.31622776601683794 : 0.17782794100389228));
        const double ang = (double)pos * (a * bq);
        const double kk = __builtin_rint(ang * 0.15915494309189535);
        const float r = (float)__builtin_fma(-kk, 6.283185307179586, ang) ;
        ct[i] = cosf(r); st[i] = sinf(r);
    }
}

DEVI void stage_rms_rows(const float* x, const float* g, bf16_t* out, unsigned char* out8, int bid, int nb) {
    const int lane = my_tid() & 63, wave = my_tid() >> 6;
    const int gw = bid * NWAVES + wave, NGW = nb * NWAVES;
    f32x4 gv[4];
#pragma unroll
    for (int j = 0; j < 4; ++j) gv[j] = *(const f32x4*)(g + 4 * lane + 256 * j);
    for (int mb = gw * 4; mb < T_; mb += NGW * 4) {
        f32x4 v[4][4];
#pragma unroll
        for (int q = 0; q < 4; ++q) { const f32x4* xr = (const f32x4*)(x + (size_t)(mb + q) * DM) + lane;
#pragma unroll
            for (int j = 0; j < 4; ++j) v[q][j] = xr[64 * j]; }
#pragma unroll
        for (int q = 0; q < 4; ++q) { float s = 0.f;
#pragma unroll
            for (int j = 0; j < 4; ++j) s += (v[q][j].x * v[q][j].x + v[q][j].y * v[q][j].y) + (v[q][j].z * v[q][j].z + v[q][j].w * v[q][j].w);
            const float rstd = rsqrtf(wave_sum(s) * (1.f / DM) + 1e-6f);
            u32x2* o8 = (u32x2*)(out + (size_t)(mb + q) * DM) + lane;
            unsigned* o4 = (unsigned*)(out8 + (size_t)(mb + q) * DM) + lane;
#pragma unroll
            for (int j = 0; j < 4; ++j) { const float h0 = v[q][j].x * rstd * gv[j].x, h1 = v[q][j].y * rstd * gv[j].y, h2_ = v[q][j].z * rstd * gv[j].z, h3 = v[q][j].w * rstd * gv[j].w;
                u32x2 w; w.x = pk2(h0, h1); w.y = pk2(h2_, h3); o8[64 * j] = w; o4[64 * j] = pk4_fp8(h0 * F8_ASCALE, h1 * F8_ASCALE, h2_ * F8_ASCALE, h3 * F8_ASCALE); } }
    }
}

typedef short v4i16_t_ __attribute__((ext_vector_type(4)));
DEVI s16x4 vtr_(const char* p) { return __builtin_bit_cast(s16x4, __builtin_amdgcn_ds_read_tr16_b64_v4i16((__attribute__((address_space(3))) v4i16_t_*)p)); }
struct EpiBf16 { bf16_t* out; int ld;
    DEVI void operator()(int row, int col, f32x4 v) const { u32x2 w; w.x = pk2(v.x, v.y); w.y = pk2(v.z, v.w); *(u32x2*)(out + (size_t)row * ld + col) = w; } };
struct EpiBiasAct { bf16_t* out; int ld; const float* bias; int act;
    DEVI void operator()(int row, int col, f32x4 v) const {
        const f32x4 b = *(const f32x4*)(bias + col); v = v + b;
        if (act) { v.x = sigmoidf_(v.x); v.y = sigmoidf_(v.y); v.z = sigmoidf_(v.z); v.w = sigmoidf_(v.w); }
        u32x2 w; w.x = pk2(v.x, v.y); w.y = pk2(v.z, v.w); *(u32x2*)(out + (size_t)row * ld + col) = w; } };
struct EpiMix { const bf16_t* gl; bf16_t* bm; const float* gb;
    DEVI void operator()(int row, int col, f32x4 v) const {
        const u32x2 g1 = *(const u32x2*)(gl + (size_t)row * 2048 + col), g2 = *(const u32x2*)(gl + (size_t)row * 2048 + 1024 + col);
        const u32x2 m = *(const u32x2*)(bm + (size_t)row * 1024 + col);
        const f32x4 b0 = *(const f32x4*)(gb + col), b1 = *(const f32x4*)(gb + 1024 + col);
        f32x4 r;
        r.x = sigmoidf_(lo16(g1.x) + b0.x) * lo16(m.x) + sigmoidf_(lo16(g2.x) + b1.x) * v.x;
        r.y = sigmoidf_(hi16(g1.x) + b0.y) * hi16(m.x) + sigmoidf_(hi16(g2.x) + b1.y) * v.y;
        r.z = sigmoidf_(lo16(g1.y) + b0.z) * lo16(m.y) + sigmoidf_(lo16(g2.y) + b1.z) * v.z;
        r.w = sigmoidf_(hi16(g1.y) + b0.w) * hi16(m.y) + sigmoidf_(hi16(g2.y) + b1.w) * v.w;
        u32x2 w; w.x = pk2(r.x, r.y); w.y = pk2(r.z, r.w); *(u32x2*)(bm + (size_t)row * 1024 + col) = w; } };
struct EpiResid { const float* x; float* out;
    DEVI void operator()(int row, int col, f32x4 v) const { const f32x4 b = *(const f32x4*)(x + (size_t)row * DM + col); *(f32x4*)(out + (size_t)row * DM + col) = b + v; } };
struct EpiSwiglu { bf16_t* hid;
    DEVI void operator()(int row, int col, f32x4 v) const {
        const float a = v.x * sigmoidf_(v.x) * v.y, b = v.z * sigmoidf_(v.z) * v.w;
        *(unsigned*)(hid + (size_t)row * DEXP + (col >> 1)) = pk2(a, b); } };

template <class Epi>
DEVI void gemm_stage(const bf16_t* A, int lda, const bf16_t* Bt, int ldb, int M, int N, int K, const Epi& epi, char* lds, int bid, int nb,
                     const int* rowidx, const int* blk_e, size_t estride) {
    const int tid = my_tid(), lane = tid & 63, wid = tid >> 6, wr = wid >> 1, wc = wid & 1;
    const int nM = M / 256, nN = (N + 127) / 128, nt = K / 64;
    for (int u = bid; u < nM * nN; u += nb) {
        const int pm = u / nN, pn = u % nN, m0 = pm * 256, n0 = pn * 128;
        const bf16_t* Bu = Bt;
        if (blk_e) { const int e = blk_e[pm]; if (e < 0) continue; Bu = Bt + (size_t)e * estride; }
        const bf16_t* ga[4]; const bf16_t* gb[2]; int offA[4], offB[2];
#pragma unroll
        for (int i = 0; i < 4; ++i) { const int pc = tid + 512 * i, row = pc >> 3, ch = pc & 7;
            int r = m0 + row; if (rowidx) r = rowidx[m0 + row];
            ga[i] = (r >= 0) ? A + (size_t)r * lda + ch * 8 : nullptr; offA[i] = row * 128 + ((ch ^ (row & 7)) << 4); }
#pragma unroll
        for (int i = 0; i < 2; ++i) { const int pc = tid + 512 * i, row = pc >> 3, ch = pc & 7; const int n = n0 + row;
            gb[i] = (n < N) ? Bu + (size_t)n * ldb + ch * 8 : nullptr; offB[i] = row * 128 + ((ch ^ (row & 7)) << 4); }
        u32x4 ra[4], rb[2];
        const u32x4 zero4 = {0u, 0u, 0u, 0u};
#define G_LOAD(kt) do { _Pragma("unroll") for (int i = 0; i < 4; ++i) ra[i] = ga[i] ? *(const u32x4*)(ga[i] + (kt) * 64) : zero4; \
                        _Pragma("unroll") for (int i = 0; i < 2; ++i) rb[i] = gb[i] ? *(const u32x4*)(gb[i] + (kt) * 64) : zero4; } while (0)
#define G_STORE(buf) do { _Pragma("unroll") for (int i = 0; i < 4; ++i) *(u32x4*)(lds + (buf) * 32768 + offA[i]) = ra[i]; \
                          _Pragma("unroll") for (int i = 0; i < 2; ++i) *(u32x4*)(lds + 65536 + (buf) * 16384 + offB[i]) = rb[i]; } while (0)
        f32x4 acc[4][4];
#pragma unroll
        for (int a = 0; a < 4; ++a)
#pragma unroll
            for (int b = 0; b < 4; ++b) acc[a][b] = (f32x4){0.f, 0.f, 0.f, 0.f};
        G_LOAD(0); G_STORE(0); __syncthreads();
        for (int kt = 0; kt < nt; ++kt) {
            const int buf = kt & 1;
            if (kt + 1 < nt) G_LOAD(kt + 1);
            const char* As = lds + buf * 32768; const char* Bs = lds + 65536 + buf * 16384;
#pragma unroll
            for (int kk = 0; kk < 2; ++kk) {
                bf16x8 af[4], bfr[4];
#pragma unroll
                for (int mi = 0; mi < 4; ++mi) { const int row = 64 * wr + 16 * mi + (lane & 15), ch = 4 * kk + (lane >> 4); af[mi] = *(const bf16x8*)(As + row * 128 + ((ch ^ (row & 7)) << 4)); }
#pragma unroll
                for (int ni = 0; ni < 4; ++ni) { const int row = 64 * wc + 16 * ni + (lane & 15), ch = 4 * kk + (lane >> 4); bfr[ni] = *(const bf16x8*)(Bs + row * 128 + ((ch ^ (row & 7)) << 4)); }
#pragma unroll
                for (int mi = 0; mi < 4; ++mi)
#pragma unroll
                    for (int ni = 0; ni < 4; ++ni) acc[mi][ni] = __builtin_amdgcn_mfma_f32_16x16x32_bf16(bfr[ni], af[mi], acc[mi][ni], 0, 0, 0);
            }
            if (kt + 1 < nt) G_STORE(buf ^ 1);
            __syncthreads();
        }
#undef G_LOAD
#undef G_STORE
#pragma unroll
        for (int mi = 0; mi < 4; ++mi)
#pragma unroll
            for (int ni = 0; ni < 4; ++ni) {
                const int row = m0 + 64 * wr + 16 * mi + (lane & 15), col = n0 + 64 * wc + 16 * ni + 4 * (lane >> 4);
                if (col < N) epi(row, col, acc[mi][ni]);
            }
    }
}


namespace pg8 {
#define PG8_LAS __attribute__((address_space(3)))
constexpr int BM = 256, BK = 64, HALF = 128, HTB = HALF * BK * 2, STAGE_BYTES = 8 * HTB, NXCD = 8, WGM = 8;
__host__ __device__ __forceinline__ int lds_byte(int r, int c) { const int st = (r >> 4) * 2 + (c >> 5), rr = r & 15, cc = c & 31, ob = rr * 64 + cc * 2; return st * 1024 + (ob ^ (((ob >> 9) & 1) << 5)); }
__host__ __device__ __forceinline__ void stage_rc(int b, int& R, int& C) { const int st = b / 1024, sb = b % 1024, swz = sb ^ (((sb >> 9) & 1) << 5); R = (st >> 1) * 16 + swz / 64; C = (st & 1) * 32 + (swz % 64) / 2; }
__host__ __device__ __forceinline__ int perm32(int rho) { const int n = rho >> 4, i = rho & 15; return 8 * (i >> 2) + 4 * n + (i & 3); }
typedef int i32x4 __attribute__((ext_vector_type(4)));
typedef int i32x8 __attribute__((ext_vector_type(8)));
struct Unit { int pm, pn, e; };
struct Gemm { const bf16_t* A; const bf16_t* Bt; int M, N, K, lda, ldb; size_t estride; const int* rowidx; };
struct StaticOrder {
    int nM, nN, nwg, G, c; const int* blk_e;
    __device__ void init(int M, int N, int G_, int c_, const int* be = nullptr) { nM = M / BM; nN = N / BM; nwg = nM * nN; G = G_; c = c_; blk_e = be; }
    __device__ bool next(int i, Unit& u) const {
        const int L = i * G + c; if (L >= nwg) return false;
        int wgid = L; { const int q = nwg / NXCD, r = nwg % NXCD, xcd = wgid % NXCD, off = wgid / NXCD; wgid = (xcd < r ? xcd * (q + 1) : r * (q + 1) + (xcd - r) * q) + off; }
        const int nig = WGM * nN, gid = wgid / nig, fm = gid * WGM, gsz = (nM - fm) < WGM ? (nM - fm) : WGM;
        u.pm = fm + ((wgid % nig) % gsz); u.pn = (wgid % nig) / gsz; u.e = blk_e ? blk_e[u.pm] : 0; return true;
    }
    __device__ __forceinline__ void a_ready(const Unit&) const {}
    __device__ __forceinline__ void done(const Unit&) const {}
};
__device__ __forceinline__ int own_pm(int c) { return ((c & 7) << 5) + (c >> 3); }
struct OwnG1 {
    int c, L2; const int* blk_e; int e_own;
    __device__ bool next(int i, Unit& u) const {
        if (i < 2) { u.pm = own_pm(c); u.pn = i; u.e = e_own; return true; }
        if (i == 2 && c < L2) { u.pm = 256 + (c >> 1); u.pn = c & 1; u.e = blk_e[u.pm]; return true; }
        return false; }
    __device__ __forceinline__ void a_ready(const Unit&) const {}
    __device__ __forceinline__ void done(const Unit&) const {}
};
struct OwnG2 {
    int c; int e_own;
    __device__ bool next(int i, Unit& u) const { if (i >= 4) return false; int pn = i; asm volatile("" : "+s"(pn));     u.pm = own_pm(c); u.pn = pn; u.e = e_own; return true; }
    __device__ __forceinline__ void a_ready(const Unit&) const {}
    __device__ __forceinline__ void done(const Unit&) const {}
};
struct RestG2 {
    int c, G, L; const int* blk_e;
    __device__ bool next(int i, Unit& u) const {
        int q = i * G + c; if (q >= 12 * L) return false;
        if (q < 4 * L) { u.pm = 256 + (q >> 2); u.pn = q & 3; } else { q -= 4 * L; u.pm = own_pm(q >> 2); u.pn = q & 3; }
        u.e = blk_e[u.pm]; return true; }
    __device__ __forceinline__ void a_ready(const Unit&) const {}
    __device__ __forceinline__ void done(const Unit&) const {}
};
struct BranchOwn {
    int c;
    __device__ bool next(int i, Unit& u) const { if (i >= 2) return false; const int x = c & 7, idx = c >> 3; int pn = 2 * (idx & 1) + i; asm volatile("" : "+s"(pn)); u.pm = 16 * x + (idx >> 1); u.pn = pn; u.e = 0; return true; }
    __device__ __forceinline__ void a_ready(const Unit&) const {}
    __device__ __forceinline__ void done(const Unit&) const {}
};
struct GateOwn {
    int c;
    __device__ bool next(int i, Unit& u) const { if (i >= 4) return false; const int x = c & 7, idx = c >> 3; int pn = 4 * (idx & 1) + i; asm volatile("" : "+s"(pn));
        u.pm = 16 * x + (idx >> 1); u.pn = pn; u.e = 0; return true; }
    __device__ __forceinline__ void a_ready(const Unit&) const {}
    __device__ __forceinline__ void done(const Unit&) const {}
};
template <class F> struct Epi8 {
    static constexpr bool PERM = true, AFTER_DRAIN = false; F f;
    __device__ __forceinline__ void operator()(const f32x4 (&acc)[2][2][4][2], const Unit& u, int wr, int wc, int fr, int fq) const {
        { const int l_ = my_tid() & 63; fr = l_ & 15; fq = l_ >> 4; }
#pragma unroll
        for (int ai = 0; ai < 2; ++ai)
#pragma unroll
            for (int m = 0; m < 4; ++m) { const int row = u.pm * BM + ai * HALF + wr * 64 + m * 16 + fr;
#pragma unroll
                for (int bj = 0; bj < 2; ++bj) f(row, u.pn * BM + bj * HALF + wc * 32 + 8 * fq, acc[ai][bj][m][0], acc[ai][bj][m][1]); }
    }
};
template <class Epi, class Sched, bool ALIGN_EPI = false, bool SP2 = false, bool GATHER = false, bool F8 = false>
__device__ __forceinline__ void gemm_phase(PG8_LAS unsigned char* lds, const Gemm g, const Sched& S, const Epi& E) {
    const int tid = my_tid(), wid = __builtin_amdgcn_readfirstlane(tid >> 6), lane = tid & 63, wr = wid >> 2, wc = wid & 3, fr = lane & 15, fq = lane >> 4;
    const int K = g.K, nt = K / BK;
    unsigned voffA[2], voffB[2];
#pragma unroll
    for (int i = 0; i < 2; ++i) { int R, C; stage_rc(tid * 16 + i * 8192, R, C); const int Rb = Epi::PERM ? ((R & ~31) + perm32(R & 31)) : R;
        voffA[i] = (unsigned)(R * g.lda + C) * 2u; voffB[i] = (unsigned)(Rb * g.ldb + C) * 2u; }
    unsigned vAc[2][2];
    PG8_LAS u32x4* const vslot = (PG8_LAS u32x4*)(lds + STAGE_BYTES) + tid;
#define PG8_VA4(pmv, o00, o01, o10, o11) do { const int t_ = my_tid(); int R0_, C0_, R1_, C1_; stage_rc(t_ * 16, R0_, C0_); stage_rc(t_ * 16 + 8192, R1_, C1_); const unsigned lb_ = (unsigned)(g.lda * 2); \
        const int* ri_ = g.rowidx + (pmv) * BM; o00 = (unsigned)ri_[R0_] * lb_ + (unsigned)(C0_ * 2); o01 = (unsigned)ri_[R1_] * lb_ + (unsigned)(C1_ * 2); \
        o10 = (unsigned)ri_[HALF + R0_] * lb_ + (unsigned)(C0_ * 2); o11 = (unsigned)ri_[HALF + R1_] * lb_ + (unsigned)(C1_ * 2); } while (0)
    const size_t kstep = (size_t)(BK * 2);
    const size_t hstepA = (size_t)HALF * g.lda * 2, hstepB = (size_t)HALF * g.ldb * 2;
    const size_t tstepA = 2 * hstepA, tstepB = 2 * hstepB, estep = g.estride * 2;
    const unsigned ldsw = (unsigned)wid * 1024u;
    const int aoff = lds_byte(wr * 64 + fr, fq * 8), boff = lds_byte(wc * 32 + fr, fq * 8);
#define PG8_SA(b, h) (((b) * 2 + (h)) * HTB)
#define PG8_SB(b, h) ((4 + (b) * 2 + (h)) * HTB)
#define PG8_STAGE(bufoff, gbase, voff) do { unsigned long long gb_ = (unsigned long long)(const char*)(gbase); asm volatile("" : "+s"(gb_)); _Pragma("unroll") for (int _i = 0; _i < 2; ++_i) \
        __builtin_amdgcn_global_load_lds((const unsigned*)((const char*)gb_ + (voff)[_i]), (PG8_LAS unsigned*)(lds + (bufoff) + ldsw + _i * 8192), 16, 0, 0); } while (0)
#define PG8_STAGE_A(bufoff, gbase, h, vv) do { if constexpr (GATHER) PG8_STAGE(bufoff, gbase, (vv)[h]); else PG8_STAGE(bufoff, (gbase) + (h) * hstepA, voffA); } while (0)
#define PG8_LD8(p_) __builtin_shufflevector(*(const PG8_LAS i32x4*)(p_), *(const PG8_LAS i32x4*)((p_) + 1024), 0, 1, 2, 3, 4, 5, 6, 7)
#define PG8_LDA(dst, b, h) do { _Pragma("unroll") for (int m = 0; m < 4; ++m) dst[m] = PG8_LD8(lds + PG8_SA(b, h) + aoff + m * 2048); } while (0)
#define PG8_LDB(dst, b, h) do { _Pragma("unroll") for (int n = 0; n < 2; ++n) dst[n] = PG8_LD8(lds + PG8_SB(b, h) + boff + n * 2048); } while (0)
#define PG8_K0(v_) __builtin_bit_cast(bf16x8, __builtin_shufflevector(v_, v_, 0, 1, 2, 3))
#define PG8_K1(v_) __builtin_bit_cast(bf16x8, __builtin_shufflevector(v_, v_, 4, 5, 6, 7))
#define PG8_MMA(ai, bj, At, Bt) do { __builtin_amdgcn_s_setprio(1); _Pragma("unroll") for (int m = 0; m < 4; ++m) _Pragma("unroll") for (int n = 0; n < 2; ++n) { \
        if constexpr (F8) acc[ai][bj][m][n] = __builtin_amdgcn_mfma_scale_f32_16x16x128_f8f6f4(Bt[n], At[m], acc[ai][bj][m][n], 0, 0, 0, F8_WSC_E8, 0, F8_ASC_E8); \
        else { acc[ai][bj][m][n] = __builtin_amdgcn_mfma_f32_16x16x32_bf16(PG8_K0(Bt[n]), PG8_K0(At[m]), acc[ai][bj][m][n], 0, 0, 0); \
               acc[ai][bj][m][n] = __builtin_amdgcn_mfma_f32_16x16x32_bf16(PG8_K1(Bt[n]), PG8_K1(At[m]), acc[ai][bj][m][n], 0, 0, 0); } } __builtin_amdgcn_s_setprio(0); } while (0)
#define PG8_WAIT_V(n) asm volatile("s_waitcnt vmcnt(" #n ")" ::: "memory")
#define PG8_WAIT_L(n) asm volatile("s_waitcnt lgkmcnt(" #n ")" ::: "memory")
#define PG8_BAR __builtin_amdgcn_s_barrier()
#define PG8_SCHED __builtin_amdgcn_sched_barrier(0)
    Unit cur, nxt; int ui = 0;
    if (!S.next(0, cur)) return;
    f32x4 acc[2][2][4][2];
#pragma unroll
    for (int a = 0; a < 2; ++a)
#pragma unroll
        for (int b = 0; b < 2; ++b)
#pragma unroll
            for (int m = 0; m < 4; ++m)
#pragma unroll
                for (int n = 0; n < 2; ++n) acc[a][b][m][n] = (f32x4){0.f, 0.f, 0.f, 0.f};
    i32x8 At[4], B0[2], B1[2];
    const char* cA = (const char*)g.A + (GATHER ? (size_t)0 : (size_t)cur.pm * tstepA); const char* cB = (const char*)g.Bt + (size_t)cur.e * estep + (size_t)cur.pn * tstepB;
    if constexpr (GATHER) PG8_VA4(cur.pm, vAc[0][0], vAc[0][1], vAc[1][0], vAc[1][1]);
    S.a_ready(cur);
    if constexpr (SP2) {
        PG8_STAGE(PG8_SB(0, 0), cB, voffB); PG8_STAGE(PG8_SB(0, 1), cB + hstepB, voffB); PG8_STAGE_A(PG8_SA(0, 0), cA, 0, vAc); PG8_STAGE_A(PG8_SA(0, 1), cA, 1, vAc);
        if (wr == 1) PG8_BAR;
        PG8_WAIT_V(2); PG8_BAR;
        PG8_STAGE(PG8_SB(1, 0), cB + kstep, voffB); PG8_STAGE_A(PG8_SA(1, 0), cA + kstep, 0, vAc); PG8_STAGE(PG8_SB(1, 1), cB + hstepB + kstep, voffB);
        PG8_WAIT_V(6); PG8_BAR;
    } else {
        PG8_STAGE(PG8_SB(0, 0), cB, voffB); PG8_STAGE(PG8_SA(0, 0), cA, voffA); PG8_STAGE(PG8_SB(0, 1), cB + hstepB, voffB); PG8_STAGE(PG8_SA(0, 1), cA + hstepA, voffA);
        if (wr == 1) PG8_BAR;
        PG8_WAIT_V(4); PG8_BAR;
        PG8_STAGE(PG8_SB(1, 0), cB + kstep, voffB); PG8_STAGE(PG8_SA(1, 0), cA + kstep, voffA); PG8_STAGE(PG8_SB(1, 1), cB + hstepB + kstep, voffB);
        PG8_WAIT_V(6); PG8_BAR;
    }
    for (;;) {
        const bool has_next = S.next(ui + 1, nxt);
        const char* nA = (has_next && !GATHER) ? (const char*)g.A + (size_t)nxt.pm * tstepA : cA; if constexpr (GATHER) { u32x4 vn_; PG8_VA4((has_next ? nxt.pm : cur.pm), vn_.x, vn_.y, vn_.z, vn_.w); *vslot = vn_; } const char* nB = has_next ? (const char*)g.Bt + (size_t)nxt.e * estep + (size_t)nxt.pn * tstepB : cB;
        for (int t = 0; t < nt; t += 2) {
            const bool last = (t == nt - 2);
            const char* a1 = cA + (size_t)(t + 1) * kstep;
            const char* a2 = last ? nA : cA + (size_t)(t + 2) * kstep; const char* b2 = last ? nB : cB + (size_t)(t + 2) * kstep;
            const char* a3 = a2 + kstep; const char* b3 = b2 + kstep;
            if (last && has_next) S.a_ready(nxt);
            if constexpr (SP2) {
            PG8_LDB(B0, 0, 0); PG8_LDB(B1, 0, 1); PG8_SCHED; PG8_LDA(At, 0, 0); PG8_STAGE_A(PG8_SA(1, 1), a1, 1, vAc);
            if constexpr (GATHER) { if (last) { const u32x4 vn_ = *vslot; vAc[0][0] = vn_.x; vAc[0][1] = vn_.y; vAc[1][0] = vn_.z; vAc[1][1] = vn_.w; } }
            PG8_WAIT_V(8); PG8_WAIT_L(0); PG8_BAR; PG8_MMA(0, 0, At, B0); PG8_MMA(0, 1, At, B1); PG8_BAR; PG8_SCHED;
            PG8_LDA(At, 0, 1); PG8_STAGE(PG8_SB(0, 0), b2, voffB); PG8_STAGE(PG8_SB(0, 1), b2 + hstepB, voffB); PG8_STAGE_A(PG8_SA(0, 0), a2, 0, vAc);
            PG8_WAIT_V(8); PG8_WAIT_L(0); PG8_BAR; PG8_MMA(1, 0, At, B0); PG8_MMA(1, 1, At, B1); PG8_BAR; PG8_SCHED;
            PG8_LDB(B0, 1, 0); PG8_LDB(B1, 1, 1); PG8_SCHED; PG8_LDA(At, 1, 0); PG8_STAGE_A(PG8_SA(0, 1), a2, 1, vAc);
            PG8_WAIT_V(8); PG8_WAIT_L(0); PG8_BAR; PG8_MMA(0, 0, At, B0); PG8_MMA(0, 1, At, B1); PG8_BAR; PG8_SCHED;
            PG8_LDA(At, 1, 1); PG8_STAGE(PG8_SB(1, 0), b3, voffB); PG8_STAGE(PG8_SB(1, 1), b3 + hstepB, voffB); PG8_STAGE_A(PG8_SA(1, 0), a3, 0, vAc);
            PG8_WAIT_V(8); PG8_WAIT_L(0); PG8_BAR; PG8_MMA(1, 0, At, B0); PG8_MMA(1, 1, At, B1); PG8_BAR; PG8_SCHED;
            } else {
            PG8_LDB(B0, 0, 0); PG8_SCHED; PG8_LDA(At, 0, 0); PG8_STAGE(PG8_SA(1, 1), a1 + hstepA, voffA);
            PG8_WAIT_L(8); PG8_BAR; PG8_WAIT_L(0); PG8_MMA(0, 0, At, B0); PG8_BAR; PG8_SCHED;
            PG8_LDB(B1, 0, 1); PG8_STAGE(PG8_SB(0, 0), b2, voffB);
            PG8_BAR; PG8_WAIT_L(0); PG8_MMA(0, 1, At, B1); PG8_BAR;
            PG8_LDA(At, 0, 1); PG8_STAGE(PG8_SA(0, 0), a2, voffA);
            PG8_BAR; PG8_WAIT_L(0); PG8_MMA(1, 0, At, B0); PG8_BAR; PG8_SCHED;
            PG8_STAGE(PG8_SB(0, 1), b2 + hstepB, voffB);
            PG8_WAIT_V(6); PG8_BAR; PG8_MMA(1, 1, At, B1); PG8_BAR;
            PG8_LDB(B0, 1, 0); PG8_SCHED; PG8_LDA(At, 1, 0); PG8_STAGE(PG8_SA(0, 1), a2 + hstepA, voffA);
            PG8_WAIT_L(8); PG8_BAR; PG8_WAIT_L(0); PG8_MMA(0, 0, At, B0); PG8_BAR; PG8_SCHED;
            PG8_LDB(B1, 1, 1); PG8_STAGE(PG8_SB(1, 0), b3, voffB);
            PG8_BAR; PG8_WAIT_L(0); PG8_MMA(0, 1, At, B1); PG8_BAR;
            PG8_LDA(At, 1, 1); PG8_STAGE(PG8_SA(1, 0), a3, voffA);
            PG8_BAR; PG8_WAIT_L(0); PG8_MMA(1, 0, At, B0); PG8_BAR; PG8_SCHED;
            PG8_STAGE(PG8_SB(1, 1), b3 + hstepB, voffB);
            PG8_WAIT_V(6); PG8_BAR; PG8_MMA(1, 1, At, B1); PG8_BAR;
            }
        }
        if constexpr (ALIGN_EPI) { if (wr == 0) PG8_BAR; }
        if constexpr (!Epi::AFTER_DRAIN) { E(acc, cur, wr, wc, fr, fq); S.done(cur); }
        if (!has_next) break;
#pragma unroll
        for (int a = 0; a < 2; ++a)
#pragma unroll
            for (int b = 0; b < 2; ++b)
#pragma unroll
                for (int m = 0; m < 4; ++m)
#pragma unroll
                    for (int n = 0; n < 2; ++n) acc[a][b][m][n] = (f32x4){0.f, 0.f, 0.f, 0.f};
        cur = nxt; cA = nA; cB = nB; ++ui;
        if constexpr (ALIGN_EPI) { if (wr == 1) PG8_BAR; }
    }
    PG8_WAIT_V(0);
    if constexpr (!ALIGN_EPI) { if (wr == 0) PG8_BAR; }
    PG8_BAR;
    if constexpr (Epi::AFTER_DRAIN) { E.fused(acc, cur, wr, wc, fr, fq, lds, wid, lane); S.done(cur); }
#undef PG8_VA
#undef PG8_SA
#undef PG8_SB
#undef PG8_STAGE
#undef PG8_LDA
#undef PG8_LDB
#undef PG8_MMA
#undef PG8_WAIT_V
#undef PG8_WAIT_L
#undef PG8_BAR
#undef PG8_SCHED
}
}

struct F8Bf16 { bf16_t* out; int ld;
    DEVI void operator()(int row, int col, f32x4 a, f32x4 b) const { unsigned long long ob_ = (unsigned long long)out; asm volatile("" : "+s"(ob_)); bf16_t* out = (bf16_t*)ob_;        u32x4 w; w.x = pk2(a.x, a.y); w.y = pk2(a.z, a.w); w.z = pk2(b.x, b.y); w.w = pk2(b.z, b.w); *(u32x4*)(out + (size_t)row * ld + col) = w; } };
struct F8Resid { const float* x; bf16_t* out;
    DEVI void operator()(int row, int col, f32x4 a, f32x4 b) const { const float* xp = x + (size_t)row * DM + col;
        a = a + *(const f32x4*)xp; b = b + *(const f32x4*)(xp + 4);
        u32x4 w; w.x = pk2(a.x, a.y); w.y = pk2(a.z, a.w); w.z = pk2(b.x, b.y); w.w = pk2(b.z, b.w); *(u32x4*)(out + (size_t)row * DM + col) = w; } };
struct F8Swiglu { bf16_t* hid;
    DEVI void operator()(int row, int col, f32x4 a, f32x4 b) const {
        const unsigned w = pk4_fp8(a.x * sigmoidf_(a.x) * a.y * F8_ASCALE, a.z * sigmoidf_(a.z) * a.w * F8_ASCALE, b.x * sigmoidf_(b.x) * b.y * F8_ASCALE, b.z * sigmoidf_(b.z) * b.w * F8_ASCALE);
        *(unsigned*)((unsigned char*)hid + (size_t)row * DEXP + (col >> 1)) = w; } };
struct F8Mix { const bf16_t* gl; const bf16_t* bm; bf16_t* mixed; const float* gb;
    DEVI void operator()(int row, int col, f32x4 a, f32x4 b) const {
        const u32x4 g1 = *(const u32x4*)(gl + (size_t)row * 2048 + col), g2 = *(const u32x4*)(gl + (size_t)row * 2048 + 1024 + col);
        const u32x4 m = *(const u32x4*)(bm + (size_t)row * 1024 + col);
        const f32x4 b0a = *(const f32x4*)(gb + col), b0b = *(const f32x4*)(gb + col + 4), b1a = *(const f32x4*)(gb + 1024 + col), b1b = *(const f32x4*)(gb + 1024 + col + 4);
        float r[8];
        r[0] = sigmoidf_(lo16(g1.x) + b0a.x) * lo16(m.x) + sigmoidf_(lo16(g2.x) + b1a.x) * a.x;
        r[1] = sigmoidf_(hi16(g1.x) + b0a.y) * hi16(m.x) + sigmoidf_(hi16(g2.x) + b1a.y) * a.y;
        r[2] = sigmoidf_(lo16(g1.y) + b0a.z) * lo16(m.y) + sigmoidf_(lo16(g2.y) + b1a.z) * a.z;
        r[3] = sigmoidf_(hi16(g1.y) + b0a.w) * hi16(m.y) + sigmoidf_(hi16(g2.y) + b1a.w) * a.w;
        r[4] = sigmoidf_(lo16(g1.z) + b0b.x) * lo16(m.z) + sigmoidf_(lo16(g2.z) + b1b.x) * b.x;
        r[5] = sigmoidf_(hi16(g1.z) + b0b.y) * hi16(m.z) + sigmoidf_(hi16(g2.z) + b1b.y) * b.y;
        r[6] = sigmoidf_(lo16(g1.w) + b0b.z) * lo16(m.w) + sigmoidf_(lo16(g2.w) + b1b.z) * b.z;
        r[7] = sigmoidf_(hi16(g1.w) + b0b.w) * hi16(m.w) + sigmoidf_(hi16(g2.w) + b1b.w) * b.w;
        u32x4 w; w.x = pk2(r[0], r[1]); w.y = pk2(r[2], r[3]); w.z = pk2(r[4], r[5]); w.w = pk2(r[6], r[7]);
        *(u32x4*)(mixed + (size_t)row * 1024 + col) = w; } };
template <class F, bool GATHER = false, bool F8 = false>
DEVI void big_gemm_(char* lds, const bf16_t* A, int lda, const bf16_t* Bt, int ldb, int M, int N, int K, const F& f, int bid, int nb, const int* blk_e, size_t estride, const int* rowidx) {
    int Kr = K; asm volatile("" : "+s"(Kr));
    pg8::Gemm g{A, Bt, M, N, Kr, lda, ldb, estride, rowidx}; pg8::StaticOrder S; S.init(M, N, nb, bid, blk_e);
    pg8::Epi8<F> E{f};
    pg8::gemm_phase<pg8::Epi8<F>, pg8::StaticOrder, true, true, GATHER, F8>((PG8_LAS unsigned char*)lds, g, S, E);
}
template <class E, class Sched, bool F8>
DEVI void big_gemm_es(char* lds, const bf16_t* A, int lda, const bf16_t* Bt, int ldb, int M, int N, int K, const E& e, const Sched& S) {
    int Kr = K; asm volatile("" : "+s"(Kr));
    pg8::Gemm g{A, Bt, M, N, Kr, lda, ldb, 0, nullptr};
    pg8::gemm_phase<E, Sched, true, true, false, F8>((PG8_LAS unsigned char*)lds, g, S, e);
}
template <class F, bool GATHER, class Sched, bool F8 = false>
DEVI void big_gemm_s(char* lds, const bf16_t* A, int lda, const bf16_t* Bt, int ldb, int M, int N, int K, const F& f, const Sched& S, size_t estride, const int* rowidx) {
    int Kr = K; asm volatile("" : "+s"(Kr));
    pg8::Gemm g{A, Bt, M, N, Kr, lda, ldb, estride, rowidx};
    pg8::Epi8<F> E{f};
    pg8::gemm_phase<pg8::Epi8<F>, Sched, true, true, GATHER, F8>((PG8_LAS unsigned char*)lds, g, S, E);
}
template <class F>
DEVI void big_gemm(char* lds, const bf16_t* A, int lda, const bf16_t* Bt, int ldb, int M, int N, int K, const F& f, int bid, int nb, const int* blk_e = nullptr, size_t estride = 0) {
    big_gemm_<F, false>(lds, A, lda, Bt, ldb, M, N, K, f, bid, nb, blk_e, estride, nullptr);
}

struct EpiGate { static constexpr bool PERM = true, AFTER_DRAIN = false; const bf16_t* bm; const bf16_t* br; bf16_t* mixed; const float* gb;
    __device__ __forceinline__ void operator()(const f32x4 (&acc)[2][2][4][2], const pg8::Unit& u, int wr, int wc, int fr, int fq) const {
        { const int l_ = my_tid() & 63; fr = l_ & 15; fq = l_ >> 4; }
        const int oc = u.pn * 128 + wc * 32 + 8 * fq;
        const f32x4 b0a = *(const f32x4*)(gb + oc), b0b = *(const f32x4*)(gb + oc + 4), b1a = *(const f32x4*)(gb + 1024 + oc), b1b = *(const f32x4*)(gb + 1024 + oc + 4);
#pragma unroll
        for (int ai = 0; ai < 2; ++ai)
#pragma unroll
            for (int m = 0; m < 4; ++m) { const int row = u.pm * pg8::BM + ai * pg8::HALF + wr * 64 + m * 16 + fr;
                const u32x4 mm = *(const u32x4*)(bm + (size_t)row * 1024 + oc), rr = *(const u32x4*)(br + (size_t)row * 1024 + oc);
                const f32x4 g1a = acc[ai][0][m][0], g1b = acc[ai][0][m][1], g2a = acc[ai][1][m][0], g2b = acc[ai][1][m][1];
                float r[8];
                r[0] = sigmoidf_(g1a.x + b0a.x) * lo16(mm.x) + sigmoidf_(g2a.x + b1a.x) * lo16(rr.x);
                r[1] = sigmoidf_(g1a.y + b0a.y) * hi16(mm.x) + sigmoidf_(g2a.y + b1a.y) * hi16(rr.x);
                r[2] = sigmoidf_(g1a.z + b0a.z) * lo16(mm.y) + sigmoidf_(g2a.z + b1a.z) * lo16(rr.y);
                r[3] = sigmoidf_(g1a.w + b0a.w) * hi16(mm.y) + sigmoidf_(g2a.w + b1a.w) * hi16(rr.y);
                r[4] = sigmoidf_(g1b.x + b0b.x) * lo16(mm.z) + sigmoidf_(g2b.x + b1b.x) * lo16(rr.z);
                r[5] = sigmoidf_(g1b.y + b0b.y) * hi16(mm.z) + sigmoidf_(g2b.y + b1b.y) * hi16(rr.z);
                r[6] = sigmoidf_(g1b.z + b0b.z) * lo16(mm.w) + sigmoidf_(g2b.z + b1b.z) * lo16(rr.w);
                r[7] = sigmoidf_(g1b.w + b0b.w) * hi16(mm.w) + sigmoidf_(g2b.w + b1b.w) * hi16(rr.w);
                u32x2 w; w.x = pk4_fp8(r[0] * F8_ASCALE, r[1] * F8_ASCALE, r[2] * F8_ASCALE, r[3] * F8_ASCALE); w.y = pk4_fp8(r[4] * F8_ASCALE, r[5] * F8_ASCALE, r[6] * F8_ASCALE, r[7] * F8_ASCALE);
                *(u32x2*)((unsigned char*)mixed + (size_t)row * 1024 + oc) = w; }
    }
};
template <class E, bool F8 = false>
DEVI void big_gemm_epi(char* lds, const bf16_t* A, int lda, const bf16_t* Bt, int ldb, int M, int N, int K, const E& e, int bid, int nb) {
    int Kr = K; asm volatile("" : "+s"(Kr));
    pg8::Gemm g{A, Bt, M, N, Kr, lda, ldb, 0, nullptr}; pg8::StaticOrder S; S.init(M, N, nb, bid, nullptr);
    pg8::gemm_phase<E, pg8::StaticOrder, true, true, false, F8>((PG8_LAS unsigned char*)lds, g, S, e);
}

DEVI void stage_mla_prep(const Params& p, char* lds, int bid, int nb, bool dry = false) {
    const int tid = my_tid(), lane = tid & 63, wave = tid >> 6;
    const int gw = bid * NWAVES + wave, NGW = nb * NWAVES;
    bf16_t* z = (bf16_t*)(p.ws + OFF_Z); bf16_t* krope = (bf16_t*)(p.ws + OFF_KROPE);
    const float* ct = (const float*)(p.ws + OFF_ROPE); const float* st = ct + SEQ * 16;
    const float* gq = p.in[3]; const float* gkv = p.in[4];
    {
        const unsigned char* wkr = p.ws + OFF_WKR;
        u32x4 w8[4];
#pragma unroll
        for (int i = 0; i < 4; ++i) { const int q = tid + 512 * i; w8[i] = *(const u32x4*)(wkr + (size_t)(q >> 6) * DM + (q & 63) * 16); }
#pragma unroll
        for (int i = 0; i < 4; ++i) { const int q = tid + 512 * i; *(u32x4*)(lds + (q >> 6) * 1040 + (q & 63) * 16) = w8[i]; }
    }
    {
        const bool isq = lane < 48;
        const float* g0p = isq ? gq + 8 * lane : gkv + 8 * (lane - 48); const float* g1p = gkv + 8 * ((lane & 15) + 16);
        const f32x4 g0a = *(const f32x4*)g0p, g0b = *(const f32x4*)(g0p + 4), g1a = *(const f32x4*)g1p, g1b = *(const f32x4*)(g1p + 4);
        const float g0[8] = {g0a.x, g0a.y, g0a.z, g0a.w, g0b.x, g0b.y, g0b.z, g0b.w}, g1[8] = {g1a.x, g1a.y, g1a.z, g1a.w, g1b.x, g1b.y, g1b.z, g1b.w};
        for (int tq = gw * 8; tq < T_; tq += NGW * 8) {
            u32x4 A[8], B[8];
#pragma unroll
            for (int q = 0; q < 8; ++q) { bf16_t* zr = z + (size_t)(tq + q) * LDZ; A[q] = *(const u32x4*)(zr + 8 * lane); B[q] = (u32x4){0u, 0u, 0u, 0u}; if (lane < 16) B[q] = *(const u32x4*)(zr + 512 + 8 * lane); }
#pragma unroll
            for (int q = 0; q < 8; ++q) {
                bf16_t* zr = z + (size_t)(tq + q) * LDZ;
                float a[8], b[8]; unpack8(A[q], a); unpack8(B[q], b);
                float sa = 0.f, sb = 0.f;
#pragma unroll
                for (int j = 0; j < 8; ++j) { sa += a[j] * a[j]; sb += b[j] * b[j]; }
                const float ssq = wave_sum(isq ? sa : 0.f), sskv = wave_sum((isq ? 0.f : sa) + sb);
                const float rq = rsqrtf(ssq * (1.f / 384.f) + 1e-6f), rkv = rsqrtf(sskv * (1.f / 256.f) + 1e-6f);
                const float r = isq ? rq : rkv;
                float oa[8], ob[8];
#pragma unroll
                for (int j = 0; j < 8; ++j) { oa[j] = a[j] * r * g0[j]; ob[j] = b[j] * rkv * g1[j]; }
                const u32x4 o = pack8(oa), o2 = pack8(ob);
                u32x2 ka, kb; ka.x = pk4_fp8(oa[0] * F8_ASCALE, oa[1] * F8_ASCALE, oa[2] * F8_ASCALE, oa[3] * F8_ASCALE); ka.y = pk4_fp8(oa[4] * F8_ASCALE, oa[5] * F8_ASCALE, oa[6] * F8_ASCALE, oa[7] * F8_ASCALE);
                kb.x = pk4_fp8(ob[0] * F8_ASCALE, ob[1] * F8_ASCALE, ob[2] * F8_ASCALE, ob[3] * F8_ASCALE); kb.y = pk4_fp8(ob[4] * F8_ASCALE, ob[5] * F8_ASCALE, ob[6] * F8_ASCALE, ob[7] * F8_ASCALE);
                unsigned char* k8 = p.ws + OFF_CKV8 + (size_t)(tq + q) * 256;
                if (!dry) { if (isq) *(u32x4*)(zr + 8 * lane) = o; else *(u32x2*)(k8 + 8 * (lane - 48)) = ka; if (lane < 16) *(u32x2*)(k8 + 128 + 8 * lane) = kb; }
                else { asm volatile("" :: "v"(o)); asm volatile("" :: "v"(o2)); asm volatile("" :: "v"(ka)); asm volatile("" :: "v"(kb)); }
            }
        }
    }
    __syncthreads();
    const unsigned char* hb = p.ws + OFF_H8;
    for (int tb = gw * 16; tb < T_; tb += NGW * 16) {
        const int li = lane & 15, kq = lane >> 4;
        const unsigned char* ap = hb + (size_t)(tb + li) * DM + 32 * kq;
        u32x4 av[16];
#pragma unroll
        for (int ks = 0; ks < 8; ++ks) { av[2 * ks] = *(const u32x4*)(ap + 128 * ks); av[2 * ks + 1] = *(const u32x4*)(ap + 128 * ks + 16); }
        const char* bl = lds + li * 1040 + kq * 32;
        f32x4 a0 = {0.f, 0.f, 0.f, 0.f}, a1 = a0;
#pragma unroll
        for (int ks = 0; ks < 8; ++ks) {
            if ((ks & 1) == 0) asm volatile("" ::: "memory");
            const pg8::i32x8 af = __builtin_shufflevector(__builtin_bit_cast(pg8::i32x4, av[2 * ks]), __builtin_bit_cast(pg8::i32x4, av[2 * ks + 1]), 0, 1, 2, 3, 4, 5, 6, 7);
            const pg8::i32x8 b0 = __builtin_shufflevector(*(const pg8::i32x4*)(bl + 128 * ks), *(const pg8::i32x4*)(bl + 128 * ks + 16), 0, 1, 2, 3, 4, 5, 6, 7);
            const pg8::i32x8 b1 = __builtin_shufflevector(*(const pg8::i32x4*)(bl + 16 * 1040 + 128 * ks), *(const pg8::i32x4*)(bl + 16 * 1040 + 128 * ks + 16), 0, 1, 2, 3, 4, 5, 6, 7);
            a0 = __builtin_amdgcn_mfma_scale_f32_16x16x128_f8f6f4(af, b0, a0, 0, 0, 0, F8_ASC_E8, 0, F8_WSC_E8);
            a1 = __builtin_amdgcn_mfma_scale_f32_16x16x128_f8f6f4(af, b1, a1, 0, 0, 0, F8_ASC_E8, 0, F8_WSC_E8);
        }
#pragma unroll
        for (int r = 0; r < 4; ++r) { const int t = tb + 4 * kq + r, pos = t & (SEQ - 1);
            const float c = ct[pos * 16 + li], s = st[pos * 16 + li];
            if (!dry) { krope[(size_t)t * 32 + li] = (bf16_t)f2bf(a0[r] * c - a1[r] * s); krope[(size_t)t * 32 + 16 + li] = (bf16_t)f2bf(a0[r] * s + a1[r] * c); } }
    }
    __syncthreads();
}

DEVI void stage_twad_prep(const Params& p, int bid, int nb) {
    const bf16_t* z = (const bf16_t*)(p.ws + OFF_Z); bf16_t* twad = (bf16_t*)(p.ws + OFF_TWAD);
    const int tid = my_tid(), c = (tid & 31) * 8;
    const f32x4 a0 = *(const f32x4*)(p.in[8] + 1536 + c), a1 = *(const f32x4*)(p.in[8] + 1536 + c + 4), b0 = *(const f32x4*)(p.in[9] + 1536 + c), b1 = *(const f32x4*)(p.in[9] + 1536 + c + 4);
    const float mp[8] = {a0.x, a0.y, a0.z, a0.w, a1.x, a1.y, a1.z, a1.w}, mn[8] = {b0.x, b0.y, b0.z, b0.w, b1.x, b1.y, b1.z, b1.w};
    const int tstep = nb * (NTHREADS / 32);
    for (int t0 = (bid * NTHREADS + tid) >> 5; t0 < T_; t0 += 8 * tstep) {
        const u32x4 z4 = {0u, 0u, 0u, 0u};
        u32x4 w0[8], wm[8], wn[8];
#pragma unroll
        for (int q = 0; q < 8; ++q) { const int t = t0 + q * tstep; w0[q] = z4; wm[q] = z4; wn[q] = z4;
            if (t < T_) { const int s_ = t & (SEQ - 1); const bf16_t* zp = z + (size_t)t * LDZ + ZR + 1536 + c;
                w0[q] = *(const u32x4*)zp; if (s_ > 0) wm[q] = *(const u32x4*)(zp - LDZ); if (s_ < SEQ - 1) wn[q] = *(const u32x4*)(zp + LDZ); } }
#pragma unroll
        for (int q = 0; q < 8; ++q) { const int t = t0 + q * tstep;
            if (t < T_) {
                float z0[8], zm[8], zn[8], r[8]; unpack8(w0[q], z0); unpack8(wm[q], zm); unpack8(wn[q], zn);
#pragma unroll
                for (int j = 0; j < 8; ++j) { const float v = z0[j] + mp[j] * (zm[j] - z0[j]) + mn[j] * (zn[j] - z0[j]); r[j] = (c < 128) ? 1.f - 2.f * __builtin_amdgcn_rcpf(1.f + __expf(2.f * v)) : v; }
                *(u32x4*)(twad + (size_t)t * 256 + c) = pack8(r);
            } }
    }
}

DEVI void stage_sg_prep(const Params& p, int bid, int nb) {
    const bf16_t* z = (const bf16_t*)(p.ws + OFF_Z); bf16_t* sg = (bf16_t*)((char*)p.out + DOFF_SG);
    const int tid = my_tid(), c = (tid & 31) * 8;
    float mp[8], mn[8];
#pragma unroll
    for (int j = 0; j < 8; ++j) { mp[j] = 0.f; mn[j] = 0.f; }
    if (c < 128) {
        const f32x4 a0 = *(const f32x4*)(p.in[8] + 1792 + c), a1 = *(const f32x4*)(p.in[8] + 1792 + c + 4), b0 = *(const f32x4*)(p.in[9] + 1792 + c), b1 = *(const f32x4*)(p.in[9] + 1792 + c + 4);
        mp[0] = a0.x; mp[1] = a0.y; mp[2] = a0.z; mp[3] = a0.w; mp[4] = a1.x; mp[5] = a1.y; mp[6] = a1.z; mp[7] = a1.w;
        mn[0] = b0.x; mn[1] = b0.y; mn[2] = b0.z; mn[3] = b0.w; mn[4] = b1.x; mn[5] = b1.y; mn[6] = b1.z; mn[7] = b1.w;
    }
    const int tstep = nb * (NTHREADS / 32);
    for (int t0 = (bid * NTHREADS + tid) >> 5; t0 < T_; t0 += 8 * tstep) {
        const u32x4 z4 = {0u, 0u, 0u, 0u};
        u32x4 w0[8], wm[8], wn[8];
#pragma unroll
        for (int q = 0; q < 8; ++q) { const int t = t0 + q * tstep; w0[q] = z4; wm[q] = z4; wn[q] = z4;
            if (c < 128 && t < T_) { const int s_ = t & (SEQ - 1); const bf16_t* zp = z + (size_t)t * LDZ + ZR + 1792 + c;
                w0[q] = *(const u32x4*)zp; if (s_ > 0) wm[q] = *(const u32x4*)(zp - LDZ); if (s_ < SEQ - 1) wn[q] = *(const u32x4*)(zp + LDZ); } }
#pragma unroll
        for (int q = 0; q < 8; ++q) { const int t = t0 + q * tstep;
            if (t < T_) {
                u32x4 o = z4;
                if (c < 128) {
                    float z0[8], zm[8], zn[8], r[8]; unpack8(w0[q], z0); unpack8(wm[q], zm); unpack8(wn[q], zn);
#pragma unroll
                    for (int j = 0; j < 8; ++j) r[j] = sigmoidf_(z0[j] + mp[j] * (zm[j] - z0[j]) + mn[j] * (zn[j] - z0[j]));
                    o = pack8(r);
                }
                if (c < 128) *(u32x4*)(sg + (size_t)t * 256 + c) = o;
            } }
    }
}

DEVI float max3f_(float a, float b, float c) { return __builtin_fmaxf(__builtin_fmaxf(a, b), c); }
constexpr int KROW = 208, VROW = 192;
constexpr int ATT_KB = 64 * KROW, ATT_VB = 64 * VROW;
DEVI void attn_unit(const Params& p, int u, char* lds) {
    const int tid = my_tid(), lane = tid & 63, wid = tid >> 6, r32 = lane & 31, hi = lane >> 5;
    const int bh = u >> 3, qb = u & 7, b = bh >> 3, h = bh & 7;
    const bf16_t* qraw = (const bf16_t*)((const char*)p.out + DOFF_QRAW);
    const bf16_t* kvraw = (const bf16_t*)((const char*)p.out + DOFF_KVRAW);
    const bf16_t* krope = (const bf16_t*)(p.ws + OFF_KROPE);
    const float* ct = (const float*)(p.ws + OFF_ROPE); const float* st = ct + SEQ * 16;
    bf16_t* omla = (bf16_t*)(p.ws + OFF_OMLA);
    const size_t rowb = (size_t)b * SEQ;
    const int sq = qb * 256 + wid * 32 + r32;
    const float QS = 0.10206207261596577f * 1.4426950408889634f;
    bf16x8 qf[6];
    {
        const bf16_t* qp = qraw + (rowb + sq) * 768 + h * 96;
        u32x4 w[6];
#pragma unroll
        for (int ks = 0; ks < 6; ++ks) w[ks] = *(const u32x4*)(qp + 16 * ks + 8 * hi);
#pragma unroll
        for (int ks = 0; ks < 4; ++ks) {
            u32x4 o; o.x = pk2(lo16(w[ks].x) * QS, hi16(w[ks].x) * QS); o.y = pk2(lo16(w[ks].y) * QS, hi16(w[ks].y) * QS);
            o.z = pk2(lo16(w[ks].z) * QS, hi16(w[ks].z) * QS); o.w = pk2(lo16(w[ks].w) * QS, hi16(w[ks].w) * QS);
            qf[ks] = __builtin_bit_cast(bf16x8, o);
        }
        float x1[8], x2[8], y1[8], y2[8];
        x1[0] = lo16(w[4].x); x1[1] = hi16(w[4].x); x1[2] = lo16(w[4].y); x1[3] = hi16(w[4].y); x1[4] = lo16(w[4].z); x1[5] = hi16(w[4].z); x1[6] = lo16(w[4].w); x1[7] = hi16(w[4].w);
        x2[0] = lo16(w[5].x); x2[1] = hi16(w[5].x); x2[2] = lo16(w[5].y); x2[3] = hi16(w[5].y); x2[4] = lo16(w[5].z); x2[5] = hi16(w[5].z); x2[6] = lo16(w[5].w); x2[7] = hi16(w[5].w);
#pragma unroll
        for (int j = 0; j < 8; ++j) { const float c = ct[sq * 16 + 8 * hi + j], s = st[sq * 16 + 8 * hi + j]; y1[j] = (x1[j] * c - x2[j] * s) * QS; y2[j] = (x1[j] * s + x2[j] * c) * QS; }
        u32x4 o4, o5;
        o4.x = pk2(y1[0], y1[1]); o4.y = pk2(y1[2], y1[3]); o4.z = pk2(y1[4], y1[5]); o4.w = pk2(y1[6], y1[7]);
        o5.x = pk2(y2[0], y2[1]); o5.y = pk2(y2[2], y2[3]); o5.z = pk2(y2[4], y2[5]); o5.w = pk2(y2[6], y2[7]);
        qf[4] = __builtin_bit_cast(bf16x8, o4); qf[5] = __builtin_bit_cast(bf16x8, o5);
    }
    const int kp0r = tid / 12, kp0c = tid % 12;
    const int kp1 = 512 + tid, kp1r = kp1 / 12, kp1c = kp1 % 12;
    const int vr = tid >> 3, vc = tid & 7;
    u32x4 rk0, rk1, rv;
#define A_LOAD(t) do { const size_t base = rowb + (size_t)(t) * 64; \
        rk0 = (kp0c < 8) ? *(const u32x4*)(kvraw + (base + kp0r) * 1024 + h * 128 + 8 * kp0c) : *(const u32x4*)(krope + (base + kp0r) * 32 + 8 * (kp0c - 8)); \
        if (tid < 256) rk1 = (kp1c < 8) ? *(const u32x4*)(kvraw + (base + kp1r) * 1024 + h * 128 + 8 * kp1c) : *(const u32x4*)(krope + (base + kp1r) * 32 + 8 * (kp1c - 8)); \
        rv = *(const u32x4*)(kvraw + (base + vr) * 1024 + h * 128 + 64 + 8 * vc); } while (0)
#define A_STORE(buf) do { char* Kb_ = lds + (buf) * ATT_KB; char* Vb_ = lds + 2 * ATT_KB + (buf) * ATT_VB; \
        *(u32x4*)(Kb_ + kp0r * KROW + kp0c * 16) = rk0; if (tid < 256) *(u32x4*)(Kb_ + kp1r * KROW + kp1c * 16) = rk1; \
        *(u32x4*)(Vb_ + vr * VROW + vc * 16) = rv; } while (0)
    float mhat = 0.f, l = 0.f;
    f32x16 o0, o1, negm;
#pragma unroll
    for (int r = 0; r < 16; ++r) { o0[r] = 0.f; o1[r] = 0.f; negm[r] = 0.f; }
    A_LOAD(0); A_STORE(0); __syncthreads();
    constexpr int NT = SEQ / 64;
    for (int t = 0; t < NT; ++t) {
        const int buf = t & 1;
        if (t + 1 < NT) A_LOAD(t + 1);
        const char* Kb = lds + buf * ATT_KB; const char* Vb = lds + 2 * ATT_KB + buf * ATT_VB;
        f32x16 p0 = negm, p1 = negm;
#pragma unroll
        for (int ks = 0; ks < 6; ++ks) {
            const bf16x8 k0 = *(const bf16x8*)(Kb + r32 * KROW + 32 * ks + 16 * hi);
            const bf16x8 k1 = *(const bf16x8*)(Kb + (32 + r32) * KROW + 32 * ks + 16 * hi);
            p0 = __builtin_amdgcn_mfma_f32_32x32x16_bf16(k0, qf[ks], p0, 0, 0, 0);
            p1 = __builtin_amdgcn_mfma_f32_32x32x16_bf16(k1, qf[ks], p1, 0, 0, 0);
        }
        float mxa = max3f_(p0[0], p0[1], p1[0]), mxb = max3f_(p0[2], p0[3], p1[1]); mxa = max3f_(mxa, p1[2], p1[3]);
#pragma unroll
        for (int r = 4; r < 16; r += 4) { mxa = max3f_(mxa, p0[r], p0[r + 1]); mxb = max3f_(mxb, p0[r + 2], p0[r + 3]); mxa = max3f_(mxa, p1[r], p1[r + 1]); mxb = max3f_(mxb, p1[r + 2], p1[r + 3]); }
        float rm = max3f_(mxa, mxb, mxb);
        if (t == 0 || __any(rm > 8.f)) {
            rm = max3f_(rm, __shfl_xor(rm, 32), rm);
            const float dl = (t == 0) ? rm : fmaxf(rm, 0.f); mhat += dl;
            const float f = __builtin_amdgcn_exp2f(-dl); l *= f;
#pragma unroll
            for (int r = 0; r < 16; ++r) { p0[r] -= dl; p1[r] -= dl; o0[r] *= f; o1[r] *= f; negm[r] = -mhat; }
        }
        float sum = 0.f;
#pragma unroll
        for (int r = 0; r < 16; ++r) { p0[r] = __builtin_amdgcn_exp2f(p0[r]); p1[r] = __builtin_amdgcn_exp2f(p1[r]); sum += p0[r] + p1[r]; }
        l += sum;
        bf16x8 pb[4];
        {
            u32x4 w;
            w.x = pk2(p0[0], p0[1]); w.y = pk2(p0[2], p0[3]); w.z = pk2(p0[4], p0[5]); w.w = pk2(p0[6], p0[7]); pb[0] = __builtin_bit_cast(bf16x8, w);
            w.x = pk2(p0[8], p0[9]); w.y = pk2(p0[10], p0[11]); w.z = pk2(p0[12], p0[13]); w.w = pk2(p0[14], p0[15]); pb[1] = __builtin_bit_cast(bf16x8, w);
            w.x = pk2(p1[0], p1[1]); w.y = pk2(p1[2], p1[3]); w.z = pk2(p1[4], p1[5]); w.w = pk2(p1[6], p1[7]); pb[2] = __builtin_bit_cast(bf16x8, w);
            w.x = pk2(p1[8], p1[9]); w.y = pk2(p1[10], p1[11]); w.z = pk2(p1[12], p1[13]); w.w = pk2(p1[14], p1[15]); pb[3] = __builtin_bit_cast(bf16x8, w);
        }
#pragma unroll
        for (int s = 0; s < 4; ++s) {
            const char* vtp = Vb + (16 * s + 4 * hi + ((lane & 15) >> 2)) * VROW + (16 * ((lane >> 4) & 1) + 4 * (lane & 3)) * 2;
            const s16x4 a0 = vtr_(vtp), a1 = vtr_(vtp + 8 * VROW);
            const s16x4 c0 = vtr_(vtp + 64), c1 = vtr_(vtp + 8 * VROW + 64);
            const bf16x8 va0 = {a0[0], a0[1], a0[2], a0[3], a1[0], a1[1], a1[2], a1[3]};
            const bf16x8 va1 = {c0[0], c0[1], c0[2], c0[3], c1[0], c1[1], c1[2], c1[3]};
            o0 = __builtin_amdgcn_mfma_f32_32x32x16_bf16(va0, pb[s], o0, 0, 0, 0);
            o1 = __builtin_amdgcn_mfma_f32_32x32x16_bf16(va1, pb[s], o1, 0, 0, 0);
        }
        if (t + 1 < NT) A_STORE(buf ^ 1);
        __syncthreads();
    }
#undef A_LOAD
#undef A_STORE
    l += __shfl_xor(l, 32);
    const float inv = 1.f / l;
    unsigned char* op = (unsigned char*)omla + (rowb + sq) * 512 + h * 64;
    const float inv8 = inv * F8_ASCALE;
#pragma unroll
    for (int g = 0; g < 4; ++g) {
        const int d0 = 8 * g + 4 * hi;
        *(unsigned*)(op + d0) = pk4_fp8(o0[4 * g] * inv8, o0[4 * g + 1] * inv8, o0[4 * g + 2] * inv8, o0[4 * g + 3] * inv8);
        *(unsigned*)(op + 32 + d0) = pk4_fp8(o1[4 * g] * inv8, o1[4 * g + 1] * inv8, o1[4 * g + 2] * inv8, o1[4 * g + 3] * inv8);
    }
}

typedef _Float16 f16x4 __attribute__((ext_vector_type(4)));
typedef _Float16 f16x8 __attribute__((ext_vector_type(8)));
DEVI float dppx1(float x) { return __int_as_float(__builtin_amdgcn_update_dpp(0, __float_as_int(x), 0xB1, 0xF, 0xF, false)); }
DEVI float dppx2(float x) { return __int_as_float(__builtin_amdgcn_update_dpp(0, __float_as_int(x), 0x4E, 0xF, 0xF, false)); }
DEVI float dpphm(float x) { return __int_as_float(__builtin_amdgcn_update_dpp(0, __float_as_int(x), 0x141, 0xF, 0xF, false)); }
DEVI float red8(float x) { x += dppx1(x); x += dppx2(x); x += dpphm(x); return x; }
DEVI float fmix_lo(float a, unsigned h, float c) { float d; asm("v_fma_mix_f32 %0, %1, %2, %3 op_sel_hi:[0,1,0]" : "=v"(d) : "v"(a), "v"(h), "v"(c)); return d; }
DEVI float fmix_hi(float a, unsigned h, float c) { float d; asm("v_fma_mix_f32 %0, %1, %2, %3 op_sel:[0,1,0] op_sel_hi:[0,1,0]" : "=v"(d) : "v"(a), "v"(h), "v"(c)); return d; }
DEVI float mmix_lo(float a, unsigned h) { float d; asm("v_fma_mix_f32 %0, %1, %2, 0 op_sel_hi:[0,1,0]" : "=v"(d) : "v"(a), "v"(h)); return d; }
DEVI float mmix_hi(float a, unsigned h) { float d; asm("v_fma_mix_f32 %0, %1, %2, 0 op_sel:[0,1,0] op_sel_hi:[0,1,0]" : "=v"(d) : "v"(a), "v"(h)); return d; }
DEVI float fmix2_lo(unsigned v, unsigned h, float c) { float d; asm("v_fma_mix_f32 %0, %1, %2, %3 op_sel_hi:[1,1,0]" : "=v"(d) : "v"(v), "v"(h), "v"(c)); return d; }
DEVI float fmix2_hi(unsigned v, unsigned h, float c) { float d; asm("v_fma_mix_f32 %0, %1, %2, %3 op_sel:[0,1,0] op_sel_hi:[1,1,0]" : "=v"(d) : "v"(v), "v"(h), "v"(c)); return d; }
DEVI float fmix_h0(unsigned hv, float b, float c) { float d; asm("v_fma_mix_f32 %0, %1, %2, %3 op_sel_hi:[1,0,0]" : "=v"(d) : "v"(hv), "v"(b), "v"(c)); return d; }
DEVI u32x4 pack8h(const float (&f)[8]) { f16x8 h;
#pragma unroll
    for (int j = 0; j < 8; ++j) h[j] = (_Float16)f[j];
    return __builtin_bit_cast(u32x4, h); }
constexpr int SLOT = 9216;
constexpr int SL_AT = 0, SL_BT = 1, SL_KT = 2, SL_RT = 3, SL_VT = 4, SL_BH = 5, SL_KH = 6, SL_S0 = 7, SL_MOFF = 8, SL_MOFFT = 9, SL_MAK = 10, SL_LRB = 11, SL_LRK = 12;
constexpr int SL_DD = 1, SL_DDT = 2, SL_N = 10, SL_NT = 12, SL_N2 = 6, SL_W1T = 8, SL_W1 = 9, SL_T = 4, SL_RHST = 1, SL_UT = 2;
constexpr int L_G = 8 * SLOT;
constexpr int GS = 68, ATS = 136;
constexpr int L_TW = 10 * SLOT, L_AD = 11 * SLOT;
constexpr int L_ATMP = 12 * SLOT;
constexpr int L_FD = 13 * SLOT;
constexpr int L_C = L_FD + 8 * 272 * 4;
constexpr int L_SEG = L_C + (896 + 320) * 4;
constexpr int L_CHAIN_END = L_SEG + 8 * 64 * 4;
static_assert(L_CHAIN_END <= 147200, "chain LDS");
DEVI f32x16 mm_tile(f32x16 acc, const char* Yt, const char* Xt, int jt, int it, int r32, int hi) {
    const char* yp = Yt + (32 * jt + r32) * 144 + 16 * hi; const char* xp = Xt + (32 * it + r32) * 144 + 16 * hi;
#pragma unroll
    for (int ks = 0; ks < 4; ++ks) acc = __builtin_amdgcn_mfma_f32_32x32x16_bf16(*(const bf16x8*)(xp + 32 * ks), *(const bf16x8*)(yp + 32 * ks), acc, 0, 0, 0);
    return acc;
}
DEVI bf16x8 frag_tr(const char* T, int col0, int ks, int lane, int hi) {
    const char* p = T + (16 * ks + 8 * hi + ((lane & 15) >> 2)) * 144 + (col0 + 16 * ((lane >> 4) & 1) + 4 * (lane & 3)) * 2;
    const s16x4 a = vtr_(p), b = vtr_(p + 4 * 144);
    return (bf16x8){a[0], a[1], a[2], a[3], b[0], b[1], b[2], b[3]};
}
template <bool YT, bool XT>
DEVI f32x16 mm_tile2(f32x16 acc, const char* Yt, const char* Xt, int jt, int it, int lane, int r32, int hi) {
#pragma unroll
    for (int ks = 0; ks < 4; ++ks) {
        const bf16x8 yf = YT ? frag_tr(Yt, 32 * jt, ks, lane, hi) : *(const bf16x8*)(Yt + (32 * jt + r32) * 144 + 16 * hi + 32 * ks);
        const bf16x8 xf = XT ? frag_tr(Xt, 32 * it, ks, lane, hi) : *(const bf16x8*)(Xt + (32 * it + r32) * 144 + 16 * hi + 32 * ks);
        acc = __builtin_amdgcn_mfma_f32_32x32x16_bf16(xf, yf, acc, 0, 0, 0);
    }
    return acc;
}
template <class M> DEVI void st_tile(char* Ot, int jt, int it, int r32, int hi, const f32x16& acc, M mask) {
    const int row = 32 * jt + r32;
#pragma unroll
    for (int g = 0; g < 4; ++g) { const int c0 = 32 * it + 8 * g + 4 * hi;
        u32x2 w; w.x = pk2(mask(row, c0) ? acc[4 * g] : 0.f, mask(row, c0 + 1) ? acc[4 * g + 1] : 0.f); w.y = pk2(mask(row, c0 + 2) ? acc[4 * g + 2] : 0.f, mask(row, c0 + 3) ? acc[4 * g + 3] : 0.f);
        *(u32x2*)(Ot + row * 144 + c0 * 2) = w; }
}
DEVI f32x16 zero16() { f32x16 z;
#pragma unroll
    for (int r = 0; r < 16; ++r) z[r] = 0.f;
    return z; }
DEVI void chain_unit(const Params& p, int unit, char* lds) {
    const int tid0 = my_tid(); const int tid = tid0;
    const int dir = unit & 1, bh = unit >> 1, b = bh >> 3, h = bh & 7;
    const bool fwd = (dir == 0);
    const bf16_t* z = (const bf16_t*)(p.ws + OFF_Z);
    bf16_t* yout = (bf16_t*)(p.ws + (dir ? OFF_YB : OFF_YF));
    bf16_t* vout = (bf16_t*)(p.ws + OFF_VS);
    float* sout = (float*)(p.ws + OFF_SDIR) + (size_t)dir * T_ * 8;
    const size_t rowb = (size_t)b * SEQ;
    float* Cc = (float*)(lds + L_C);
    for (int i = tid; i < 448; i += NTHREADS) {
        int gi;
        if (i < 192) gi = (i >> 6) * 512 + h * 64 + (i & 63); else if (i < 256) gi = 1536 + dir * 64 + (i - 192); else if (i < 320) gi = 1664 + dir * 64 + (i - 256); else gi = 1792 + (i - 320);
        Cc[i] = p.in[8][gi]; Cc[448 + i] = p.in[9][gi];
    }
    if (tid < 64) { const int c = h * 64 + tid; Cc[896 + tid] = p.in[15][c]; Cc[960 + tid] = p.in[16][c]; Cc[1024 + tid] = p.in[17][c]; Cc[1088 + tid] = p.in[10][dir * 512 + c]; Cc[1152 + tid] = p.in[12][dir * 512 + c]; }
    for (int i = tid; i < SLOT / 16; i += NTHREADS) ((u32x4*)(lds + SL_S0 * SLOT))[i] = (u32x4){0u, 0u, 0u, 0u};
    bf16x8 wf[4];
    {
        const int lane = tid & 63, wid = __builtin_amdgcn_readfirstlane(tid >> 6), r32 = lane & 31, hi = lane >> 5, nt = (wid >> 1) & 1;
        const bf16_t* wsrc = (const bf16_t*)(p.ws + (wid < 4 ? OFF_WUP : OFF_AUP)) + ((size_t)dir * 512 + h * 64 + 32 * nt + r32) * 64 + 8 * hi;
#pragma unroll
        for (int ks = 0; ks < 4; ++ks) wf[ks] = *(const bf16x8*)(wsrc + 16 * ks);
    }
    u32x4 zl[3][3], ztw, zad;
#define C_LOAD(c) do { const int t0_ = dir ? (SEQ - 64 * ((c) + 1)) : 64 * (c); const int ts_ = t0_ + tt; const bf16_t* zp_ = z + (rowb + ts_) * LDZ + ZR; \
        const bool hp_ = ts_ > 0, hn_ = ts_ < SEQ - 1; const u32x4 z4_ = {0u, 0u, 0u, 0u}; \
        _Pragma("unroll") for (int sg = 0; sg < 3; ++sg) { const int co_ = sg * 512 + h * 64 + 8 * c8; \
            zl[sg][1] = *(const u32x4*)(zp_ + co_); zl[sg][0] = hp_ ? *(const u32x4*)(zp_ + co_ - LDZ) : z4_; zl[sg][2] = hn_ ? *(const u32x4*)(zp_ + co_ + LDZ) : z4_; } \
        { const bf16_t* tw_ = (const bf16_t*)(p.ws + OFF_TWAD) + (rowb + ts_) * 256 + dir * 64 + 8 * c8; ztw = *(const u32x4*)tw_; zad = *(const u32x4*)(tw_ + 128); } \
        } while (0)
#define SHIFT8(dst, regs, mi) do { float z0_[8], zm_[8], zn_[8]; unpack8(regs[1], z0_); unpack8(regs[0], zm_); unpack8(regs[2], zn_); \
        const f32x4 mpa_ = *(const f32x4*)(Cc + (mi)), mpb_ = *(const f32x4*)(Cc + (mi) + 4), mna_ = *(const f32x4*)(Cc + 448 + (mi)), mnb_ = *(const f32x4*)(Cc + 448 + (mi) + 4); \
        const float mp_[8] = {mpa_.x, mpa_.y, mpa_.z, mpa_.w, mpb_.x, mpb_.y, mpb_.z, mpb_.w}, mn_[8] = {mna_.x, mna_.y, mna_.z, mna_.w, mnb_.x, mnb_.y, mnb_.z, mnb_.w}; \
        _Pragma("unroll") for (int j = 0; j < 8; ++j) dst[j] = z0_[j] + mp_[j] * (zm_[j] - z0_[j]) + mn_[j] * (zn_[j] - z0_[j]); } while (0)
    f32x16 state = zero16();
    { const int tt = tid >> 3, c8 = tid & 7; C_LOAD(0); }
    __syncthreads();
    for (int c = 0; c < SEQ / 64; ++c) {
        int tid = tid0; asm volatile("" : "+v"(tid));
        const int lane = tid & 63, wid = __builtin_amdgcn_readfirstlane(tid >> 6), r32 = lane & 31, hi = lane >> 5;
        const int nt = (wid >> 1) & 1, tt2 = wid & 1, pj = nt, pi = tt2;
        const int tt = tid >> 3, c8 = tid & 7;
        const int sp = dir ? 63 - tt : tt;
        const int t0 = dir ? (SEQ - 64 * (c + 1)) : 64 * c;
        float r8[8], k8[8], v8[8], kk8[8];
        {
            SHIFT8(r8, zl[0], 8 * c8); SHIFT8(k8, zl[1], 64 + 8 * c8); SHIFT8(v8, zl[2], 128 + 8 * c8);
            *(u32x4*)(lds + L_TW + tt * 144 + c8 * 16) = ztw;
            *(u32x4*)(lds + L_AD + tt * 144 + c8 * 16) = zad;
            float ss = 0.f;
#pragma unroll
            for (int j = 0; j < 8; ++j) { kk8[j] = k8[j] * Cc[896 + 8 * c8 + j]; ss += kk8[j] * kk8[j]; }
            ss = red8(ss);
            const float inv = 1.f / fmaxf(sqrtf(ss), 1e-12f);
#pragma unroll
            for (int j = 0; j < 8; ++j) kk8[j] *= inv;
        }
        __syncthreads();
        {
            f32x16 acc = zero16();
            const int tl = 32 * tt2 + r32;
            const int rsel = (wid < 4 && dir) ? 63 - tl : tl;
            const char* xt = lds + (wid < 4 ? L_TW : L_AD) + rsel * 144 + 16 * hi;
#pragma unroll
            for (int ks = 0; ks < 4; ++ks) acc = __builtin_amdgcn_mfma_f32_32x32x16_bf16(wf[ks], *(const bf16x8*)(xt + 32 * ks), acc, 0, 0, 0);
            if (wid < 4) {
                const int sl = tl;
#pragma unroll
                for (int g = 0; g < 4; ++g) { const int n0 = 32 * nt + 8 * g + 4 * hi; f32x4 o;
#pragma unroll
                    for (int q = 0; q < 4; ++q) o[q] = -0.6065306597126334f * sigmoidf_(acc[4 * g + q] + Cc[1088 + n0 + q]);
                    {
                        float s0 = o[0], s1 = o[1], s2 = o[2], s3 = o[3];
#define CH_SCAN4(ctl) "v_add_f32_dpp %0, %0, %0 " ctl "\n v_add_f32_dpp %1, %1, %1 " ctl "\n v_add_f32_dpp %2, %2, %2 " ctl "\n v_add_f32_dpp %3, %3, %3 " ctl "\n"
                        asm volatile("s_nop 1\n"
                                     CH_SCAN4("row_shr:1 row_mask:0xf bank_mask:0xf bound_ctrl:0") CH_SCAN4("row_shr:2 row_mask:0xf bank_mask:0xf bound_ctrl:0")
                                     CH_SCAN4("row_shr:4 row_mask:0xf bank_mask:0xf bound_ctrl:0") CH_SCAN4("row_shr:8 row_mask:0xf bank_mask:0xf bound_ctrl:0")
                                     CH_SCAN4("row_bcast:15 row_mask:0xa bank_mask:0xf")
                                     "s_nop 1" : "+v"(s0), "+v"(s1), "+v"(s2), "+v"(s3));
#undef CH_SCAN4
                        o[0] = s0; o[1] = s1; o[2] = s2; o[3] = s3; }
                    *(f32x4*)(lds + L_G + sl * (GS * 4) + n0 * 4) = o;
                    if (tt2 == 0 && r32 == 31) *(f32x4*)(lds + L_SEG + n0 * 4) = o; }
            } else {
#pragma unroll
                for (int g = 0; g < 4; ++g) { const int n0 = 32 * nt + 8 * g + 4 * hi; f16x4 o;
#pragma unroll
                    for (int q = 0; q < 4; ++q) o[q] = (_Float16)sigmoidf_(acc[4 * g + q] + Cc[1152 + n0 + q]);
                    *(f16x4*)(lds + L_ATMP + tl * ATS + n0 * 2) = o; }
            }
        }
        __syncthreads();
        float kd8[8], b8[8];
        {
            const f16x8 ah = *(const f16x8*)(lds + L_ATMP + tt * ATS + c8 * 16);
            float sp_ = 0.f;
#pragma unroll
            for (int j = 0; j < 8; ++j) { const float a = (float)ah[j];
                kd8[j] = k8[j] * (1.f + (a - 1.f) * Cc[960 + 8 * c8 + j]); b8[j] = kk8[j] * a; sp_ += r8[j] * kd8[j] * Cc[1024 + 8 * c8 + j]; }
            sp_ = red8(sp_);
            if (c8 == 0) sout[(rowb + t0 + tt) * 8 + h] = sp_;
            if (fwd) *(u32x4*)(vout + (rowb + t0 + tt) * 512 + h * 64 + 8 * c8) = pack8(v8);
            if (tid < 64) ((float*)(lds + L_FD))[tid] = __expf(((const float*)(lds + L_G))[63 * GS + tid] + ((const float*)(lds + L_SEG))[tid]);
        }
        __syncthreads();
        {
            const float* G = (const float*)(lds + L_G);
            const f32x4 ga = *(const f32x4*)(G + sp * GS + 8 * c8), gb = *(const f32x4*)(G + sp * GS + 8 * c8 + 4);
            const f32x4 ha = *(const f32x4*)((const float*)(lds + L_FD) + 8 * c8), hb = *(const f32x4*)((const float*)(lds + L_FD) + 8 * c8 + 4);
            f32x4 pa = {0.f, 0.f, 0.f, 0.f}, pb = pa;
            if (sp > 0) { pa = *(const f32x4*)(G + (sp - 1) * GS + 8 * c8); pb = *(const f32x4*)(G + (sp - 1) * GS + 8 * c8 + 4); }
            const f32x4 ta = *(const f32x4*)((const float*)(lds + L_SEG) + 8 * c8), tb = *(const f32x4*)((const float*)(lds + L_SEG) + 8 * c8 + 4);
            const float t0s = sp >= 32 ? 1.f : 0.f, t0m = sp >= 33 ? 1.f : 0.f;
            const float gs[8] = {ga.x + t0s * ta.x, ga.y + t0s * ta.y, ga.z + t0s * ta.z, ga.w + t0s * ta.w, gb.x + t0s * tb.x, gb.y + t0s * tb.y, gb.z + t0s * tb.z, gb.w + t0s * tb.w};
            const float gm[8] = {pa.x + t0m * ta.x, pa.y + t0m * ta.y, pa.z + t0m * ta.z, pa.w + t0m * ta.w, pb.x + t0m * tb.x, pb.y + t0m * tb.y, pb.z + t0m * tb.z, pb.w + t0m * tb.w};
            const float gl[8] = {ha.x, ha.y, ha.z, ha.w, hb.x, hb.y, hb.z, hb.w};
            {
                float at_[8], rt_[8];
#pragma unroll
                for (int j = 0; j < 8; ++j) { at_[j] = -kk8[j] * __expf(gm[j]); rt_[j] = r8[j] * __expf(gs[j]); }
                *(u32x4*)(lds + SL_AT * SLOT + sp * 144 + c8 * 16) = pack8(at_); *(u32x4*)(lds + SL_RT * SLOT + sp * 144 + c8 * 16) = pack8(rt_);
            }
            float en8[8];
            {
                float bt_[8], kt_[8];
#pragma unroll
                for (int j = 0; j < 8; ++j) { const float en = __expf(-gs[j]); en8[j] = en; bt_[j] = b8[j] * en; kt_[j] = kd8[j] * en; }
                *(u32x4*)(lds + SL_BT * SLOT + sp * 144 + c8 * 16) = pack8(bt_); *(u32x4*)(lds + SL_KT * SLOT + sp * 144 + c8 * 16) = pack8(kt_);
            }
            {
                float bh_[8], kh_[8];
#pragma unroll
                for (int j = 0; j < 8; ++j) { const float eh = gl[j] * en8[j]; bh_[j] = b8[j] * eh; kh_[j] = kd8[j] * eh; }
                *(u32x4*)(lds + SL_VT * SLOT + sp * 144 + c8 * 16) = pack8(v8);
                *(u32x4*)(lds + SL_BH * SLOT + sp * 144 + c8 * 16) = pack8(bh_); *(u32x4*)(lds + SL_KH * SLOT + sp * 144 + c8 * 16) = pack8(kh_);
            }
        }
        __syncthreads();
        {
            const char* ATt = lds + SL_AT * SLOT; const char* RTt = lds + SL_RT * SLOT;
            f32x16 acc = mm_tile(zero16(), ATt, lds + (wid < 4 ? SL_BT : SL_KT) * SLOT, pj, pi, r32, hi);
            f32x16 acc2 = mm_tile(zero16(), RTt, lds + (wid < 4 ? SL_BT : SL_KT) * SLOT, pj, pi, r32, hi);
            const int row = 32 * pj + r32;
            if (wid < 4) {
                st_tile(lds + SL_MOFF * SLOT, pj, pi, r32, hi, acc, [](int s, int i) { return (s >> 4) > (i >> 4); });
#pragma unroll
                for (int g = 0; g < 4; ++g)
#pragma unroll
                    for (int q = 0; q < 4; ++q) { const int i = 32 * pi + 8 * g + 4 * hi + q; const float vv = acc[4 * g + q];
                        if ((row >> 4) == (i >> 4)) ((float*)(lds + L_FD))[64 + (row >> 4) * 320 + (row & 15) * 20 + (i & 15)] = (i < row) ? vv : 0.f; }
                st_tile(lds + SL_LRB * SLOT, pj, pi, r32, hi, acc2, [](int s, int i) { return i <= s; });
            } else {
                st_tile(lds + SL_MAK * SLOT, pj, pi, r32, hi, acc, [](int s, int i) { return i < s; });
                st_tile(lds + SL_LRK * SLOT, pj, pi, r32, hi, acc2, [](int s, int i) { return i <= s; });
            }
        }
        __syncthreads();
        if (c + 1 < SEQ / 64) C_LOAD(c + 1);
        if (wid == 0) {
            const int d = lane >> 4, j = lane & 15; const float* Md = (const float*)(lds + L_FD) + 64 + d * 320;
            float x[16];
#pragma unroll
            for (int q = 0; q < 16; ++q) x[q] = (q == j) ? 1.f : 0.f;
            f32x4 mrow[16][4];
#pragma unroll
            for (int g = 0; g < 4; ++g) { mrow[15][g] = *(const f32x4*)(Md + 15 * 20 + 4 * g); mrow[14][g] = *(const f32x4*)(Md + 14 * 20 + 4 * g); }
#pragma unroll
            for (int s = 15; s >= 1; --s) {
#pragma unroll
                for (int g = 0; g < 4; ++g) if (s >= 3 && 4 * g < s - 2) mrow[s - 2][g] = *(const f32x4*)(Md + (s - 2) * 20 + 4 * g);
                asm volatile("" ::: "memory");
                const float xs = x[s];
#pragma unroll
                for (int q = 0; q < 16; ++q) if (q < s) x[q] = fmaf(xs, mrow[s][q >> 2][q & 3], x[q]);
            }
            char* rowp = lds + SL_DD * SLOT + (16 * d + j) * 144;
            const u32x4 z4 = {0u, 0u, 0u, 0u};
#pragma unroll
            for (int q = 0; q < 8; ++q) *(u32x4*)(rowp + 16 * q) = z4;
            u32x4 w0, w1; w0.x = pk2(x[0], x[1]); w0.y = pk2(x[2], x[3]); w0.z = pk2(x[4], x[5]); w0.w = pk2(x[6], x[7]); w1.x = pk2(x[8], x[9]); w1.y = pk2(x[10], x[11]); w1.z = pk2(x[12], x[13]); w1.w = pk2(x[14], x[15]);
            asm volatile("s_waitcnt lgkmcnt(0)" ::: "memory");
            *(u32x4*)(rowp + 32 * d) = w0; *(u32x4*)(rowp + 32 * d + 16) = w1;
        }
        f32x16 locA = zero16(), locB = zero16();
        if (wid < 4) { locA = mm_tile2<true, false>(locA, lds + SL_VT * SLOT, lds + SL_MAK * SLOT, pj, pi, lane, r32, hi); locB = mm_tile2<true, true>(locB, lds + SL_VT * SLOT, lds + SL_KH * SLOT, pj, pi, lane, r32, hi); }
        __syncthreads();
        if (wid < 4) {
            f32x16 acc = mm_tile2<false, true>(zero16(), lds + SL_DD * SLOT, lds + SL_MOFF * SLOT, pj, pi, lane, r32, hi);
            st_tile(lds + SL_N * SLOT, pj, pi, r32, hi, acc, [](int, int) { return true; });
        } else locA = mm_tile2<false, true>(locA, lds + SL_LRK * SLOT, lds + SL_VT * SLOT, pj, pi, lane, r32, hi);
        __syncthreads();
        {
            f32x16 acc = zero16();
            if (wid >= 4) { const int row = 32 * pj + r32; const char* addt = lds + SL_DD * SLOT;
#pragma unroll
                for (int g = 0; g < 4; ++g) { const u32x2 w = *(const u32x2*)(addt + row * 144 + (32 * pi + 8 * g + 4 * hi) * 2); acc[4 * g] = lo16(w.x); acc[4 * g + 1] = hi16(w.x); acc[4 * g + 2] = lo16(w.y); acc[4 * g + 3] = hi16(w.y); } }
            acc = (wid < 4) ? mm_tile2<false, true>(acc, lds + SL_N * SLOT, lds + SL_N * SLOT, pj, pi, lane, r32, hi) : mm_tile2<false, true>(acc, lds + SL_N * SLOT, lds + SL_DD * SLOT, pj, pi, lane, r32, hi);
            st_tile(lds + (wid < 4 ? SL_N2 : SL_W1) * SLOT, pj, pi, r32, hi, acc, [](int, int) { return true; });
        }
        __syncthreads();
        if (wid < 4) {
            f32x16 acc;
            { const int row = 32 * pj + r32; const char* addt = lds + SL_W1 * SLOT;
#pragma unroll
              for (int g = 0; g < 4; ++g) { const u32x2 w = *(const u32x2*)(addt + row * 144 + (32 * pi + 8 * g + 4 * hi) * 2); acc[4 * g] = lo16(w.x); acc[4 * g + 1] = hi16(w.x); acc[4 * g + 2] = lo16(w.y); acc[4 * g + 3] = hi16(w.y); } }
            acc = mm_tile2<false, true>(acc, lds + SL_N2 * SLOT, lds + SL_W1 * SLOT, pj, pi, lane, r32, hi);
            st_tile(lds + SL_T * SLOT, pj, pi, r32, hi, acc, [](int, int) { return true; });
        } else {
            locA = mm_tile(locA, lds + SL_RT * SLOT, lds + SL_S0 * SLOT, pj, pi, r32, hi);
        }
        if (wid < 4) {
            locA = mm_tile(locA, lds + SL_S0 * SLOT, lds + SL_AT * SLOT, pj, pi, r32, hi);
            st_tile(lds + SL_RHST * SLOT, pj, pi, r32, hi, locA, [](int, int) { return true; });
        }
        __syncthreads();
        if (wid < 4) {
            f32x16 acc = mm_tile(zero16(), lds + SL_RHST * SLOT, lds + SL_T * SLOT, pj, pi, r32, hi);
            st_tile(lds + SL_UT * SLOT, pj, pi, r32, hi, acc, [](int, int) { return true; });
        }
        __syncthreads();
        if (wid < 4) {
            const float* gam = (const float*)(lds + L_FD);
#pragma unroll
            for (int g = 0; g < 4; ++g) { const f32x4 gq = *(const f32x4*)(gam + 32 * pi + 8 * g + 4 * hi);
                state[4 * g] = state[4 * g] * gq.x + locB[4 * g]; state[4 * g + 1] = state[4 * g + 1] * gq.y + locB[4 * g + 1]; state[4 * g + 2] = state[4 * g + 2] * gq.z + locB[4 * g + 2]; state[4 * g + 3] = state[4 * g + 3] * gq.w + locB[4 * g + 3]; }
            state = mm_tile2<false, true>(state, lds + SL_UT * SLOT, lds + SL_BH * SLOT, pj, pi, lane, r32, hi);
            st_tile(lds + SL_S0 * SLOT, pj, pi, r32, hi, state, [](int, int) { return true; });
        } else {
            locA = mm_tile(locA, lds + SL_LRB * SLOT, lds + SL_UT * SLOT, pj, pi, r32, hi);
            const int s = 32 * pj + r32; const int tn = t0 + (dir ? 63 - s : s);
            bf16_t* yp = yout + (rowb + tn) * 512 + h * 64 + 32 * pi;
#pragma unroll
            for (int g = 0; g < 4; ++g) { u32x2 w; w.x = pk2(locA[4 * g], locA[4 * g + 1]); w.y = pk2(locA[4 * g + 2], locA[4 * g + 3]); *(u32x2*)(yp + 8 * g + 4 * hi) = w; }
        }
        __syncthreads();
    }
#undef C_LOAD
#undef SHIFT8
}

DEVI void stage_rwkv_post(const Params& p, int bid, int nb) {
    const bf16_t* yf = (const bf16_t*)(p.ws + OFF_YF); const bf16_t* yb = (const bf16_t*)(p.ws + OFF_YB);
    const bf16_t* g = (const bf16_t*)(p.ws + OFF_G); const bf16_t* vs = (const bf16_t*)(p.ws + OFF_VS);
    const float* sf = (const float*)(p.ws + OFF_SDIR); const float* sb = sf + (size_t)T_ * 8;
    for (int i = bid * NTHREADS + my_tid(); i < T_ * 64; i += nb * NTHREADS) {
        const int c8 = i & 7, th = i >> 3, c = (th & 7) * 64 + 8 * c8;
        const size_t o = (size_t)(th >> 3) * 512 + c;
        float a[8], b[8], y[8], gv[8], vv[8];
        unpack8(*(const u32x4*)(yf + o), a); unpack8(*(const u32x4*)(yb + o), b); unpack8(*(const u32x4*)(g + o), gv); unpack8(*(const u32x4*)(vs + o), vv);
        float s = 0.f;
#pragma unroll
        for (int j = 0; j < 8; ++j) { y[j] = a[j] + b[j]; s += y[j]; }
        const float mu = red8(s) * (1.f / 64.f);
        float q = 0.f;
#pragma unroll
        for (int j = 0; j < 8; ++j) { y[j] -= mu; q += y[j] * y[j]; }
        const float rstd = rsqrtf(red8(q) * (1.f / 64.f) + 64e-5f);
        const float bs = sf[th] + sb[th];
        const f32x4 lga = *(const f32x4*)(p.in[18] + c), lgb = *(const f32x4*)(p.in[18] + c + 4), lba = *(const f32x4*)(p.in[19] + c), lbb = *(const f32x4*)(p.in[19] + c + 4);
        const float lg[8] = {lga.x, lga.y, lga.z, lga.w, lgb.x, lgb.y, lgb.z, lgb.w}, lb[8] = {lba.x, lba.y, lba.z, lba.w, lbb.x, lbb.y, lbb.z, lbb.w};
        float r[8];
#pragma unroll
        for (int j = 0; j < 8; ++j) r[j] = (y[j] * rstd * lg[j] + lb[j] + bs * vv[j]) * gv[j];
        { u32x2 w8; w8.x = pk4_fp8(r[0] * F8_ASCALE, r[1] * F8_ASCALE, r[2] * F8_ASCALE, r[3] * F8_ASCALE); w8.y = pk4_fp8(r[4] * F8_ASCALE, r[5] * F8_ASCALE, r[6] * F8_ASCALE, r[7] * F8_ASCALE);
          *(u32x2*)((unsigned char*)p.out + DOFF_SG + o) = w8; }
    }
}

typedef float f32x2v __attribute__((ext_vector_type(2)));
DEVI float shfl_xor_now(float v, int m) { const int a = ((my_tid() ^ m) & 63) << 2; return __int_as_float(__builtin_amdgcn_ds_bpermute(a, __float_as_int(v))); }
DEVI float shfl_idx_now(float v, int src) { int a = (src & 63) << 2; asm volatile("" : "+v"(a)); return __int_as_float(__builtin_amdgcn_ds_bpermute(a, __float_as_int(v))); }
DEVI void stage_route(const Params& p, char* lds, int bid, int nb, bool do_count = true) {
    const int tid0 = my_tid();
    const bf16_t* x1 = (const bf16_t*)(p.ws + OFF_X1); bf16_t* h2 = (bf16_t*)((char*)p.out + DOFF_H2);
    int* toke = (int*)(p.ws + OFF_TOKE); float* tokw = (float*)(p.ws + OFF_TOKW); int* tokr = (int*)(p.ws + OFF_TOKR);
    int* cntwg = (int*)(p.ws + OFF_CNTWG);
    const bf16_t* wrt = (const bf16_t*)(p.ws + OFF_WRT);
    const float* g2 = p.in[23];
    int* hist = (int*)lds;
    float* bs = (float*)(lds + 128);
    float* g2s = (float*)(lds + 25088);
    constexpr int WB0 = 29184, WBSZ = 96 * 528;
    if (bid == 0 && do_count) { u32x4* zr = (u32x4*)((unsigned char*)h2 + (size_t)T_ * DM); if (tid0 < 64) zr[tid0] = (u32x4){0u, 0u, 0u, 0u}; }
    g2s[tid0] = g2[tid0] * F8_ASCALE; g2s[tid0 + 512] = g2[tid0 + 512] * F8_ASCALE;
    if (tid0 < 4) bs[tid0] = p.in[25][tid0]; else if (tid0 < 36) bs[tid0] = p.in[27][tid0 - 4];
    for (int b = bid; b < T_ / 128; b += nb) {
        int tidl_ = tid0; asm volatile("" : "+v"(tidl_));
        const int tid = tidl_, lane = tidl_ & 63, wave = tidl_ >> 6;
        if (tid < 32) hist[tid] = 0;
        const int t0 = b * 128 + wave * 16;
        const int li = lane & 15, kq = lane >> 4;
        const bf16_t* xrow = x1 + (size_t)(t0 + li) * DM + 8 * kq;
        u32x4 xr[32];
#pragma unroll
        for (int ks = 0; ks < 32; ++ks) xr[ks] = *(const u32x4*)(xrow + 32 * ks);
        unsigned gvoff = (unsigned)((tid >> 5) * 2048 + (tid & 31) * 16); asm volatile("" : "+v"(gvoff));
        unsigned svoff = (unsigned)((tid >> 5) * 528 + (tid & 31) * 16); asm volatile("" : "+v"(svoff));
        unsigned fvoff = (unsigned)(li * 528 + kq * 16); asm volatile("" : "+v"(fvoff));
        const char* wbase = (const char*)wrt;
        u32x4 st[6];
#pragma unroll
        for (int i = 0; i < 6; ++i) st[i] = *(const u32x4*)(wbase + (size_t)(i * 16 * 2048) + gvoff);
#pragma unroll
        for (int i = 0; i < 6; ++i) *(u32x4*)(lds + WB0 + i * 16 * 528 + svoff) = st[i];
        __syncthreads();
        f32x4 acc0 = {0.f, 0.f, 0.f, 0.f}, acc1 = acc0, acc2 = acc0;
        float ss = 0.f;
#pragma unroll
        for (int c = 0; c < 4; ++c) {
            if (c < 3) {
#pragma unroll
                for (int i = 0; i < 6; ++i) st[i] = *(const u32x4*)(wbase + (size_t)(i * 16 * 2048 + (c + 1) * 512) + gvoff);
            }
            const char* wl = lds + WB0 + (c & 1) * WBSZ + fvoff;
#pragma unroll
            for (int ksl = 0; ksl < 8; ++ksl) {
                const int ks = 8 * c + ksl;
                bf16x8 wf[6];
#pragma unroll
                for (int ob = 0; ob < 3; ++ob) { wf[2 * ob] = *(const bf16x8*)(wl + (ob * 16) * 528 + ksl * 64); wf[2 * ob + 1] = *(const bf16x8*)(wl + (48 + ob * 16) * 528 + ksl * 64); }
                float xv[8]; unpack8(xr[ks], xv);
#pragma unroll
                for (int j = 0; j < 8; ++j) ss += xv[j] * xv[j];
                const bf16x8 ax = __builtin_bit_cast(bf16x8, xr[ks]);
                acc0 = __builtin_amdgcn_mfma_f32_16x16x32_bf16(ax, wf[0], acc0, 0, 0, 0);
                acc1 = __builtin_amdgcn_mfma_f32_16x16x32_bf16(ax, wf[2], acc1, 0, 0, 0);
                acc2 = __builtin_amdgcn_mfma_f32_16x16x32_bf16(ax, wf[4], acc2, 0, 0, 0);
                acc0 = __builtin_amdgcn_mfma_f32_16x16x32_bf16(ax, wf[1], acc0, 0, 0, 0);
                acc1 = __builtin_amdgcn_mfma_f32_16x16x32_bf16(ax, wf[3], acc1, 0, 0, 0);
                acc2 = __builtin_amdgcn_mfma_f32_16x16x32_bf16(ax, wf[5], acc2, 0, 0, 0);
            }
            if (c < 3) {
#pragma unroll
                for (int i = 0; i < 6; ++i) *(u32x4*)(lds + WB0 + ((c + 1) & 1) * WBSZ + i * 16 * 528 + svoff) = st[i];
                __syncthreads();
            }
        }
        ss += shfl_xor_now(ss, 16); ss += shfl_xor_now(ss, 32);
        const float my_rstd = rsqrtf(ss * (1.f / DM) + 1e-6f);
        {
            int t2_ = tid0; asm volatile("" : "+v"(t2_));
            const int li = t2_ & 15, kq = (t2_ >> 4) & 3, t0 = b * 128 + (t2_ >> 6) * 16;
            unsigned char* orow = (unsigned char*)h2 + (size_t)(t0 + li) * DM + 8 * kq;
#pragma unroll
            for (int ks = 0; ks < 32; ++ks) {
                if ((ks & 1) == 0) asm volatile("" ::: "memory");
                u32x4 xw = xr[ks]; asm volatile("" : "+v"(xw));
                float xv[8]; unpack8(xw, xv);
                const f32x4 ga = *(const f32x4*)(g2s + 32 * ks + 8 * kq), gb = *(const f32x4*)(g2s + 32 * ks + 8 * kq + 4);
                const float gq[8] = {ga.x, ga.y, ga.z, ga.w, gb.x, gb.y, gb.z, gb.w};
                float o[8];
#pragma unroll
                for (int j = 0; j < 8; ++j) o[j] = xv[j] * my_rstd * gq[j];
                u32x2 o8; o8.x = pk4_fp8(o[0], o[1], o[2], o[3]); o8.y = pk4_fp8(o[4], o[5], o[6], o[7]);
                *(u32x2*)(orow + 32 * ks) = o8;
            }
        }
#pragma unroll
        for (int r = 0; r < 4; ++r) { const float rs = shfl_idx_now(my_rstd, 4 * kq + r); acc0[r] *= rs; acc1[r] *= rs; acc2[r] *= rs; }
        int t3_ = tid0; asm volatile("" : "+v"(t3_));
        float* lgs = (float*)(lds + 512) + (t3_ >> 6) * (16 * 48);
#pragma unroll
        for (int r = 0; r < 4; ++r) { float* lr = lgs + (4 * kq + r) * 48 + li; lr[0] = acc0[r]; lr[16] = acc1[r]; lr[32] = acc2[r]; }
        asm volatile("s_waitcnt lgkmcnt(0)" ::: "memory");
        if (lane < 16) {
            const float* lg = lgs + lane * 48; const int t = t0 + lane;
            float gl[4];
#pragma unroll
            for (int j = 0; j < 4; ++j) gl[j] = lg[j] + bs[j];
            int gi = 0; float gm = gl[0];
#pragma unroll
            for (int j = 1; j < 4; ++j) if (gl[j] > gm) { gm = gl[j]; gi = j; }
            float gs = 0.f;
#pragma unroll
            for (int j = 0; j < 4; ++j) gs += __expf(gl[j] - gm);
            const float gp = 1.f / gs;
            float el[8];
#pragma unroll
            for (int j = 0; j < 8; ++j) el[j] = lg[4 + gi * 8 + j] + bs[4 + gi * 8 + j];
            int i1 = 0; float m1 = el[0];
#pragma unroll
            for (int j = 1; j < 8; ++j) if (el[j] > m1) { m1 = el[j]; i1 = j; }
            int i2 = -1; float m2 = -INFINITY;
#pragma unroll
            for (int j = 0; j < 8; ++j) if (j != i1 && el[j] > m2) { m2 = el[j]; i2 = j; }
            const float e2 = __expf(m2 - m1), tp1 = 1.f / (1.f + e2), tp2 = e2 / (1.f + e2);
            const int e1i = gi * 8 + i1, e2i = gi * 8 + i2;
            toke[2 * t] = e1i; toke[2 * t + 1] = e2i; tokw[2 * t] = gp * tp1; tokw[2 * t + 1] = gp * tp2;
            if (do_count) { tokr[2 * t] = atomicAdd(hist + e1i, 1); tokr[2 * t + 1] = atomicAdd(hist + e2i, 1); }
        }
        __syncthreads();
        if (do_count && tid < 32) cntwg[b * 32 + tid] = hist[tid];
        __syncthreads();
    }
}
DEVI void stage_scatter(const Params& p, char* lds, int bid, int nb, bool dry = false) {
    const int tid = my_tid(), lane = tid & 63, wave = tid >> 6;
    const int gw = bid * NWAVES + wave, NGW = nb * NWAVES;
    int* ctl = (int*)(p.ws + OFF_CTL); const int* toke = (const int*)(p.ws + OFF_TOKE); const int* tokr = (const int*)(p.ws + OFF_TOKR); int* toks = (int*)(p.ws + OFF_TOKS);
    const int* cntwg = (const int*)(p.ws + OFF_CNTWG);
    int* slottok = (int*)(p.ws + OFF_SLOTTOK);
    int* part = (int*)lds;
    int* tot = part + 512;
    int* cnts = tot + 32;
    int* bases = cnts + 32;
    constexpr int NB = T_ / 128;
    int* pre = bases + 32;
    int te0 = 0, tr0 = 0; if (tid < 256 && bid < NB) { const int a0 = bid * 256 + tid; te0 = toke[a0]; tr0 = tokr[a0]; }
    {
        const int e = tid & 31, q = tid >> 5;
        int cw[16];
#pragma unroll
        for (int w = 0; w < 16; ++w) cw[w] = cntwg[(16 * q + w) * 32 + e];
        int s = 0, pb = 0;
#pragma unroll
        for (int w = 0; w < 16; ++w) { if (16 * q + w < bid) pb = s + cw[w]; s += cw[w]; }
        part[q * 32 + e] = s;
        if (q == (bid >> 4)) pre[e] = ((bid & 15) == 0) ? 0 : pb;
    }
    __syncthreads();
    if (tid < 64) {
        const int e = tid & 31; int c = 0, gpre = 0;
#pragma unroll
        for (int q = 0; q < 16; ++q) { const int v = part[q * 32 + e]; if (q < (bid >> 4)) gpre += v; c += v; }
        const int pad = (c + 255) / 256 * 256;
        int inc = pad;
        inc += __builtin_amdgcn_update_dpp(0, inc, 0x111, 0xF, 0xF, false); inc += __builtin_amdgcn_update_dpp(0, inc, 0x112, 0xF, 0xF, false);
        inc += __builtin_amdgcn_update_dpp(0, inc, 0x114, 0xF, 0xF, false); inc += __builtin_amdgcn_update_dpp(0, inc, 0x118, 0xF, 0xF, false);
        inc += __builtin_amdgcn_update_dpp(0, inc, 0x142, 0xA, 0xF, false);
        const int run = inc - pad;
        if (tid < 32) { cnts[e] = c; tot[e] = run; bases[e] = run + gpre + pre[e];
            if (bid == 0) { for (int bq = run / 256; bq < (run + pad) / 256; ++bq) ctl[C_BLKE + bq] = e;
                if (e == 31) { for (int bq = inc / 256; bq < NBLK; ++bq) ctl[C_BLKE + bq] = -1; ctl[C_NBLK] = inc / 256; } } }
    }
    __syncthreads();
    for (int b = bid; b < NB; b += nb) {
        if (b != bid) {
            if (tid < 32) { int s = tot[tid]; for (int q = 0; q < (b >> 4); ++q) s += part[q * 32 + tid]; for (int w = b & ~15; w < b; ++w) s += cntwg[w * 32 + tid]; bases[tid] = s; }
            __syncthreads();
        }
        if (tid < 256) { const int a = b * 256 + tid; const int slot = (b == bid) ? bases[te0] + tr0 : bases[toke[a]] + tokr[a]; if (!dry) { toks[a] = slot; slottok[slot] = a >> 1; } else asm volatile("" :: "v"(slot)); }
        __syncthreads();
    }
    {
        const int e = gw & 31; const int c = cnts[e], pad = (c + 255) / 256 * 256;
        for (int s = tot[e] + c + (gw >> 5) * 64 + lane; s < tot[e] + pad; s += (NGW >> 5) * 64) slottok[s] = T_;
    }
    __syncthreads();
}
DEVI void stage_final(const Params& p, int bid, int nb, bool dry = false) {
    const int lane = my_tid() & 63, wave = my_tid() >> 6;
    const int gw = bid * NWAVES + wave, NGW = nb * NWAVES;
    const bf16_t* ye = (const bf16_t*)(p.ws + OFF_YE); const int* toks = (const int*)(p.ws + OFF_TOKS); const float* tokw = (const float*)(p.ws + OFF_TOKW);
    const bf16_t* x1 = (const bf16_t*)(p.ws + OFF_X1);
    const float* gf = p.in[31];
    f32x4 gv[4];
#pragma unroll
    for (int j = 0; j < 4; ++j) gv[j] = *(const f32x4*)(gf + 4 * lane + 256 * j);
    for (int tb = gw * 2; tb < T_; tb += NGW * 2) {
        u32x2 xa[2][4], ya[2][4], yb[2][4]; float w0[2], w1[2];
#pragma unroll
        for (int q = 0; q < 2; ++q) { const int t = tb + q; const int s0 = toks[2 * t], s1 = toks[2 * t + 1]; w0[q] = tokw[2 * t]; w1[q] = tokw[2 * t + 1];
            const u32x2* xr = (const u32x2*)(x1 + (size_t)t * DM) + lane; const u32x2* y0 = (const u32x2*)(ye + (size_t)s0 * DM) + lane; const u32x2* y1 = (const u32x2*)(ye + (size_t)s1 * DM) + lane;
#pragma unroll
            for (int j = 0; j < 4; ++j) { xa[q][j] = xr[64 * j]; ya[q][j] = y0[64 * j]; yb[q][j] = y1[64 * j]; } }
#pragma unroll
        for (int q = 0; q < 2; ++q) {
            f32x4 v[4]; float s = 0.f;
#pragma unroll
            for (int j = 0; j < 4; ++j) { const u32x2 x = xa[q][j], a = ya[q][j], b = yb[q][j];
                v[j].x = lo16(x.x) + w0[q] * lo16(a.x) + w1[q] * lo16(b.x); v[j].y = hi16(x.x) + w0[q] * hi16(a.x) + w1[q] * hi16(b.x);
                v[j].z = lo16(x.y) + w0[q] * lo16(a.y) + w1[q] * lo16(b.y); v[j].w = hi16(x.y) + w0[q] * hi16(a.y) + w1[q] * hi16(b.y);
                s += (v[j].x * v[j].x + v[j].y * v[j].y) + (v[j].z * v[j].z + v[j].w * v[j].w); }
            const float rstd = rsqrtf(wave_sum(s) * (1.f / DM) + 1e-6f);
            f32x4* orow = (f32x4*)(p.out + (size_t)(tb + q) * DM) + lane;
#pragma unroll
            for (int j = 0; j < 4; ++j) { const f32x4 o = v[j] * rstd * gv[j]; if (!dry) orow[64 * j] = o; else asm volatile("" :: "v"(o)); }
        }
    }
}

#define LAS __attribute__((address_space(3)))
#define XB_TMO      128
#define XB_XCNT(j)  (256  + 64 * (j))
#define XB_XSUB(j)  (1280 + 64 * (j))
#define XB_XGEN(j)  (2304 + 64 * (j))
#define XB_TOP      3328
#define XB_TOPGEN   3392
#define XCD_BAR_WORDS 3456
#define XB_SPIN_CAP (1u << 18)
DEVI unsigned xb_ld(unsigned* p)              { return __hip_atomic_load(p, __ATOMIC_RELAXED, __HIP_MEMORY_SCOPE_AGENT); }
DEVI unsigned xb_add(unsigned* p, unsigned v) { return __hip_atomic_fetch_add(p, v, __ATOMIC_RELAXED, __HIP_MEMORY_SCOPE_AGENT); }
DEVI unsigned xb_xcc_id() { return (unsigned)__builtin_amdgcn_s_getreg((3 << 11) | 20) & 0xFu; }
#define XB_SPIN(cond, bar) do { unsigned _sp = 0; while (cond) { __builtin_amdgcn_s_sleep(1); \
    if ((++_sp & 255u) == 0u) { if (xb_ld(&(bar)[XB_TMO])) break; if (_sp > XB_SPIN_CAP) { atomicAdd(&(bar)[XB_TMO], 1u); break; } } } } while (0)
struct XcdBarrier { unsigned* bar; unsigned x; volatile LAS unsigned* st; };
DEVI XcdBarrier xcd_barrier_post(unsigned* bar, volatile LAS unsigned* st) {
    XcdBarrier b; b.bar = bar; b.x = xb_xcc_id(); b.st = st;
    if (my_tid() == 0) (void)xb_add(&bar[XB_XCNT(b.x)], 1u);
    return b;
}
DEVI void xcd_barrier_complete(unsigned* bar, unsigned x, unsigned& nloc, unsigned& nx) {
    const unsigned G = gridDim.x * gridDim.y * gridDim.z;
    unsigned sum, cnt, mine, sp = 0u;
    for (;;) {
        sum = 0u; cnt = 0u; mine = 0u;
#pragma unroll
        for (unsigned j = 0; j < 16; ++j) { const unsigned c = xb_ld(&bar[XB_XCNT(j)]); sum += c; cnt += (c > 0u) ? 1u : 0u; mine = (j == x) ? c : mine; }
        if (sum == G) break;
        __builtin_amdgcn_s_sleep(1);
        if ((++sp & 255u) == 0u) { if (xb_ld(&bar[XB_TMO])) break; if (sp > XB_SPIN_CAP) { atomicAdd(&bar[XB_TMO], 1u); break; } }
    }
    nloc = mine > 0u ? mine : 1u; nx = cnt > 0u ? cnt : 1u;
}
DEVI void xcd_barrier(const XcdBarrier& b) {
    asm volatile("s_waitcnt vmcnt(0)" ::: "memory");
    __syncthreads();
    if (my_tid() == 0) {
        unsigned* bar = b.bar;
        __builtin_amdgcn_s_waitcnt(0);
        unsigned nloc = b.st[0], nx = b.st[1];
        if (nloc == 0u) { xcd_barrier_complete(bar, b.x, nloc, nx); b.st[0] = nloc; b.st[1] = nx; }
        const unsigned old = xb_add(&bar[XB_XSUB(b.x)], 1u);
        const unsigned gen = old / nloc;
        if (old + 1u == (gen + 1u) * nloc) {
            __builtin_amdgcn_fence(__ATOMIC_RELEASE, "agent");
            asm volatile("s_waitcnt vmcnt(0)" ::: "memory");
            const unsigned og = xb_add(&bar[XB_TOP], 1u);
            const unsigned tg = og / nx;
            if (og + 1u == (tg + 1u) * nx) xb_add(&bar[XB_TOPGEN], 1u);
            else XB_SPIN(xb_ld(&bar[XB_TOPGEN]) == tg, bar);
            __builtin_amdgcn_fence(__ATOMIC_ACQUIRE, "agent");
            xb_add(&bar[XB_XGEN(b.x)], 1u);
            asm volatile("s_waitcnt vmcnt(0)" ::: "memory");
        } else {
            XB_SPIN(xb_ld(&bar[XB_XGEN(b.x)]) == gen, bar);
            __builtin_amdgcn_fence(__ATOMIC_ACQUIRE, "agent");
            asm volatile("s_waitcnt vmcnt(0)" ::: "memory");
        }
    }
    __syncthreads();
}

constexpr int LDS_BYTES = 147456;
constexpr int LDS_MISC = 147200;
constexpr int C_BAR = 4096;
constexpr size_t CTL_ZERO_BYTES = 65536;
constexpr size_t DOFF_H2ND = 0;
constexpr size_t DOFF_ORWKV = 64 * MiB;

template <int PH>
DEVI void run_phase(const Params& p, char* lds, int bid, int nb) {
    unsigned char* ws = p.ws;
    if constexpr (PH == 0) { stage_transposes(p, 0, p.njobs_mid, 0, p.items_mid, lds, bid, nb); stage_rope_table(p, bid, nb);
        { u32x4* wz = (u32x4*)(ws + OFF_WIN + (size_t)NZ * DM * 2); const u32x4 z4 = {0u, 0u, 0u, 0u}; for (int i = bid * NTHREADS + my_tid(); i < (LDZ - NZ) * DM / 8; i += nb * NTHREADS) wz[i] = z4; }
        { bf16_t* gp = (bf16_t*)(ws + OFF_GUP); const u32x4 z4 = {0u, 0u, 0u, 0u}; for (int i = bid * NTHREADS + my_tid(); i < 512 * 16; i += nb * NTHREADS) *(u32x4*)(gp + (size_t)(i >> 4) * 256 + 128 + 8 * (i & 15)) = z4; }
        { bf16_t* wrh = (bf16_t*)(ws + OFF_WRT); bf16_t* wrl = wrh + 48 * DM; for (int i = bid * NTHREADS + my_tid(); i < 48 * DM; i += nb * NTHREADS) { const int o = i >> 10, c = i & 1023; const float w = p.in[23][c] * ((o < 4) ? p.in[24][c * 4 + o] : (o < 36 ? p.in[26][c * 32 + (o - 4)] : 0.f)); const unsigned h = f2bf(w); wrh[i] = (bf16_t)h; wrl[i] = (bf16_t)f2bf(w - bf2f(h)); } }
        stage_rms_rows(p.in[0], p.in[1], (bf16_t*)(ws + OFF_H), ws + OFF_H8, bid, nb); }
    if constexpr (PH == 1) { F8Bf16 e{(bf16_t*)(ws + OFF_Z), LDZ}; big_gemm(lds, (const bf16_t*)(ws + OFF_H), DM, (const bf16_t*)(ws + OFF_WIN), DM, T_, LDZ, DM, e, bid, nb); }
    if constexpr (PH == 2) { if ((PROBE_MASK >> 25) & 1) { stage_mla_prep(p, lds, bid, nb, true); stage_sg_prep(p, bid, nb); } stage_mla_prep(p, lds, bid, nb); stage_sg_prep(p, bid, nb); stage_twad_prep(p, bid, nb); }
    if constexpr (PH == 3) {
        const bf16_t* z = (const bf16_t*)(ws + OFF_Z);
        { F8Bf16 e{(bf16_t*)((char*)p.out + DOFF_QRAW), 768}; big_gemm(lds, z, LDZ, (const bf16_t*)(ws + OFF_WUQ), 384, T_, 768, 384, e, bid, nb); }
        { F8Bf16 e{(bf16_t*)((char*)p.out + DOFF_KVRAW), 1024}; big_gemm_<F8Bf16, false, true>(lds, (const bf16_t*)(ws + OFF_CKV8), 128, (const bf16_t*)(ws + OFF_WUKV), 128, T_, 1024, 128, e, bid, nb, nullptr, 0, nullptr); }
        if ((nb & 15) == 0) { if (bid >= nb / 2) { F8Bf16 e{(bf16_t*)(ws + OFF_G), 512}; big_gemm(lds, (const bf16_t*)((const char*)p.out + DOFF_SG), 256, (const bf16_t*)(ws + OFF_GUP), 256, T_, 512, 128  , e, bid - nb / 2, nb / 2); } }
        else { F8Bf16 e{(bf16_t*)(ws + OFF_G), 512}; big_gemm(lds, (const bf16_t*)((const char*)p.out + DOFF_SG), 256, (const bf16_t*)(ws + OFF_GUP), 256, T_, 512, 128  , e, bid, nb); }
        for (int rep = 0; rep < 1 + ((PROBE_MASK >> 20) & 1); ++rep) for (int u = bid; u < BATCH * NH * 2; u += nb) chain_unit(p, u, lds);
    }
    if constexpr (PH == 4) {
        for (int rep = 0; rep < 1 + ((PROBE_MASK >> 21) & 1); ++rep) for (int u = bid; u < BATCH * NH * 8; u += nb) attn_unit(p, u, lds);
        stage_rwkv_post(p, bid, nb);
    }
    if constexpr (PH == 6) {
        if (nb == 256) {
            pg8::BranchOwn SB{bid};
            { F8Bf16 e{(bf16_t*)(ws + OFF_BM), 1024}; big_gemm_s<F8Bf16, false, pg8::BranchOwn, true>(lds, (const bf16_t*)(ws + OFF_OMLA), 256, (const bf16_t*)(ws + OFF_WBM), 256, T_, 1024, 256, e, SB, 0, nullptr); }
            { F8Bf16 e{(bf16_t*)(ws + OFF_BR), 1024}; big_gemm_s<F8Bf16, false, pg8::BranchOwn, true>(lds, (const bf16_t*)((const char*)p.out + DOFF_SG), 256, (const bf16_t*)(ws + OFF_WBR), 256, T_, 1024, 256, e, SB, 0, nullptr); }
            __syncthreads();
            EpiGate eg{(const bf16_t*)(ws + OFF_BM), (const bf16_t*)(ws + OFF_BR), (bf16_t*)(ws + OFF_MIXED), p.in[21]}; pg8::GateOwn SG{bid};
            big_gemm_es<EpiGate, pg8::GateOwn, true>(lds, (const bf16_t*)(ws + OFF_H8), DM / 2, (const bf16_t*)(ws + OFF_WG), DM / 2, T_, 2048, DM / 2, eg, SG);
        } else {
            { F8Bf16 e{(bf16_t*)(ws + OFF_BM), 1024}; big_gemm_<F8Bf16, false, true>(lds, (const bf16_t*)(ws + OFF_OMLA), 256, (const bf16_t*)(ws + OFF_WBM), 256, T_, 1024, 256, e, bid, nb, nullptr, 0, nullptr); }
            { F8Bf16 e{(bf16_t*)(ws + OFF_BR), 1024}; big_gemm_<F8Bf16, false, true>(lds, (const bf16_t*)((const char*)p.out + DOFF_SG), 256, (const bf16_t*)(ws + OFF_WBR), 256, T_, 1024, 256, e, bid, nb, nullptr, 0, nullptr); }
        }
    }
    if constexpr (PH == 7) { if (nb != 256) { EpiGate e{(const bf16_t*)(ws + OFF_BM), (const bf16_t*)(ws + OFF_BR), (bf16_t*)(ws + OFF_MIXED), p.in[21]};
        big_gemm_epi<EpiGate, true>(lds, (const bf16_t*)(ws + OFF_H8), DM / 2, (const bf16_t*)(ws + OFF_WG), DM / 2, T_, 2048, DM / 2, e, bid, nb); } }
    if constexpr (PH == 8) { F8Resid e{p.in[0], (bf16_t*)(ws + OFF_X1)};
        big_gemm_<F8Resid, false, true>(lds, (const bf16_t*)(ws + OFF_MIXED), DM / 2, (const bf16_t*)(ws + OFF_WOUT), DM / 2, T_, DM, DM / 2, e, bid, nb, nullptr, 0, nullptr); }
    if constexpr (PH == 9) { stage_route(p, lds, bid, nb); if ((PROBE_MASK >> 22) & 1) stage_route(p, lds, bid, nb, false); }
    if constexpr (PH == 10) { if ((PROBE_MASK >> 27) & 1) stage_scatter(p, lds, bid, nb, true); stage_scatter(p, lds, bid, nb);
        __syncthreads(); stage_transposes(p, p.njobs_mid, p.njobs_all, p.items_mid, p.items_all, lds, bid, nb); }
    if constexpr (PH == 11) { F8Swiglu e{(bf16_t*)((char*)p.out + DOFF_HID)}; const int* ctl = (const int*)(ws + OFF_CTL);
        const bf16_t* h2 = (const bf16_t*)((const char*)p.out + DOFF_H2); const int nblk = ctl[C_NBLK]; const int e_own = ctl[C_BLKE + (pg8::own_pm(bid) & 255)];
        if (nb == 256 && nblk >= 256 && nblk <= 288) {
            const int L = nblk - 256;
            pg8::OwnG1 S1{bid, 2 * L, ctl + C_BLKE, e_own};
            big_gemm_s<F8Swiglu, true, pg8::OwnG1, true>(lds, h2, DM / 2, (const bf16_t*)(ws + OFF_W13), DM / 2, nblk * 256, 512, DM / 2, e, S1, (size_t)512 * (DM / 2), (const int*)(ws + OFF_SLOTTOK));
            if (bid >= 2 * L) { __syncthreads();
                F8Bf16 e2{(bf16_t*)(ws + OFF_YE), DM}; pg8::OwnG2 S2{bid, e_own};
                big_gemm_s<F8Bf16, false, pg8::OwnG2, true>(lds, (const bf16_t*)((const char*)p.out + DOFF_HID), DEXP / 2, (const bf16_t*)(ws + OFF_W2), DEXP / 2, nblk * 256, DM, DEXP / 2, e2, S2, (size_t)DM * (DEXP / 2), nullptr); }
        } else
            big_gemm_<F8Swiglu, true, true>(lds, h2, DM / 2, (const bf16_t*)(ws + OFF_W13), DM / 2, nblk * 256, 512, DM / 2, e, bid, nb, ctl + C_BLKE, (size_t)512 * (DM / 2), (const int*)(ws + OFF_SLOTTOK));
    }
    if constexpr (PH == 12) { F8Bf16 e{(bf16_t*)(ws + OFF_YE), DM}; const int* ctl = (const int*)(ws + OFF_CTL); const int nblk = ctl[C_NBLK];
        if (nb == 256 && nblk >= 256 && nblk <= 288) { pg8::RestG2 S{bid, nb, nblk - 256, ctl + C_BLKE};
            big_gemm_s<F8Bf16, false, pg8::RestG2, true>(lds, (const bf16_t*)((const char*)p.out + DOFF_HID), DEXP / 2, (const bf16_t*)(ws + OFF_W2), DEXP / 2, nblk * 256, DM, DEXP / 2, e, S, (size_t)DM * (DEXP / 2), nullptr); }
        else big_gemm_<F8Bf16, false, true>(lds, (const bf16_t*)((const char*)p.out + DOFF_HID), DEXP / 2, (const bf16_t*)(ws + OFF_W2), DEXP / 2, nblk * 256, DM, DEXP / 2, e, bid, nb, ctl + C_BLKE, (size_t)DM * (DEXP / 2), nullptr); }
    if constexpr (PH == 13) { if ((PROBE_MASK >> 26) & 1) stage_final(p, bid, nb, true); stage_final(p, bid, nb); }
}

__global__ void __launch_bounds__(NTHREADS, 2) mega_fwd(Params p) {
    extern __shared__ __attribute__((aligned(16))) char lds[];
    const int bid = blockIdx.x, nb = gridDim.x;
    volatile LAS unsigned* misc = (volatile LAS unsigned*)((LAS char*)lds + LDS_MISC);
    if (my_tid() < 64) misc[my_tid()] = 0u;
    __syncthreads();
    XcdBarrier bar = xcd_barrier_post((unsigned*)(p.ws + OFF_CTL) + C_BAR, misc + 8);
    unsigned long long tsp0 = 0, tsp1 = 0;
#define PHASE(k) do { if (SPAN_PH == k) tsp0 = __builtin_amdgcn_s_memrealtime(); run_phase<k>(p, lds, bid, nb); if ((PROBE_MASK >> k) & 1) { __syncthreads(); run_phase<k>(p, lds, bid, nb); } xcd_barrier(bar); if ((PROBE_MASK >> 24) & 1) xcd_barrier(bar); if (SPAN_PH == k) tsp1 = __builtin_amdgcn_s_memrealtime(); } while (0)
    PHASE(0); PHASE(1); PHASE(2); PHASE(3); PHASE(4); PHASE(6); if (nb != 256) PHASE(7); PHASE(8); PHASE(9); PHASE(10); PHASE(11); PHASE(12);
    if (SPAN_PH == 13) tsp0 = __builtin_amdgcn_s_memrealtime();
    run_phase<13>(p, lds, bid, nb);
    if (SPAN_PH == 13) { __syncthreads(); tsp1 = __builtin_amdgcn_s_memrealtime(); }
    if (SPAN_PH >= 0 && bid == 0) { const unsigned long long t2 = __builtin_amdgcn_s_memrealtime(); while (__builtin_amdgcn_s_memrealtime() - t2 < tsp1 - tsp0) __builtin_amdgcn_s_sleep(8); }
#undef PHASE
}

static int add_job(Params& P, int& nj, int& items, int in_idx, int K, int ldsrc, int col0, int ncols, int row_mul, int row_off, int nbatch, long long sbs, long long dbs, size_t dst_off, int dst_ld = 0, int fp8 = 0) {
    TJob& J = P.jobs[nj]; J.in_idx = in_idx; J.K = K; J.ldsrc = ldsrc; J.col0 = col0; J.ncols = ncols; J.row_mul = row_mul; J.row_off = row_off; J.nbatch = nbatch;
    J.sbs = sbs; J.dbs = dbs; J.dst_off = (long long)dst_off; J.item0 = items; J.dst_ld = dst_ld ? dst_ld : K; J.fp8 = fp8;
    items += nbatch * (K / 64) * (ncols / 32); return ++nj;
}
extern "C" void kernel_launch(void* const* d_in, const int* in_sizes, int n_in, void* d_out, int out_size, void* d_ws, size_t ws_size, hipStream_t stream) {
    static int grid = 0;
    if (grid == 0) {
        if (n_in != 32 || out_size != T_ * DM || ws_size < WS_NEED) { fprintf(stderr, "kernel_launch: unexpected shapes (n_in %d out %d ws %zu)\n", n_in, out_size, ws_size); grid = -1; return; }
        int dev = 0, cus = 0, per_cu = 0;
        if (hipGetDevice(&dev) != hipSuccess || hipDeviceGetAttribute(&cus, hipDeviceAttributeMultiprocessorCount, dev) != hipSuccess) { grid = -1; return; }
        if (hipFuncSetAttribute((const void*)mega_fwd, hipFuncAttributeMaxDynamicSharedMemorySize, LDS_BYTES) != hipSuccess) { fprintf(stderr, "kernel_launch: hipFuncSetAttribute failed\n"); grid = -1; return; }
        if (hipOccupancyMaxActiveBlocksPerMultiprocessor(&per_cu, (const void*)mega_fwd, NTHREADS, LDS_BYTES) != hipSuccess || per_cu < 1)
            fprintf(stderr, "kernel_launch: note: occupancy query reports %d workgroups per CU\n", per_cu);
        (void)hipGetLastError();
        grid = cus;
    }
    if (grid < 0) return;
    Params P{};
    for (int i = 0; i < 32; ++i) P.in[i] = (const float*)d_in[i];
    P.out = (float*)d_out; P.ws = (unsigned char*)d_ws;
    int nj = 0, items = 0;
    add_job(P, nj, items, 2, 1024, 4640, 0, 640, 1, 0, 1, 0, 0, OFF_WIN);
    add_job(P, nj, items, 2, 1024, 4640, 672, 1920, 1, 640, 1, 0, 0, OFF_WIN);
    add_job(P, nj, items, 2, 1024, 4640, 640, 32, 1, 0, 1, 0, 0, OFF_WKR, 0, 1);
    add_job(P, nj, items, 2, 1024, 4640, 2592, 1024, -1, 0, 1, 0, 0, OFF_WG, 0, 1);
    add_job(P, nj, items, 2, 1024, 4640, 3616, 1024, -1, 128, 1, 0, 0, OFF_WG, 0, 1);
    add_job(P, nj, items, 5, 384, 768, 0, 768, 1, 0, 1, 0, 0, OFF_WUQ);
    add_job(P, nj, items, 6, 256, 1024, 0, 1024, 1, 0, 1, 0, 0, OFF_WUKV, 0, 1);
    add_job(P, nj, items, 7, 512, 1024, 0, 1024, 1, 0, 1, 0, 0, OFF_WBM, 0, 1);
    add_job(P, nj, items, 20, 512, 1024, 0, 1024, 1, 0, 1, 0, 0, OFF_WBR, 0, 1);
    add_job(P, nj, items, 22, 1024, 1024, 0, 1024, 1, 0, 1, 0, 0, OFF_WOUT, 0, 1);
    add_job(P, nj, items, 11, 64, 512, 0, 512, 1, 0, 2, 64 * 512, 512 * 64, OFF_WUP);
    add_job(P, nj, items, 13, 64, 512, 0, 512, 1, 0, 2, 64 * 512, 512 * 64, OFF_AUP);
    add_job(P, nj, items, 14, 128, 512, 0, 512, 1, 0, 1, 0, 0, OFF_GUP, 256);
    P.njobs_early = nj; P.items_early = items;
    add_job(P, nj, items, 28, 1024, 256, 0, 256, 2, 0, 32, 1024 * 256, 512 * 1024, OFF_W13, 0, 1);
    add_job(P, nj, items, 29, 1024, 256, 0, 256, 2, 1, 32, 1024 * 256, 512 * 1024, OFF_W13, 0, 1);
    P.njobs_mid = nj; P.items_mid = items;
    add_job(P, nj, items, 30, 256, 1024, 0, 1024, 1, 0, 32, 256 * 1024, 1024 * 256, OFF_W2, 0, 1);
    P.njobs_all = nj; P.items_all = items;
    if (hipMemsetAsync((char*)d_ws + OFF_CTL, 0, CTL_ZERO_BYTES, stream) != hipSuccess) { fprintf(stderr, "kernel_launch: memset failed\n"); return; }
    hipLaunchKernelGGL(mega_fwd, dim3(grid), dim3(NTHREADS), LDS_BYTES, stream, P);
}
```
